# Optimizing an MI355X kernel written in HIP

```python
import math
import jax
import jax.numpy as jnp
from jax import lax
import numpy as np

D_MODEL = 1024
BATCH = 16
SEQ = 256
DEPTH = 2
DEC_BATCH = 8
DEC_SEQ = 4096
PAST_LEN = 512

GRID_W = 64
N_EVEN = (DEPTH + 1) // 2
N_ODD = DEPTH // 2
EPS = 1e-6
NEG_INF = -1e30
QBLK = 128
ROPE_THETA = 10000.0

D_SSD = D_MODEL
SSD_HEADDIM = 64
SSD_HEADS = D_SSD // SSD_HEADDIM
SSD_GROUPS = 4
SSD_HPG = SSD_HEADS // SSD_GROUPS
SSD_STATE = 128
SSD_CHUNK = 128
D_CONV = 5
CONV_CH = D_SSD + 2 * SSD_GROUPS * SSD_STATE
D_POOL = D_MODEL
POOL_WINDOWS = (2, 4, 8, 16)
POOL_GROUP = D_POOL // len(POOL_WINDOWS)
IN_EVEN = D_SSD + CONV_CH + 2 * SSD_HEADS + 2 * D_POOL
DIFF_HEADS = 8
DIFF_HD = 64
W_DIFF = DIFF_HEADS * 2 * DIFF_HD
WIN_HEADS = 16
WIN_KV = 4
WIN_GROUP = WIN_HEADS // WIN_KV
WIN_HD = 64
WINDOW = 128
WIN_BLK = 128
W_WIN = WIN_HEADS * WIN_HD
IN_ODD = 4 * W_DIFF + 2 * W_WIN + 2 * WIN_KV * WIN_HD

kernel_name = 'hybrid_dit_ssd_pool_diffattn_swa_step'


def rmsnorm(x, g=None):
    xf = x.astype(jnp.float32)
    y = (xf * lax.rsqrt(jnp.mean(xf * xf, axis=-1, keepdims=True) + EPS)).astype(x.dtype)
    return y if g is None else y * g


def split_cols(u, sizes):
    offs = np.cumsum(sizes)[:-1].tolist()
    return jnp.split(u, offs, axis=-1)


def split_blocks(a, axis):
    t = a.shape[axis]
    a = a.reshape(a.shape[:axis] + (t // QBLK, QBLK) + a.shape[axis + 1:])
    return jnp.moveaxis(a, axis, 0)


def merge_blocks(a, axis):
    a = jnp.moveaxis(a, 0, axis)
    return a.reshape(a.shape[:axis] + (a.shape[axis] * a.shape[axis + 1],) + a.shape[axis + 2:])


def ada_mod(cvec, w, b):
    m = (jax.nn.silu(cvec) @ w + b)[:, None, :]
    return jnp.split(m, 3, axis=-1)


def modulated_norm(x, shift, scale):
    return rmsnorm(x) * (1 + scale) + shift


def axial_rope_tables(t_len, d):
    n_rows = t_len // GRID_W
    row = jnp.repeat(jnp.arange(n_rows), GRID_W).astype(jnp.float32)
    col = jnp.tile(jnp.arange(GRID_W), n_rows).astype(jnp.float32)
    nf = d // 4
    inv = ROPE_THETA ** (-jnp.arange(nf, dtype=jnp.float32) / nf)
    ang = jnp.stack([row[:, None] * inv, col[:, None] * inv], axis=1)
    return jnp.cos(ang), jnp.sin(ang)


def apply_axial_rope(x, cos, sin):
    nf = cos.shape[-1]
    shp = x.shape
    xr = x.reshape(shp[:-1] + (2, 2, nf))
    x1, x2 = xr[..., 0, :], xr[..., 1, :]
    c, s = cos.astype(x.dtype), sin.astype(x.dtype)
    out = jnp.stack([x1 * c - x2 * s, x2 * c + x1 * s], axis=-2)
    return out.reshape(shp)


def centred_dwconv(x, w, b):
    pad = D_CONV // 2
    y = lax.conv_general_dilated(x, w[:, None, :], window_strides=(1,), padding=[(pad, pad)],
                                 dimension_numbers=('NWC', 'WIO', 'NWC'),
                                 feature_group_count=x.shape[-1])
    return y + b


def ssd_scan(x, dt, A, Bm, Cm, h0):
    bsz, t_len = x.shape[:2]
    nc = t_len // SSD_CHUNK

    def chunk(a):
        return a.reshape((bsz, nc, SSD_CHUNK) + a.shape[2:])

    a = chunk(dt.astype(jnp.float32) * A.astype(jnp.float32))
    xdt = chunk(x * dt[..., None])
    Bc, Cc = chunk(Bm), chunk(Cm)
    a_cs = jnp.cumsum(a, axis=2)
    a_cs_t = jnp.moveaxis(a_cs, 2, -1)
    seg = a_cs_t[..., :, None] - a_cs_t[..., None, :]
    lower = jnp.tril(jnp.ones((SSD_CHUNK, SSD_CHUNK), dtype=bool))
    l_mat = jnp.exp(jnp.where(lower, seg, NEG_INF))
    cb = jnp.einsum('bclgn,bcsgn->bcgls', Cc, Bc)
    y_diag = jnp.einsum('bcgrls,bcsgrp->bclgrp', cb[:, :, :, None] * l_mat, xdt)
    decay_to_end = jnp.exp(a_cs[:, :, -1:] - a_cs)
    states = jnp.einsum('bclgn,bclgr,bclgrp->bcgrpn', Bc, decay_to_end, xdt)
    chunk_decay = jnp.exp(a_cs[:, :, -1])

    def step(h, inp):
        st, dec = inp
        return h * dec[..., None, None] + st, h

    h_final, h_prev = lax.scan(step, h0.astype(states.dtype),
                               (jnp.moveaxis(states, 1, 0), jnp.moveaxis(chunk_decay, 1, 0)))
    h_prev = jnp.moveaxis(h_prev, 0, 1)
    y_off = jnp.einsum('bclgn,bcgrpn,bclgr->bclgrp', Cc, h_prev, jnp.exp(a_cs))
    y = (y_diag + y_off).reshape(x.shape)
    return y.astype(x.dtype), h_final.astype(x.dtype)


def pool_mixer(xb, pool_w, pool_scale):
    bsz, t_len, _ = xb.shape
    ng = len(POOL_WINDOWS)
    xg = xb.reshape(bsz, t_len, ng, POOL_GROUP).astype(jnp.float32)
    cs = jnp.concatenate([jnp.zeros((bsz, 1, ng, POOL_GROUP), jnp.float32), jnp.cumsum(xg, axis=1)], axis=1)
    win = np.array(POOL_WINDOWS)
    left = win // 2
    right = win - 1 - left
    t = jnp.arange(t_len)
    lo = jnp.clip(t[None, :] - left[:, None], 0, t_len)
    hi = jnp.clip(t[None, :] + right[:, None] + 1, 0, t_len)
    gi = jnp.arange(ng)[:, None]
    s = cs[:, hi, gi] - cs[:, lo, gi]
    mean = s / (hi - lo).astype(jnp.float32)[None, :, :, None]
    pooled = (jnp.moveaxis(mean, 1, 2) - xg).astype(xb.dtype)
    y = jnp.einsum('btgc,gcd->btgd', pooled, pool_w).reshape(bsz, t_len, D_POOL)
    return y * pool_scale


def even_mixer(h, w_in, conv_w, conv_b, A_log, dt_bias, D_skip, norm_g, pool_w, pool_scale, w_out, h0_fwd, h0_bwd):
    bsz, t_len, _ = h.shape
    u = h @ w_in
    z_a, xbc, dt_raw, z_b, x_b = split_cols(u, [D_SSD, CONV_CH, 2 * SSD_HEADS, D_POOL, D_POOL])
    xbc = jax.nn.silu(centred_dwconv(xbc, conv_w, conv_b))
    xs, Bm, Cm = split_cols(xbc, [D_SSD, SSD_GROUPS * SSD_STATE, SSD_GROUPS * SSD_STATE])
    xs = xs.reshape(bsz, t_len, SSD_GROUPS, SSD_HPG, SSD_HEADDIM)
    Bm = Bm.reshape(bsz, t_len, SSD_GROUPS, SSD_STATE)
    Cm = Cm.reshape(bsz, t_len, SSD_GROUPS, SSD_STATE)
    dt = jax.nn.softplus(dt_raw.reshape(bsz, t_len, 2, SSD_GROUPS, SSD_HPG)
                         + dt_bias.reshape(2, SSD_GROUPS, SSD_HPG))
    A = -jnp.exp(A_log.reshape(2, SSD_GROUPS, SSD_HPG))

    def to_grp(s):
        return s.reshape(bsz, SSD_GROUPS, SSD_HPG, SSD_HEADDIM, SSD_STATE)

    def flip(a):
        return jnp.flip(a, axis=1)

    y_f, h_f = ssd_scan(xs, dt[:, :, 0], A[0], Bm, Cm, to_grp(h0_fwd))
    y_b, h_b = ssd_scan(flip(xs), flip(dt[:, :, 1]), A[1], flip(Bm), flip(Cm), to_grp(h0_bwd))
    y = y_f + flip(y_b) + xs * D_skip.reshape(SSD_GROUPS, SSD_HPG, 1)
    y_ssd = rmsnorm(y.reshape(bsz, t_len, D_SSD) * jax.nn.silu(z_a), norm_g)
    y_pool = pool_mixer(x_b, pool_w, pool_scale) * jax.nn.silu(z_b)
    out = jnp.concatenate([y_ssd, y_pool], axis=-1) @ w_out
    return (out,
            h_f.reshape(bsz, SSD_HEADS, SSD_HEADDIM, SSD_STATE),
            h_b.reshape(bsz, SSD_HEADS, SSD_HEADDIM, SSD_STATE))


def odd_project(h, w_in):
    bsz, t_len, _ = h.shape
    u = h @ w_in
    qc, kc, vc, zc, qd, kd, vd, zd = split_cols(
        u, [W_DIFF, W_DIFF, W_DIFF, W_DIFF, W_WIN, WIN_KV * WIN_HD, WIN_KV * WIN_HD, W_WIN])
    qc = qc.reshape(bsz, t_len, DIFF_HEADS, 2, DIFF_HD).transpose(0, 2, 3, 1, 4)
    kc = kc.reshape(bsz, t_len, DIFF_HEADS, 2, DIFF_HD).transpose(0, 2, 3, 1, 4)
    vc = vc.reshape(bsz, t_len, DIFF_HEADS, 2 * DIFF_HD).transpose(0, 2, 1, 3)
    qd = qd.reshape(bsz, t_len, WIN_KV, WIN_GROUP, WIN_HD).transpose(0, 2, 3, 1, 4)
    kd = kd.reshape(bsz, t_len, WIN_KV, WIN_HD).transpose(0, 2, 1, 3)
    vd = vd.reshape(bsz, t_len, WIN_KV, WIN_HD).transpose(0, 2, 1, 3)
    return qc, kc, vc, zc, qd, kd, vd, zd


def diff_lambda(lam_params, layer_idx):
    lam_init = 0.8 - 0.6 * math.exp(-0.3 * layer_idx)
    lq1, lk1, lq2, lk2 = lam_params[0], lam_params[1], lam_params[2], lam_params[3]
    lam = (jnp.exp(jnp.sum(lq1 * lk1).astype(jnp.float32))
           - jnp.exp(jnp.sum(lq2 * lk2).astype(jnp.float32)) + lam_init)
    return lam, lam_init


def diff_attention(q, k, v, lam):
    scale = DIFF_HD ** -0.5

    def block(qb):
        s = jnp.einsum('bhiqd,bhikd->bhiqk', qb, k).astype(jnp.float32) * scale
        p = jax.nn.softmax(s, axis=-1)
        attn = p[:, :, 0] - lam * p[:, :, 1]
        return jnp.einsum('bhqk,bhkv->bhqv', attn.astype(v.dtype), v)

    out = lax.map(block, split_blocks(q, axis=3))
    return merge_blocks(out, axis=2)


def sink_attention(q, k, v, sink):
    scale = WIN_HD ** -0.5
    sk = sink.astype(jnp.float32)[None, :, :, None, None]

    def block(qb):
        s = jnp.einsum('bkgqd,bkld->bkgql', qb, k).astype(jnp.float32) * scale
        logits = jnp.concatenate([s, jnp.broadcast_to(sk, s.shape[:-1] + (1,))], axis=-1)
        p = jax.nn.softmax(logits, axis=-1)[..., :-1]
        return jnp.einsum('bkgql,bkld->bkgqd', p.astype(v.dtype), v)

    out = lax.map(block, split_blocks(q, axis=3))
    return merge_blocks(out, axis=3)


def window_sink_attention(q, k, v, k_ctx, v_ctx, sink):
    t_len = q.shape[3]
    nb = t_len // WIN_BLK
    n_ctx = k_ctx.shape[2]
    scale = WIN_HD ** -0.5
    pad = ((0, 0), (0, 0), (WIN_BLK, WIN_BLK), (0, 0))
    k_pad = jnp.pad(k, pad)
    v_pad = jnp.pad(v, pad)
    sk = sink.astype(jnp.float32)[None, :, :, None, None]

    def block(i):
        start = i * WIN_BLK
        qb = lax.dynamic_slice_in_dim(q, start, WIN_BLK, axis=3)
        kw = lax.dynamic_slice_in_dim(k_pad, start, 3 * WIN_BLK, axis=2)
        vw = lax.dynamic_slice_in_dim(v_pad, start, 3 * WIN_BLK, axis=2)
        qpos = start + jnp.arange(WIN_BLK)
        kpos = start - WIN_BLK + jnp.arange(3 * WIN_BLK)
        valid = ((kpos[None, :] >= 0) & (kpos[None, :] < t_len)
                 & (jnp.abs(qpos[:, None] - kpos[None, :]) <= WINDOW))
        s_w = jnp.einsum('bkgqd,bkwd->bkgqw', qb, kw).astype(jnp.float32) * scale
        s_w = jnp.where(valid, s_w, NEG_INF)
        s_c = jnp.einsum('bkgqd,bkld->bkgql', qb, k_ctx).astype(jnp.float32) * scale
        logits = jnp.concatenate([s_c, s_w, jnp.broadcast_to(sk, s_c.shape[:-1] + (1,))], axis=-1)
        p = jax.nn.softmax(logits, axis=-1).astype(v.dtype)
        return (jnp.einsum('bkgql,bkld->bkgqd', p[..., :n_ctx], v_ctx)
                + jnp.einsum('bkgqw,bkwd->bkgqd', p[..., n_ctx:n_ctx + 3 * WIN_BLK], vw))

    out = lax.map(block, jnp.arange(nb))
    return merge_blocks(out, axis=3)


def odd_output(oc, od, zc, zd, subln_g, lam_init, w_out):
    bsz, t_len = zc.shape[:2]
    oc = rmsnorm(oc, subln_g) * (1 - lam_init)
    oc = oc.transpose(0, 2, 1, 3).reshape(bsz, t_len, W_DIFF)
    od = od.transpose(0, 3, 1, 2, 4).reshape(bsz, t_len, W_WIN)
    return jnp.concatenate([oc * jax.nn.silu(zc), od * jax.nn.silu(zd)], axis=-1) @ w_out


def odd_mixer_context(h, w_in, lam_params, subln_g, sink, w_out, layer_idx):
    bsz, t_len, _ = h.shape
    qc, kc, vc, zc, qd, kd, vd, zd = odd_project(h, w_in)
    lam, lam_init = diff_lambda(lam_params, layer_idx)
    oc = diff_attention(qc, kc, vc, lam)
    od = sink_attention(qd, kd, vd, sink.reshape(WIN_KV, WIN_GROUP))
    out = odd_output(oc, od, zc, zd, subln_g, lam_init, w_out)
    k_cache = kc.transpose(0, 1, 3, 2, 4).reshape(bsz, DIFF_HEADS, t_len, 2 * DIFF_HD)
    return out, k_cache, vc, kd, vd


def odd_mixer_latent(h, w_in, lam_params, subln_g, sink, w_out, ck, cv, wk, wv, layer_idx):
    bsz, t_len, _ = h.shape
    qc, kc, vc, zc, qd, kd, vd, zd = odd_project(h, w_in)
    cos_c, sin_c = axial_rope_tables(t_len, DIFF_HD)
    qc = apply_axial_rope(qc, cos_c, sin_c)
    kc = apply_axial_rope(kc, cos_c, sin_c)
    cos_w, sin_w = axial_rope_tables(t_len, WIN_HD)
    qd = apply_axial_rope(qd, cos_w, sin_w)
    kd = apply_axial_rope(kd, cos_w, sin_w)
    n_ctx = ck.shape[2]
    ck = ck.reshape(bsz, DIFF_HEADS, n_ctx, 2, DIFF_HD).transpose(0, 1, 3, 2, 4)
    k_all = jnp.concatenate([ck, kc], axis=3)
    v_all = jnp.concatenate([cv, vc], axis=2)
    lam, lam_init = diff_lambda(lam_params, layer_idx)
    oc = diff_attention(qc, k_all, v_all, lam)
    od = window_sink_attention(qd, kd, vd, wk, wv, sink.reshape(WIN_KV, WIN_GROUP))
    return odd_output(oc, od, zc, zd, subln_g, lam_init, w_out)


def setup_inputs(seed: int = 0) -> dict:
    key = jax.random.key(seed)
    ks = jax.random.split(key, 32)
    f32 = jnp.float32

    def nrm(k, shape, s):
        return jax.random.normal(k, shape, f32) * s

    inp = {}
    inp['x_prompt'] = nrm(ks[0], (BATCH, SEQ, D_MODEL), 1.0)
    inp['x_sample'] = nrm(ks[1], (DEC_BATCH, DEC_SEQ, D_MODEL), 1.0)
    inp['state_ssd_fwd'] = nrm(ks[2], (DEC_BATCH, N_EVEN, SSD_HEADS, SSD_HEADDIM, SSD_STATE), 0.5)
    inp['state_ssd_bwd'] = nrm(ks[3], (DEC_BATCH, N_EVEN, SSD_HEADS, SSD_HEADDIM, SSD_STATE), 0.5)
    inp['cache_diff_k'] = nrm(ks[4], (DEC_BATCH, N_ODD, DIFF_HEADS, PAST_LEN, 2 * DIFF_HD), 1.0)
    inp['cache_diff_v'] = nrm(ks[5], (DEC_BATCH, N_ODD, DIFF_HEADS, PAST_LEN, 2 * DIFF_HD), 1.0)
    inp['cache_win_k'] = nrm(ks[6], (DEC_BATCH, N_ODD, WIN_KV, PAST_LEN, WIN_HD), 1.0)
    inp['cache_win_v'] = nrm(ks[7], (DEC_BATCH, N_ODD, WIN_KV, PAST_LEN, WIN_HD), 1.0)
    inp['c'] = nrm(ks[8], (DEC_BATCH, D_MODEL), 1.0)
    inp['c_ctx'] = nrm(ks[9], (D_MODEL,), 1.0)
    inp['w_ada'] = nrm(ks[10], (DEPTH, D_MODEL, 3 * D_MODEL), 0.5 * D_MODEL ** -0.5)
    inp['b_ada'] = nrm(ks[11], (DEPTH, 3 * D_MODEL), 0.02)
    inp['ev_w_in'] = nrm(ks[12], (N_EVEN, D_MODEL, IN_EVEN), D_MODEL ** -0.5)
    inp['ev_conv_w'] = nrm(ks[13], (N_EVEN, D_CONV, CONV_CH), D_CONV ** -0.5)
    inp['ev_conv_b'] = nrm(ks[14], (N_EVEN, CONV_CH), 0.02)
    inp['ev_A_log'] = jnp.log(jax.random.uniform(ks[15], (N_EVEN, 2, SSD_HEADS), f32, 1.0, 16.0))
    dt0 = jnp.exp(jax.random.uniform(ks[16], (N_EVEN, 2, SSD_HEADS), f32, math.log(1e-3), math.log(1e-1)))
    inp['ev_dt_bias'] = dt0 + jnp.log(-jnp.expm1(-dt0))
    inp['ev_D'] = 1.0 + nrm(ks[17], (N_EVEN, SSD_HEADS), 0.1)
    inp['ev_norm_g'] = 1.0 + nrm(ks[18], (N_EVEN, D_SSD), 0.05)
    inp['ev_pool_w'] = nrm(ks[19], (N_EVEN, len(POOL_WINDOWS), POOL_GROUP, POOL_GROUP), POOL_GROUP ** -0.5)
    inp['ev_pool_scale'] = 1.0 + nrm(ks[20], (N_EVEN, D_POOL), 0.1)
    inp['ev_w_out'] = nrm(ks[21], (N_EVEN, D_SSD + D_POOL, D_MODEL), (D_SSD + D_POOL) ** -0.5)
    inp['od_w_in'] = nrm(ks[22], (N_ODD, D_MODEL, IN_ODD), D_MODEL ** -0.5)
    inp['od_lambda'] = nrm(ks[23], (N_ODD, 4, DIFF_HD), 0.1)
    inp['od_subln_g'] = 1.0 + nrm(ks[24], (N_ODD, 2 * DIFF_HD), 0.05)
    inp['od_sink'] = nrm(ks[25], (N_ODD, WIN_HEADS), 0.5)
    inp['od_w_out'] = nrm(ks[26], (N_ODD, W_DIFF + W_WIN, D_MODEL), (W_DIFF + W_WIN) ** -0.5)
    inp['final_norm_g'] = 1.0 + nrm(ks[27], (D_MODEL,), 0.05)
    return inp


def reference(x_prompt, x_sample, state_ssd_fwd, state_ssd_bwd, cache_diff_k, cache_diff_v,
              cache_win_k, cache_win_v, c, c_ctx, w_ada, b_ada,
              ev_w_in, ev_conv_w, ev_conv_b, ev_A_log, ev_dt_bias, ev_D, ev_norm_g,
              ev_pool_w, ev_pool_scale, ev_w_out,
              od_w_in, od_lambda, od_subln_g, od_sink, od_w_out, final_norm_g):
    x = x_prompt
    n_req = x.shape[0]
    ssd_f, ssd_b, diff_k, diff_v, win_k, win_v = [], [], [], [], [], []
    for l in range(DEPTH):
        j = l // 2
        shift, scale, gate = ada_mod(c_ctx[None, :], w_ada[l], b_ada[l])
        h = modulated_norm(x, shift, scale)
        if l % 2 == 0:
            zero_state = jnp.zeros((n_req, SSD_HEADS, SSD_HEADDIM, SSD_STATE), x.dtype)
            y, h_f, h_b = even_mixer(h, ev_w_in[j], ev_conv_w[j], ev_conv_b[j], ev_A_log[j], ev_dt_bias[j],
                                     ev_D[j], ev_norm_g[j], ev_pool_w[j], ev_pool_scale[j], ev_w_out[j],
                                     zero_state, zero_state)
            ssd_f.append(h_f)
            ssd_b.append(h_b)
        else:
            y, k_d, v_d, k_w, v_w = odd_mixer_context(h, od_w_in[j], od_lambda[j], od_subln_g[j],
                                                      od_sink[j], od_w_out[j], l)
            diff_k.append(k_d)
            diff_v.append(v_d)
            win_k.append(k_w)
            win_v.append(v_w)
        x = x + gate * y
    y_prompt = rmsnorm(x, final_norm_g)

    x = x_sample
    for l in range(DEPTH):
        j = l // 2
        shift, scale, gate = ada_mod(c, w_ada[l], b_ada[l])
        h = modulated_norm(x, shift, scale)
        if l % 2 == 0:
            y, _, _ = even_mixer(h, ev_w_in[j], ev_conv_w[j], ev_conv_b[j], ev_A_log[j], ev_dt_bias[j],
                                 ev_D[j], ev_norm_g[j], ev_pool_w[j], ev_pool_scale[j], ev_w_out[j],
                                 state_ssd_fwd[:, j], state_ssd_bwd[:, j])
        else:
            y = odd_mixer_latent(h, od_w_in[j], od_lambda[j], od_subln_g[j], od_sink[j], od_w_out[j],
                                 cache_diff_k[:, j], cache_diff_v[:, j], cache_win_k[:, j], cache_win_v[:, j], l)
        x = x + gate * y
    y_sample = rmsnorm(x, final_norm_g)

    new_ssd_fwd = jnp.stack(ssd_f, axis=1)
    new_ssd_bwd = jnp.stack(ssd_b, axis=1)
    new_diff_k = jnp.stack(diff_k, axis=1)
    new_diff_v = jnp.stack(diff_v, axis=1)
    new_win_k = jnp.stack(win_k, axis=1)
    new_win_v = jnp.stack(win_v, axis=1)
    return (y_prompt, y_sample, new_ssd_fwd, new_ssd_bwd, new_diff_k, new_diff_v, new_win_k, new_win_v)
```

```cpp
#include <hip/hip_runtime.h>
#include <hip/hip_cooperative_groups.h>
#include <cstdio>
#include <cstdint>
namespace cg = cooperative_groups;

#define DI __device__ __forceinline__
#define LAS __attribute__((address_space(3)))
typedef unsigned short bf16_t;
typedef short bf16x8 __attribute__((ext_vector_type(8)));
typedef short s16x4 __attribute__((ext_vector_type(4)));
typedef float f32x2 __attribute__((ext_vector_type(2)));
typedef float f32x4 __attribute__((ext_vector_type(4)));
typedef float f32x16 __attribute__((ext_vector_type(16)));
typedef unsigned u32x2 __attribute__((ext_vector_type(2)));
typedef unsigned u32x4 __attribute__((ext_vector_type(4)));
typedef __bf16 bf16x2_t __attribute__((ext_vector_type(2)));
typedef LAS unsigned char* ldsp;

constexpr int DM = 1024;
constexpr int R_CTX = 4096, R_ALL = 36864;
constexpr int GRP_ROW0[2] = {0, 20480};
constexpr int GRP_ROWS[2] = {20480, 16384};
constexpr int MAXROWS = 20480;
constexpr int N_E = 5376;
constexpr int N_O = 6656;
constexpr float EPS = 1e-6f;
constexpr float C2 = 0.125f * 1.4426950408889634f;
constexpr float LOG2E = 1.4426950408889634f;

constexpr size_t MiB = 1u << 20;
constexpr size_t WS_MOD = 0;
constexpr size_t WS_ROPE = 256 * 1024;
constexpr size_t WS_LAM = 300 * 1024;
constexpr size_t WS_BIAS1 = 320 * 1024;
constexpr size_t WS_SSY = 600 * 1024;
constexpr size_t WS_SS1 = 700 * 1024;
constexpr size_t WS_WT_IN_E = 1 * MiB;
constexpr size_t WS_WT_OUT_E = 12 * MiB;
constexpr size_t WS_WT_IN_O = 16 * MiB;
constexpr size_t WS_WT_OUT_O = 29 * MiB;
constexpr size_t WS_WT_POOL = 33 * MiB;
constexpr size_t WS_CK = 34 * MiB;
constexpr size_t WS_CV = 42 * MiB;
constexpr size_t WS_WK = 50 * MiB;
constexpr size_t WS_WV = 52 * MiB;
constexpr size_t WS_DTRAW = 54 * MiB;
constexpr size_t WS_DTV = 57 * MiB;
constexpr size_t WS_ACS = 60 * MiB;
constexpr size_t WS_DECAY = 63 * MiB;
constexpr size_t WS_REGA = 64 * MiB;
constexpr size_t WS_X1B = 64 * MiB + 40 * MiB;
constexpr size_t WS_AOUT = 144 * MiB;
constexpr size_t WS_U = 224 * MiB;
constexpr size_t WS_XBCRAW = WS_U;
constexpr size_t WS_XBC = WS_U + 80 * MiB;
constexpr size_t WS_XB = WS_U + 160 * MiB;
constexpr size_t WS_POOLED = WS_U + 200 * MiB;
constexpr size_t WS_BAR = 484 * MiB;
constexpr size_t WS_END = 485 * MiB;

constexpr size_t OUT_X = 0;
constexpr size_t OUT_SSD_F = (size_t)R_ALL * DM;
constexpr size_t OUT_SSD_B = OUT_SSD_F + 16 * 16 * 64 * 128;
constexpr size_t OUT_DIFF_K = OUT_SSD_B + 16 * 16 * 64 * 128;
constexpr size_t OUT_DIFF_V = OUT_DIFF_K + 16 * 8 * 256 * 128;
constexpr size_t OUT_WIN_K = OUT_DIFF_V + 16 * 8 * 256 * 128;
constexpr size_t OUT_WIN_V = OUT_WIN_K + 16 * 4 * 256 * 64;
constexpr size_t OUT_END = OUT_WIN_V + 16 * 4 * 256 * 64;

constexpr int NTHREADS = 512, NWAVES = 8;
constexpr int LDS_BYTES = 160 * 1024;

DI float bf2f(bf16_t v) { return __uint_as_float((unsigned)v << 16); }
DI unsigned pk2(float lo, float hi) { f32x2 v = {lo, hi}; bf16x2_t b = __builtin_convertvector(v, bf16x2_t); return __builtin_bit_cast(unsigned, b); }
DI bf16_t f2bf(float f) { return (bf16_t)(pk2(f, 0.f) & 0xffffu); }
DI float lo_f(unsigned w) { return __uint_as_float(w << 16); }
DI float hi_f(unsigned w) { return __uint_as_float(w & 0xffff0000u); }
DI float silu_f(float x) { return x * __builtin_amdgcn_rcpf(1.f + __expf(-x)); }
DI void bar_lds() { asm volatile("s_waitcnt lgkmcnt(0)" ::: "memory"); __builtin_amdgcn_s_barrier(); asm volatile("" ::: "memory"); }
DI float shfl_idx(float v, int srclane) { return __uint_as_float((unsigned)__builtin_amdgcn_ds_bpermute(srclane << 2, (int)__float_as_uint(v))); }
DI float wave_sum(float v, int lane) {
#pragma unroll
    for (int o = 1; o < 64; o <<= 1) v += shfl_idx(v, lane ^ o);
    return v;
}
DI bf16x8 lds_ld128(ldsp p) { return *(const LAS bf16x8*)p; }
DI void lds_st128(ldsp p, u32x4 v) { *(LAS u32x4*)p = v; }
typedef short v4i16_t __attribute__((ext_vector_type(4)));
DI s16x4 lds_tr(ldsp p) { return __builtin_bit_cast(s16x4, __builtin_amdgcn_ds_read_tr16_b64_v4i16((LAS v4i16_t*)p)); }
DI bf16x8 cat8(s16x4 lo, s16x4 hi) { return __builtin_shufflevector(lo, hi, 0, 1, 2, 3, 4, 5, 6, 7); }
DI int crow(int reg, int h) { return (reg & 3) + 8 * (reg >> 2) + 4 * h; }
DI bf16x8 pack8(const f32x16& x, int s) {
    u32x4 p; p.x = pk2(x[8 * s], x[8 * s + 1]); p.y = pk2(x[8 * s + 2], x[8 * s + 3]); p.z = pk2(x[8 * s + 4], x[8 * s + 5]); p.w = pk2(x[8 * s + 6], x[8 * s + 7]);
    return __builtin_bit_cast(bf16x8, p);
}
#define MFMA32(a, b, c) __builtin_amdgcn_mfma_f32_32x32x16_bf16((a), (b), (c), 0, 0, 0)

struct RowInfo { int ctx, b, t, T, g; };
DI RowInfo rowinfo(int row) {
    RowInfo r;
    if (row < R_CTX) { r.ctx = 1; r.b = row >> 8; r.t = row & 255; r.T = 256; r.g = 8; }
    else { const int q = row - R_CTX; r.ctx = 0; r.b = q >> 12; r.t = q & 4095; r.T = 4096; r.g = r.b; }
    return r;
}
namespace pg8 {
#define PG8_LAS __attribute__((address_space(3)))
constexpr int BM = 256, BK = 64, HALF = 128, HTB = HALF * BK * 2  , STAGE_BYTES = 8 * HTB, NXCD = 8, WGM = 8;

__host__ __device__ __forceinline__ int lds_byte(int r, int c) { const int st = (r >> 4) * 2 + (c >> 5), rr = r & 15, cc = c & 31, ob = rr * 64 + cc * 2; return st * 1024 + (ob ^ (((ob >> 9) & 1) << 5)); }
__host__ __device__ __forceinline__ void stage_rc(int b, int& R, int& C) { const int st = b / 1024, sb = b % 1024, swz = sb ^ (((sb >> 9) & 1) << 5); R = (st >> 1) * 16 + swz / 64; C = (st & 1) * 32 + (swz % 64) / 2; }
__host__ __device__ __forceinline__ int perm32(int rho) { const int n = rho >> 4, i = rho & 15; return 8 * (i >> 2) + 4 * n + (i & 3); }

struct Unit { int pm, pn; };
struct Gemm { const bf16_t* A; const bf16_t* Bt; int M, N, K, lda, a_pn_off; };

struct StaticOrder {
    int nM, nN, nwg, G, c;
    __host__ __device__ void init(int M, int N, int G_, int c_) { nM = M / BM; nN = N / BM; nwg = nM * nN; G = G_; c = c_; }
    __host__ __device__ bool next(int i, Unit& u) const {
        const long L = (long)i * G + c; if (L >= nwg) return false;
        int wgid = (int)L; { const int q = nwg / NXCD, r = nwg % NXCD, xcd = wgid % NXCD, off = wgid / NXCD; wgid = (xcd < r ? xcd * (q + 1) : r * (q + 1) + (xcd - r) * q) + off; }
        const int nig = WGM * nN, gid = wgid / nig, fm = gid * WGM, gsz = (nM - fm) < WGM ? (nM - fm) : WGM;
        u.pm = fm + ((wgid % nig) % gsz); u.pn = (wgid % nig) / gsz; return true;
    }
    __device__ __forceinline__ void a_ready(const Unit&) const {}
    __device__ __forceinline__ void done(const Unit&) const {}
};


template <class Epi, class Sched, bool ALIGN_EPI = false, bool SP2 = false>
__device__ __forceinline__ void gemm_phase(PG8_LAS unsigned char* lds, const Gemm g, const Sched& S, const Epi& E, const int tid) {
    const int wid = __builtin_amdgcn_readfirstlane(tid >> 6), lane = tid & 63, wr = wid >> 2, wc = wid & 3, fr = lane & 15, fq = lane >> 4;
    const int K = g.K, nt = K / BK;
    unsigned voffA[2], voffB[2];
#pragma unroll
    for (int i = 0; i < 2; ++i) { int R, C; stage_rc(tid * 16 + i * 8192, R, C); const int Rb = Epi::PERM ? ((R & ~31) + perm32(R & 31)) : R;
        voffA[i] = (unsigned)(R * g.lda + C) * 2u; voffB[i] = (unsigned)(Rb * K + C) * 2u; }
    const size_t kstep = (size_t)(BK * 2);
    const size_t hstepA = (size_t)HALF * g.lda * 2, hstepB = (size_t)HALF * K * 2;
    const size_t tstepA = 2 * hstepA, tstepB = 2 * hstepB, pnoff = (size_t)g.a_pn_off * 2;
    const unsigned ldsw = (unsigned)wid * 1024u;
    const int aoff = lds_byte(wr * 64 + fr, fq * 8), boff = lds_byte(wc * 32 + fr, fq * 8);
#define PG8_SA(b, h) (((b) * 2 + (h)) * HTB)
#define PG8_SB(b, h) ((4 + (b) * 2 + (h)) * HTB)
#define PG8_STAGE(bufoff, gbase, voff) do { _Pragma("unroll") for (int _i = 0; _i < 2; ++_i) \
        __builtin_amdgcn_global_load_lds((const unsigned*)((const char*)(gbase) + (voff)[_i]), (PG8_LAS unsigned*)(lds + (bufoff) + ldsw + _i * 8192), 16, 0, 0); } while (0)
#define PG8_LDA(dst, b, h) do { _Pragma("unroll") for (int m = 0; m < 4; ++m) _Pragma("unroll") for (int k = 0; k < 2; ++k) dst[m][k] = *(const PG8_LAS bf16x8*)(lds + PG8_SA(b, h) + aoff + m * 2048 + k * 1024); } while (0)
#define PG8_LDB(dst, b, h) do { _Pragma("unroll") for (int n = 0; n < 2; ++n) _Pragma("unroll") for (int k = 0; k < 2; ++k) dst[n][k] = *(const PG8_LAS bf16x8*)(lds + PG8_SB(b, h) + boff + n * 2048 + k * 1024); } while (0)
#define PG8_MMA(ai, bj, At, Bt) do { __builtin_amdgcn_s_setprio(1); _Pragma("unroll") for (int m = 0; m < 4; ++m) _Pragma("unroll") for (int n = 0; n < 2; ++n) _Pragma("unroll") for (int k = 0; k < 2; ++k) \
        acc[ai][bj][m][n] = __builtin_amdgcn_mfma_f32_16x16x32_bf16(Bt[n][k], At[m][k], acc[ai][bj][m][n], 0, 0, 0); __builtin_amdgcn_s_setprio(0); } while (0)
#define PG8_WAIT_V(n) asm volatile("s_waitcnt vmcnt(" #n ")" ::: "memory")
#define PG8_WAIT_L(n) asm volatile("s_waitcnt lgkmcnt(" #n ")" ::: "memory")
#define PG8_BAR __builtin_amdgcn_s_barrier()
#define PG8_SCHED __builtin_amdgcn_sched_barrier(0)
    Unit cur, nxt; int ui = 0;
    if (!S.next(0, cur)) return;
    f32x4 acc[2][2][4][2];
#pragma unroll
    for (int a = 0; a < 2; ++a)
#pragma unroll
        for (int b = 0; b < 2; ++b)
#pragma unroll
            for (int m = 0; m < 4; ++m)
#pragma unroll
                for (int n = 0; n < 2; ++n) acc[a][b][m][n] = (f32x4){0.f, 0.f, 0.f, 0.f};
    bf16x8 At[4][2], B0[2][2], B1[2][2];
    const char* cA = (const char*)g.A + (size_t)cur.pm * tstepA + (size_t)cur.pn * pnoff; const char* cB = (const char*)g.Bt + (size_t)cur.pn * tstepB;
    S.a_ready(cur);
    if constexpr (SP2) {
        PG8_STAGE(PG8_SB(0, 0), cB, voffB); PG8_STAGE(PG8_SB(0, 1), cB + hstepB, voffB); PG8_STAGE(PG8_SA(0, 0), cA, voffA); PG8_STAGE(PG8_SA(0, 1), cA + hstepA, voffA);
        if (wr == 1) PG8_BAR;
        PG8_WAIT_V(2); PG8_BAR;
        PG8_STAGE(PG8_SB(1, 0), cB + kstep, voffB); PG8_STAGE(PG8_SA(1, 0), cA + kstep, voffA); PG8_STAGE(PG8_SB(1, 1), cB + hstepB + kstep, voffB);
        PG8_WAIT_V(6); PG8_BAR;
    } else {
        PG8_STAGE(PG8_SB(0, 0), cB, voffB); PG8_STAGE(PG8_SA(0, 0), cA, voffA); PG8_STAGE(PG8_SB(0, 1), cB + hstepB, voffB); PG8_STAGE(PG8_SA(0, 1), cA + hstepA, voffA);
        if (wr == 1) PG8_BAR;
        PG8_WAIT_V(4); PG8_BAR;
        PG8_STAGE(PG8_SB(1, 0), cB + kstep, voffB); PG8_STAGE(PG8_SA(1, 0), cA + kstep, voffA); PG8_STAGE(PG8_SB(1, 1), cB + hstepB + kstep, voffB);
        PG8_WAIT_V(6); PG8_BAR;
    }
    for (;;) {
        const bool has_next = S.next(ui + 1, nxt);
        const char* nA = has_next ? (const char*)g.A + (size_t)nxt.pm * tstepA + (size_t)nxt.pn * pnoff : cA; const char* nB = has_next ? (const char*)g.Bt + (size_t)nxt.pn * tstepB : cB;
        for (int t = 0; t < nt; t += 2) {
            const bool last = (t == nt - 2);
            const char* a1 = cA + (size_t)(t + 1) * kstep;
            const char* a2 = last ? nA : cA + (size_t)(t + 2) * kstep; const char* b2 = last ? nB : cB + (size_t)(t + 2) * kstep;
            const char* a3 = a2 + kstep; const char* b3 = b2 + kstep;
            if (last && has_next) S.a_ready(nxt);
            if constexpr (SP2) {
            PG8_LDB(B0, 0, 0); PG8_LDB(B1, 0, 1); PG8_SCHED; PG8_LDA(At, 0, 0); PG8_STAGE(PG8_SA(1, 1), a1 + hstepA, voffA);
            PG8_WAIT_V(8); PG8_WAIT_L(0); PG8_BAR; PG8_MMA(0, 0, At, B0); PG8_MMA(0, 1, At, B1); PG8_BAR; PG8_SCHED;
            PG8_LDA(At, 0, 1); PG8_STAGE(PG8_SB(0, 0), b2, voffB); PG8_STAGE(PG8_SB(0, 1), b2 + hstepB, voffB); PG8_STAGE(PG8_SA(0, 0), a2, voffA);
            PG8_WAIT_V(8); PG8_WAIT_L(0); PG8_BAR; PG8_MMA(1, 0, At, B0); PG8_MMA(1, 1, At, B1); PG8_BAR; PG8_SCHED;
            PG8_LDB(B0, 1, 0); PG8_LDB(B1, 1, 1); PG8_SCHED; PG8_LDA(At, 1, 0); PG8_STAGE(PG8_SA(0, 1), a2 + hstepA, voffA);
            PG8_WAIT_V(8); PG8_WAIT_L(0); PG8_BAR; PG8_MMA(0, 0, At, B0); PG8_MMA(0, 1, At, B1); PG8_BAR; PG8_SCHED;
            PG8_LDA(At, 1, 1); PG8_STAGE(PG8_SB(1, 0), b3, voffB); PG8_STAGE(PG8_SB(1, 1), b3 + hstepB, voffB); PG8_STAGE(PG8_SA(1, 0), a3, voffA);
            PG8_WAIT_V(8); PG8_WAIT_L(0); PG8_BAR; PG8_MMA(1, 0, At, B0); PG8_MMA(1, 1, At, B1); PG8_BAR; PG8_SCHED;
            } else {
            PG8_LDB(B0, 0, 0); PG8_SCHED; PG8_LDA(At, 0, 0); PG8_STAGE(PG8_SA(1, 1), a1 + hstepA, voffA);
            PG8_WAIT_L(8); PG8_BAR; PG8_WAIT_L(0); PG8_MMA(0, 0, At, B0); PG8_BAR; PG8_SCHED;
            PG8_LDB(B1, 0, 1); PG8_STAGE(PG8_SB(0, 0), b2, voffB);
            PG8_BAR; PG8_WAIT_L(0); PG8_MMA(0, 1, At, B1); PG8_BAR;
            PG8_LDA(At, 0, 1); PG8_STAGE(PG8_SA(0, 0), a2, voffA);
            PG8_BAR; PG8_WAIT_L(0); PG8_MMA(1, 0, At, B0); PG8_BAR; PG8_SCHED;
            PG8_STAGE(PG8_SB(0, 1), b2 + hstepB, voffB);
            PG8_WAIT_V(6); PG8_BAR; PG8_MMA(1, 1, At, B1); PG8_BAR;
            PG8_LDB(B0, 1, 0); PG8_SCHED; PG8_LDA(At, 1, 0); PG8_STAGE(PG8_SA(0, 1), a2 + hstepA, voffA);
            PG8_WAIT_L(8); PG8_BAR; PG8_WAIT_L(0); PG8_MMA(0, 0, At, B0); PG8_BAR; PG8_SCHED;
            PG8_LDB(B1, 1, 1); PG8_STAGE(PG8_SB(1, 0), b3, voffB);
            PG8_BAR; PG8_WAIT_L(0); PG8_MMA(0, 1, At, B1); PG8_BAR;
            PG8_LDA(At, 1, 1); PG8_STAGE(PG8_SA(1, 0), a3, voffA);
            PG8_BAR; PG8_WAIT_L(0); PG8_MMA(1, 0, At, B0); PG8_BAR; PG8_SCHED;
            PG8_STAGE(PG8_SB(1, 1), b3 + hstepB, voffB);
            PG8_WAIT_V(6); PG8_BAR; PG8_MMA(1, 1, At, B1); PG8_BAR;
            }
        }
        if constexpr (ALIGN_EPI) { if (wr == 0) PG8_BAR; }
        if constexpr (!Epi::AFTER_DRAIN) { E(acc, cur, wr, wc, fr, fq); S.done(cur); }
        if (!has_next) break;
#pragma unroll
        for (int a = 0; a < 2; ++a)
#pragma unroll
            for (int b = 0; b < 2; ++b)
#pragma unroll
                for (int m = 0; m < 4; ++m)
#pragma unroll
                    for (int n = 0; n < 2; ++n) acc[a][b][m][n] = (f32x4){0.f, 0.f, 0.f, 0.f};
        cur = nxt; cA = nA; cB = nB; ++ui;
        if constexpr (ALIGN_EPI) { if (wr == 1) PG8_BAR; }
    }
    PG8_WAIT_V(0);
    if constexpr (!ALIGN_EPI) { if (wr == 0) PG8_BAR; }
    PG8_BAR;
    if constexpr (Epi::AFTER_DRAIN) { E.fused(acc, cur, wr, wc, fr, fq, lds, wid, lane); S.done(cur); }
#undef PG8_SA
#undef PG8_SB
#undef PG8_STAGE
#undef PG8_LDA
#undef PG8_LDB
#undef PG8_MMA
#undef PG8_WAIT_V
#undef PG8_WAIT_L
#undef PG8_BAR
#undef PG8_SCHED
}
}

namespace epi {
using pg8::Unit; using pg8::HALF; using pg8::BM;

DI void store_bf16_tile(const f32x4 (&acc)[2][2][4][2], bf16_t* base, int ld, int row0, int col0) {
#pragma unroll
    for (int ai = 0; ai < 2; ++ai)
#pragma unroll
        for (int m = 0; m < 4; ++m) { bf16_t* rowp = base + (size_t)(row0 + ai * HALF + m * 16) * ld + col0;
#pragma unroll
            for (int bj = 0; bj < 2; ++bj) { const f32x4 v0 = acc[ai][bj][m][0], v1 = acc[ai][bj][m][1];
                u32x4 w; w.x = pk2(v0[0], v0[1]); w.y = pk2(v0[2], v0[3]); w.z = pk2(v1[0], v1[1]); w.w = pk2(v1[2], v1[3]);
                *(u32x4*)(rowp + bj * HALF) = w; } }
}

struct EpiE0 {
    static constexpr bool PERM = true, AFTER_DRAIN = false;
    bf16_t* zab; bf16_t* xbcraw; bf16_t* xb; float* dtraw;
    DI void operator()(const f32x4 (&acc)[2][2][4][2], const Unit& u, int wr, int wc, int fr, int fq) const {
        const int pn = u.pn, row0 = u.pm * BM + wr * 64 + fr;
        bf16_t* base; int ld, colt;
        if (pn < 4) { base = zab; ld = 2048; colt = pn * 256; }
        else if (pn < 12) { base = xbcraw; ld = 2048; colt = (pn - 4) * 256; }
        else if (pn < 16) { base = zab; ld = 2048; colt = 1024 + (pn - 12) * 256; }
        else if (pn < 20) { base = xb; ld = 1024; colt = (pn - 16) * 256; }
        else {
            if (wc == 0) {
#pragma unroll
                for (int ai = 0; ai < 2; ++ai)
#pragma unroll
                    for (int m = 0; m < 4; ++m) { float* p = dtraw + (size_t)(row0 + ai * HALF + m * 16) * 32 + 8 * fq;
                        *(f32x4*)p = acc[ai][0][m][0]; *(f32x4*)(p + 4) = acc[ai][0][m][1]; }
            }
            return;
        }
        store_bf16_tile(acc, base, ld, row0, colt + wc * 32 + 8 * fq);
    }
};
struct EpiO {
    static constexpr bool PERM = true, AFTER_DRAIN = false;
    bf16_t* u1; const float* rope; int grow0;
    DI void operator()(const f32x4 (&acc)[2][2][4][2], const Unit& u, int wr, int wc, int fr_, int fq_) const {
        int lane; asm volatile("v_mbcnt_lo_u32_b32 %0, -1, 0\n\tv_mbcnt_hi_u32_b32 %0, -1, %0" : "=v"(lane));
        const int fr = lane & 15, fq = lane >> 4;
        const int gr0 = grow0 + u.pm * BM, pn = u.pn;
        const bool rot = gr0 >= R_CTX && (pn < 8 || (pn >= 16 && pn <= 20));
        const int rl0 = u.pm * BM + wr * 64 + fr, col0 = pn * 256 + wc * 32 + 8 * fq;
        if (!rot) { store_bf16_tile(acc, u1, N_O, rl0, col0); return; }
        const int axis = wc & 1;
        const bool upper = lane >= 32;
        const float sgn = upper ? 1.f : -1.f;
#pragma unroll
        for (int ai = 0; ai < 2; ++ai)
#pragma unroll
            for (int m = 0; m < 4; ++m) {
                const int rl = rl0 + ai * HALF + m * 16;
                const int t = (grow0 + rl - R_CTX) & 4095, pos = axis ? (t & 63) : (t >> 6);
                const float* cp = rope + pos * 16 + 8 * (fq & 1);
                const f32x4 c0 = *(const f32x4*)cp, c1 = *(const f32x4*)(cp + 4), s0 = *(const f32x4*)(cp + 1024) * sgn, s1 = *(const f32x4*)(cp + 1028) * sgn;
                bf16_t* rowp = u1 + (size_t)rl * N_O + col0;
#pragma unroll
                for (int bj = 0; bj < 2; ++bj) {
                    f32x4 o[2];
#pragma unroll
                    for (int n = 0; n < 2; ++n) { const f32x4 own = acc[ai][bj][m][n]; f32x4 par;
#pragma unroll
                        for (int q = 0; q < 4; ++q) { auto rr = __builtin_amdgcn_permlane32_swap(__float_as_uint(own[q]), __float_as_uint(own[q]), false, false); par[q] = __uint_as_float(upper ? rr[0] : rr[1]); }
                        o[n] = own * (n ? c1 : c0) + par * (n ? s1 : s0); }
                    u32x4 w; w.x = pk2(o[0][0], o[0][1]); w.y = pk2(o[0][2], o[0][3]); w.z = pk2(o[1][0], o[1][1]); w.w = pk2(o[1][2], o[1][3]);
                    *(u32x4*)(rowp + bj * HALF) = w;
                }
            }
    }
};
struct EpiPool {
    static constexpr bool PERM = true, AFTER_DRAIN = false;
    bf16_t* aout; const bf16_t* zab; const float* ssy;
    DI void operator()(const f32x4 (&acc)[2][2][4][2], const Unit& u, int wr, int wc, int fr_, int fq_) const {
        int lane; asm volatile("v_mbcnt_lo_u32_b32 %0, -1, 0\n\tv_mbcnt_hi_u32_b32 %0, -1, %0" : "=v"(lane));
        const int fr = lane & 15, fq = lane >> 4;
        const int row0 = u.pm * BM + wr * 64 + fr, col0 = u.pn * 256 + wc * 32 + 8 * fq;
#pragma unroll
        for (int ai = 0; ai < 2; ++ai)
#pragma unroll
            for (int m = 0; m < 4; ++m) { const size_t r = (size_t)(row0 + ai * HALF + m * 16); const float irs = sqrtf(ssy[r] * (1.f / 1024.f) + EPS);
#pragma unroll
                for (int bj = 0; bj < 2; ++bj) {
                    const size_t off = r * 2048 + 1024 + col0 + bj * HALF;
                    const u32x4 z = *(const u32x4*)(zab + off);
                    const f32x4 v0 = acc[ai][bj][m][0] * irs, v1 = acc[ai][bj][m][1] * irs;
                    u32x4 w; w.x = pk2(v0[0] * silu_f(lo_f(z.x)), v0[1] * silu_f(hi_f(z.x))); w.y = pk2(v0[2] * silu_f(lo_f(z.y)), v0[3] * silu_f(hi_f(z.y)));
                    w.z = pk2(v1[0] * silu_f(lo_f(z.z)), v1[1] * silu_f(hi_f(z.z))); w.w = pk2(v1[2] * silu_f(lo_f(z.w)), v1[3] * silu_f(hi_f(z.w)));
                    *(u32x4*)(aout + off) = w;
                    asm volatile("" ::: "memory"); } }
    }
};
template <bool L0>
struct EpiRes {
    static constexpr bool PERM = true, AFTER_DRAIN = false;
    const float* xp; const float* xs;
    float* out;
    const float* modl;
    int grow0;
    const float* ssy;
    bf16_t* x1b;
    bf16_t* x2b;
    DI void operator()(const f32x4 (&acc)[2][2][4][2], const Unit& u, int wr, int wc, int fr_, int fq_) const {
        int lane; asm volatile("v_mbcnt_lo_u32_b32 %0, -1, 0\n\tv_mbcnt_hi_u32_b32 %0, -1, %0" : "=v"(lane));
        const int fr = lane & 15, fq = lane >> 4;
        const int gr0 = grow0 + u.pm * BM;
        const int g = gr0 < R_CTX ? 8 : ((gr0 - R_CTX) >> 12);
        const float* gate = modl + g * 3072 + 2048;
        const int col0 = u.pn * 256 + wc * 32 + 8 * fq, rl = wr * 64 + fr;
        f32x4 gv[2][2];
#pragma unroll
        for (int bj = 0; bj < 2; ++bj) { gv[bj][0] = *(const f32x4*)(gate + col0 + bj * HALF); gv[bj][1] = *(const f32x4*)(gate + col0 + bj * HALF + 4); }
#pragma unroll
        for (int ai = 0; ai < 2; ++ai)
#pragma unroll
            for (int m = 0; m < 4; ++m) { const int rt = rl + ai * HALF + m * 16; const size_t loff = (size_t)(u.pm * BM + rt) * DM + col0;
                float rs = 1.f; if (L0) rs = rsqrtf(ssy[u.pm * BM + rt] * (1.f / 1024.f) + EPS);
#pragma unroll
                for (int bj = 0; bj < 2; ++bj) {
                    f32x4 x0, x1;
                    if (L0) { const float* xin = (gr0 < R_CTX ? xp + (size_t)gr0 * DM : xs + (size_t)(gr0 - R_CTX) * DM) + (size_t)rt * DM + col0 + bj * HALF;
                        x0 = *(const f32x4*)xin; x1 = *(const f32x4*)(xin + 4); }
                    else { const u32x4 xb = *(const u32x4*)(x1b + loff + bj * HALF); x0 = (f32x4){lo_f(xb.x), hi_f(xb.x), lo_f(xb.y), hi_f(xb.y)}; x1 = (f32x4){lo_f(xb.z), hi_f(xb.z), lo_f(xb.w), hi_f(xb.w)}; }
                    const f32x4 y0 = x0 + gv[bj][0] * (acc[ai][bj][m][0] * rs), y1 = x1 + gv[bj][1] * (acc[ai][bj][m][1] * rs);
                    u32x4 w; w.x = pk2(y0[0], y0[1]); w.y = pk2(y0[2], y0[3]); w.z = pk2(y1[0], y1[1]); w.w = pk2(y1[2], y1[3]);
                    *(u32x4*)((L0 ? x1b : x2b) + loff + bj * HALF) = w;
                }
                asm volatile("" ::: "memory"); }
    }
};
}
struct Params { const float* in[28]; float* out; unsigned char* ws; int ph_lo, ph_hi; };
struct Frame {
    ldsp lds; int tid, lane, wave, G, bid;
    const Params& p; float* out; unsigned char* ws; int probe;
};
enum { I_XP = 0, I_XS, I_SSDF, I_SSDB, I_CDK, I_CDV, I_CWK, I_CWV, I_C, I_CCTX, I_WADA, I_BADA, I_EWIN, I_ECONVW, I_ECONVB, I_EALOG, I_EDTB, I_ED, I_ENORMG,
       I_EPOOLW, I_EPOOLS, I_EWOUT, I_OWIN, I_OLAM, I_OSUBG, I_OSINK, I_OWOUT, I_FNORMG };

DI void transpose_item(const float* W, int ldw, int srcn0, int K, bf16_t* WT, int dstn0, int k0, LAS float* scr, int lane, const float* nscale = nullptr) {
    if (srcn0 >= 0) {
#pragma unroll 8
        for (int i = 0; i < 32; ++i) { const int kk = 2 * i + (lane >> 5); scr[kk * 33 + (lane & 31)] = W[(size_t)(k0 + kk) * ldw + srcn0 + (lane & 31)]; }
    } else {
#pragma unroll 8
        for (int i = 0; i < 32; ++i) { const int kk = 2 * i + (lane >> 5); scr[kk * 33 + (lane & 31)] = 0.f; }
    }
    asm volatile("s_waitcnt lgkmcnt(0)" ::: "memory");
    const int c = lane & 7;
#pragma unroll
    for (int j = 0; j < 4; ++j) { const int n = (lane >> 3) + 8 * j; const LAS float* s = scr + (8 * c) * 33 + n;
        const float sc = nscale ? nscale[n] : 1.f;
        u32x4 o; o.x = pk2(s[0 * 33] * sc, s[1 * 33] * sc); o.y = pk2(s[2 * 33] * sc, s[3 * 33] * sc); o.z = pk2(s[4 * 33] * sc, s[5 * 33] * sc); o.w = pk2(s[6 * 33] * sc, s[7 * 33] * sc);
        *(u32x4*)(WT + (size_t)(dstn0 + n) * K + k0 + 8 * c) = o; }
    asm volatile("s_waitcnt lgkmcnt(0)" ::: "memory");
}

DI void phase_p0(Frame& F) {
    if (F.bid < 192) {
        LAS float* sv = (LAS float*)F.lds;
        LAS float* red = (LAS float*)(F.lds + 40960);
        for (int i = F.tid; i < 9 * 1024; i += NTHREADS) { const int g = i >> 10, k = i & 1023; const float v = g < 8 ? F.p.in[I_C][g * 1024 + k] : F.p.in[I_CCTX][k]; sv[i] = silu_f(v); }
        __syncthreads();
        const int l = F.bid / 96, n0 = (F.bid % 96) * 32, kg = F.tid >> 5, c = F.tid & 31;
        const float* w = F.p.in[I_WADA] + (size_t)l * 1024 * 3072 + n0 + c;
        float acc[9];
#pragma unroll
        for (int g = 0; g < 9; ++g) acc[g] = 0.f;
#pragma unroll 4
        for (int kk = 0; kk < 64; ++kk) { const int k = kg * 64 + kk; const float wv = w[(size_t)k * 3072];
#pragma unroll
            for (int g = 0; g < 9; ++g) acc[g] += sv[g * 1024 + k] * wv; }
#pragma unroll
        for (int g = 0; g < 9; ++g) red[(kg * 9 + g) * 32 + c] = acc[g];
        __syncthreads();
        if (F.tid < 288) { const int g = F.tid >> 5, cc = F.tid & 31; float s = F.p.in[I_BADA][l * 3072 + n0 + cc];
#pragma unroll
            for (int q = 0; q < 16; ++q) s += red[(q * 9 + g) * 32 + cc];
            ((float*)(F.ws + WS_MOD))[(l * 9 + g) * 3072 + n0 + cc] = s; }
        __syncthreads();
    }
    if (F.bid == F.G - 1) {
        float* rc = (float*)(F.ws + WS_ROPE); float* rs = rc + 1024;
        for (int i = F.tid; i < 1024; i += NTHREADS) { const int pos = i >> 4, f = i & 15; const float inv = __builtin_amdgcn_exp2f(-(float)f * (13.287712379549449f / 16.f)); const float ang = (float)pos * inv; rc[i] = __cosf(ang); rs[i] = __sinf(ang); }
        if (F.tid == 0) { const float* lp = F.p.in[I_OLAM]; float s1 = 0.f, s2 = 0.f;
            for (int i = 0; i < 64; ++i) { s1 += lp[i] * lp[64 + i]; s2 += lp[128 + i] * lp[192 + i]; }
            float lam_init = 0.8f - 0.6f * 0.7408182206817179f; asm volatile("" : "+v"(lam_init));
            float* o = (float*)(F.ws + WS_LAM); o[0] = __expf(s1) - __expf(s2) + lam_init; o[1] = 1.f - lam_init; }
    }
    {
        LAS float* scr = (LAS float*)(F.lds + 65536 + F.wave * 8704);
        const int gw = F.bid * NWAVES + F.wave, NGW = F.G * NWAVES;
        for (int it = gw; it < 8192; it += NGW) {
            int r = it;
            if (r < 2688) { const int kb = r / 168, nb = r % 168; int src;
                if (nb < 96) src = nb * 32; else if (nb < 160) src = (nb + 1) * 32; else if (nb == 160) src = 3072; else src = -1;
                transpose_item(F.p.in[I_EWIN], 5152, src, 1024, (bf16_t*)(F.ws + WS_WT_IN_E), nb * 32, kb * 64, scr, F.lane); continue; }
            r -= 2688;
            if (r < 1024) { const int kb = r >> 5, nb = r & 31; transpose_item(F.p.in[I_EWOUT], 1024, nb * 32, 2048, (bf16_t*)(F.ws + WS_WT_OUT_E), nb * 32, kb * 64, scr, F.lane); continue; }
            r -= 1024;
            if (r < 3328) { const int kb = r / 208, nb = r % 208; transpose_item(F.p.in[I_OWIN], N_O, nb * 32, 1024, (bf16_t*)(F.ws + WS_WT_IN_O), nb * 32, kb * 64, scr, F.lane); continue; }
            r -= 3328;
            if (r < 1024) { const int kb = r >> 5, nb = r & 31; transpose_item(F.p.in[I_OWOUT], 1024, nb * 32, 2048, (bf16_t*)(F.ws + WS_WT_OUT_O), nb * 32, kb * 64, scr, F.lane); continue; }
            r -= 1024;
            { const int g = r >> 5, q = r & 31, kb = q >> 3, nb = q & 7;
              transpose_item(F.p.in[I_EPOOLW] + (size_t)g * 65536, 256, nb * 32, 256, (bf16_t*)(F.ws + WS_WT_POOL) + (size_t)g * 65536, nb * 32, kb * 64, scr, F.lane, F.p.in[I_EPOOLS] + g * 256 + nb * 32); }
        }
    }
    {
        const int gt = F.bid * NTHREADS + F.tid, NT = F.G * NTHREADS;
        for (int it = gt; it < 1310720; it += NT) {
            const float* src; bf16_t* dst; int o = it;
            if (o < 524288) { src = F.p.in[I_CDK]; dst = (bf16_t*)(F.ws + WS_CK); }
            else if (o < 1048576) { o -= 524288; src = F.p.in[I_CDV]; dst = (bf16_t*)(F.ws + WS_CV); }
            else if (o < 1179648) { o -= 1048576; src = F.p.in[I_CWK]; dst = (bf16_t*)(F.ws + WS_WK); }
            else { o -= 1179648; src = F.p.in[I_CWV]; dst = (bf16_t*)(F.ws + WS_WV); }
            const f32x4 a = *(const f32x4*)(src + (size_t)o * 8), b = *(const f32x4*)(src + (size_t)o * 8 + 4);
            u32x4 w; w.x = pk2(a[0], a[1]); w.y = pk2(a[2], a[3]); w.z = pk2(b[0], b[1]); w.w = pk2(b[2], b[3]);
            *(u32x4*)(dst + (size_t)o * 8) = w;
        }
    }
}

DI void phase_modnorm(Frame& F, int grp, int layer) {
    const int row0 = GRP_ROW0[grp], rows = GRP_ROWS[grp];
    const int gw = F.bid * NWAVES + F.wave, NGW = F.G * NWAVES;
    const float* mod = (const float*)(F.ws + WS_MOD) + layer * 9 * 3072;
    bf16_t* H = (bf16_t*)(F.ws + WS_REGA);
    for (int rl = gw; rl < rows; rl += 2 * NGW) {
        f32x4 v[2][4]; float s[2];
#pragma unroll
        for (int q = 0; q < 2; ++q) { const int grow = row0 + min(rl + q * NGW, rows - 1);
            if (layer == 0) { const float* xrow = grow < R_CTX ? F.p.in[I_XP] + (size_t)grow * DM : F.p.in[I_XS] + (size_t)(grow - R_CTX) * DM;
                const f32x4* xr = (const f32x4*)xrow + F.lane;
#pragma unroll
                for (int j = 0; j < 4; ++j) v[q][j] = xr[64 * j]; }
            else { const u32x2* xr = (const u32x2*)((const bf16_t*)(F.ws + WS_X1B) + (size_t)(grow - row0) * DM) + F.lane;
#pragma unroll
                for (int j = 0; j < 4; ++j) { const u32x2 w = xr[64 * j]; v[q][j] = (f32x4){lo_f(w.x), hi_f(w.x), lo_f(w.y), hi_f(w.y)}; } } }
#pragma unroll
        for (int q = 0; q < 2; ++q) { float t = 0.f;
#pragma unroll
            for (int j = 0; j < 4; ++j) t += (v[q][j].x * v[q][j].x + v[q][j].y * v[q][j].y) + (v[q][j].z * v[q][j].z + v[q][j].w * v[q][j].w);
            s[q] = t; }
#pragma unroll
        for (int o = 1; o < 64; o <<= 1) { s[0] += shfl_idx(s[0], F.lane ^ o); s[1] += shfl_idx(s[1], F.lane ^ o); }
#pragma unroll
        for (int q = 0; q < 2; ++q) { const int rq = min(rl + q * NGW, rows - 1), grow = row0 + rq; const RowInfo ri = rowinfo(grow);
            const float rstd = rsqrtf(s[q] * (1.f / DM) + EPS);
            const float* sh = mod + ri.g * 3072; const float* sc = sh + 1024;
            u32x2* o8 = (u32x2*)(H + (size_t)rq * DM) + F.lane;
#pragma unroll
            for (int j = 0; j < 4; ++j) { const f32x4 a = *((const f32x4*)sh + F.lane + 64 * j), b = *((const f32x4*)sc + F.lane + 64 * j);
                const f32x4 y = v[q][j] * rstd * (b + 1.f) + a; u32x2 w; w.x = pk2(y.x, y.y); w.y = pk2(y.z, y.w); o8[64 * j] = w; } }
    }
}

DI float softplus_f(float x) { return x > 15.f ? x : (x < -15.f ? __expf(x) : __logf(1.f + __expf(x))); }
DI void acc8(float (&s)[8], const u32x4 xv, const float sg) {
    s[0] += sg * lo_f(xv.x); s[1] += sg * hi_f(xv.x); s[2] += sg * lo_f(xv.y); s[3] += sg * hi_f(xv.y); s[4] += sg * lo_f(xv.z); s[5] += sg * hi_f(xv.z); s[6] += sg * lo_f(xv.w); s[7] += sg * hi_f(xv.w);
}
template <int W>
DI void pool_task(const bf16_t* xp, bf16_t* op, const int t0, const int T) {
    constexpr int LEFT = W / 2, RIGHT = W - 1 - LEFT, S = 16, NR = S + W - 1;
    const u32x4 zero4 = {0u, 0u, 0u, 0u};
    u32x4 r[NR];
#pragma unroll
    for (int k = 0; k < NR; ++k) { const int pos = t0 - LEFT + k; r[k] = (pos >= 0 && pos < T) ? *(const u32x4*)(xp + (ptrdiff_t)(k - LEFT) * 1024) : zero4; }
    float s[8];
#pragma unroll
    for (int e = 0; e < 8; ++e) s[e] = 0.f;
#pragma unroll
    for (int k = 0; k < W; ++k) acc8(s, r[k], 1.f);
#pragma unroll
    for (int i = 0; i < S; ++i) {
        const int t = t0 + i, lo = max(t - LEFT, 0), hi = min(t + RIGHT + 1, T);
        const float inv = 1.f / (float)(hi - lo);
        const u32x4 xs = r[i + LEFT];
        u32x4 o; o.x = pk2(s[0] * inv - lo_f(xs.x), s[1] * inv - hi_f(xs.x)); o.y = pk2(s[2] * inv - lo_f(xs.y), s[3] * inv - hi_f(xs.y));
        o.z = pk2(s[4] * inv - lo_f(xs.z), s[5] * inv - hi_f(xs.z)); o.w = pk2(s[6] * inv - lo_f(xs.w), s[7] * inv - hi_f(xs.w));
        *(u32x4*)(op + (size_t)i * 1024) = o;
        if (i + 1 < S) { acc8(s, r[i + W], 1.f); acc8(s, r[i], -1.f); }
    }
}
DI void phase_conv(Frame& F, int grp) {
    const int row0 = GRP_ROW0[grp], rows = GRP_ROWS[grp];
    const int gt = F.bid * NTHREADS + F.tid, NT = F.G * NTHREADS;
    { float* ssy = (float*)(F.ws + WS_SSY); float* ss1 = (float*)(F.ws + WS_SS1); for (int i = gt; i < rows; i += NT) { ssy[i] = 0.f; ss1[i] = 0.f; } }
    const bf16_t* xb = (const bf16_t*)(F.ws + WS_XB); bf16_t* pooled = (bf16_t*)(F.ws + WS_POOLED);
    const int nstrip = rows / 16;
    for (int task = gt; task < nstrip * 128; task += NT) {
        const int g = task / (nstrip * 32), rem = task - g * (nstrip * 32), strip = rem >> 5, c0 = g * 256 + (rem & 31) * 8, rl0 = strip * 16;
        const RowInfo ri = rowinfo(row0 + rl0);
        const bf16_t* xp = xb + (size_t)rl0 * 1024 + c0; bf16_t* op = pooled + (size_t)rl0 * 1024 + c0;
        if (g == 0) pool_task<2>(xp, op, ri.t, ri.T); else if (g == 1) pool_task<4>(xp, op, ri.t, ri.T); else if (g == 2) pool_task<8>(xp, op, ri.t, ri.T); else pool_task<16>(xp, op, ri.t, ri.T);
    }
    const float* dtraw = (const float*)(F.ws + WS_DTRAW); float* dtv = (float*)(F.ws + WS_DTV); float* acs = (float*)(F.ws + WS_ACS);
    const int nch = rows >> 7;
    LAS float* tot = (LAS float*)F.lds;
    for (int ci = F.bid; ci < nch; ci += F.G) {
        const int j = F.tid & 31, seg = F.tid >> 5; const size_t r0 = (size_t)ci * 128 + seg * 8;
        const float bias = F.p.in[I_EDTB][j], A = -__expf(F.p.in[I_EALOG][j]);
        float d[8], inc[8], run = 0.f;
#pragma unroll
        for (int i = 0; i < 8; ++i) d[i] = dtraw[(r0 + i) * 32 + j];
#pragma unroll
        for (int i = 0; i < 8; ++i) { d[i] = softplus_f(d[i] + bias); run += d[i] * A; inc[i] = run; }
        tot[seg * 32 + j] = run;
        __syncthreads();
        float before = 0.f, total = 0.f;
#pragma unroll
        for (int s = 0; s < 16; ++s) { const float v = tot[s * 32 + j]; total += v; before += s < seg ? v : 0.f; }
        __syncthreads();
#pragma unroll
        for (int i = 0; i < 8; ++i) { dtv[(r0 + i) * 32 + j] = d[i]; acs[(r0 + i) * 32 + j] = j < 16 ? inc[i] + before : total - (inc[i] + before) + d[i] * A; }
    }
}

DI void phase_bias1(Frame& F) {
    const bf16_t* wt = (const bf16_t*)(F.ws + WS_WT_IN_O); const float* mod1 = (const float*)(F.ws + WS_MOD) + 9 * 3072; float* b1 = (float*)(F.ws + WS_BIAS1);
    const int gw = F.bid * NWAVES + F.wave, NGW = F.G * NWAVES;
    for (int n = gw; n < N_O; n += NGW) {
        const u32x4 w0 = *(const u32x4*)(wt + (size_t)n * 1024 + F.lane * 16), w1 = *(const u32x4*)(wt + (size_t)n * 1024 + F.lane * 16 + 8);
        const float wv[16] = {lo_f(w0.x), hi_f(w0.x), lo_f(w0.y), hi_f(w0.y), lo_f(w0.z), hi_f(w0.z), lo_f(w0.w), hi_f(w0.w), lo_f(w1.x), hi_f(w1.x), lo_f(w1.y), hi_f(w1.y), lo_f(w1.z), hi_f(w1.z), lo_f(w1.w), hi_f(w1.w)};
#pragma unroll 1
        for (int g = 0; g < 9; ++g) { const float* sh = mod1 + g * 3072 + F.lane * 16; float s = 0.f;
#pragma unroll
            for (int q = 0; q < 4; ++q) { const f32x4 v = *(const f32x4*)(sh + 4 * q); s += (v.x * wv[4 * q] + v.y * wv[4 * q + 1]) + (v.z * wv[4 * q + 2] + v.w * wv[4 * q + 3]); }
            s = wave_sum(s, F.lane);
            if (F.lane == 0) b1[g * N_O + n] = s; }
    }
}
template <int NR = 8>
DI void conv_rows_to_lds(const bf16_t* xraw, const float* cw, const float* cb, int rbase, int t0, int T, int col0, int rb, ldsp dst, int dstride) {
    const bf16_t* xp = xraw + (size_t)(rbase + NR * rb) * 2048 + col0;
    const u32x4 zero4 = {0u, 0u, 0u, 0u};
    u32x4 r[NR + 4];
#pragma unroll
    for (int k = 0; k < NR + 4; ++k) { const int pos = t0 + NR * rb + k - 2; r[k] = (pos >= 0 && pos < T) ? *(const u32x4*)(xp + (ptrdiff_t)(k - 2) * 2048) : zero4; }
    float w[5][8], bias[8];
#pragma unroll
    for (int k = 0; k < 5; ++k) { const f32x4 w0 = *(const f32x4*)(cw + k * 2048 + col0), w1 = *(const f32x4*)(cw + k * 2048 + col0 + 4);
        w[k][0] = w0.x; w[k][1] = w0.y; w[k][2] = w0.z; w[k][3] = w0.w; w[k][4] = w1.x; w[k][5] = w1.y; w[k][6] = w1.z; w[k][7] = w1.w; }
    { const f32x4 b0 = *(const f32x4*)(cb + col0), b1 = *(const f32x4*)(cb + col0 + 4); bias[0] = b0.x; bias[1] = b0.y; bias[2] = b0.z; bias[3] = b0.w; bias[4] = b1.x; bias[5] = b1.y; bias[6] = b1.z; bias[7] = b1.w; }
#pragma unroll
    for (int i = 0; i < NR; ++i) {
        float acc[8];
#pragma unroll
        for (int e = 0; e < 8; ++e) acc[e] = bias[e];
#pragma unroll
        for (int k = 0; k < 5; ++k) { const u32x4 xv = r[i + k];
            acc[0] += lo_f(xv.x) * w[k][0]; acc[1] += hi_f(xv.x) * w[k][1]; acc[2] += lo_f(xv.y) * w[k][2]; acc[3] += hi_f(xv.y) * w[k][3];
            acc[4] += lo_f(xv.z) * w[k][4]; acc[5] += hi_f(xv.z) * w[k][5]; acc[6] += lo_f(xv.w) * w[k][6]; acc[7] += hi_f(xv.w) * w[k][7]; }
        u32x4 o; o.x = pk2(silu_f(acc[0]), silu_f(acc[1])); o.y = pk2(silu_f(acc[2]), silu_f(acc[3])); o.z = pk2(silu_f(acc[4]), silu_f(acc[5])); o.w = pk2(silu_f(acc[6]), silu_f(acc[7]));
        lds_st128(dst + (NR * rb + i) * dstride, o);
    }
}

DI void phase_states(Frame& F, int grp) {
    const int row0 = GRP_ROW0[grp], rows = GRP_ROWS[grp], nch = rows >> 7;
    const bf16_t* xraw = (const bf16_t*)(F.ws + WS_XBCRAW);
    const float* dtv = (const float*)(F.ws + WS_DTV); const float* acs = (const float*)(F.ws + WS_ACS);
    float* decay = (float*)(F.ws + WS_DECAY); bf16_t* states = (bf16_t*)(F.ws + WS_REGA);
    const ldsp Bimg = F.lds, ximg = F.lds + 40960, xw = F.lds + 114688; LAS float* wts = (LAS float*)(F.lds + 139264);
    const int lane = F.lane, h = lane >> 5, i16 = lane & 15, qq = i16 >> 2, pp = i16 & 3, blk = (lane >> 4) & 1;
    for (int unit = F.bid; unit < nch * 4; unit += F.G) {
        const int ci = unit >> 2, g = unit & 3, rbase = ci * 128;
        { const RowInfo ri = rowinfo(row0 + rbase);
          conv_rows_to_lds<8>(xraw, F.p.in[I_ECONVW], F.p.in[I_ECONVB], rbase, ri.t, ri.T, g * 256 + (F.tid & 31) * 8, F.tid >> 5, ximg + (F.tid & 31) * 16, 576);
          conv_rows_to_lds<4>(xraw, F.p.in[I_ECONVW], F.p.in[I_ECONVB], rbase, ri.t, ri.T, 1024 + g * 128 + (F.tid & 15) * 8, F.tid >> 4, Bimg + (F.tid & 15) * 16, 320); }
#pragma unroll
        for (int i = 0; i < 2; ++i) { const int v = F.tid + 512 * i, hd = v >> 7, l = v & 127, j = (hd >> 2) * 16 + g * 4 + (hd & 3);
            const float ref = acs[(size_t)(rbase + ((hd >> 2) ? 0 : 127)) * 32 + j];
            wts[v] = __expf(ref - acs[(size_t)(rbase + l) * 32 + j]) * dtv[(size_t)(rbase + l) * 32 + j]; }
        if (F.tid < 8) { const int hd = F.tid, j = (hd >> 2) * 16 + g * 4 + (hd & 3); decay[ci * 32 + j] = __expf(acs[(size_t)(rbase + ((hd >> 2) ? 0 : 127)) * 32 + j]); }
        __syncthreads();
        for (int hd = 0; hd < 8; ++hd) {
            const int r = hd & 3, j = (hd >> 2) * 16 + g * 4 + r;
            { const int l = F.tid >> 2, pq = F.tid & 3; const float w = wts[hd * 128 + l];
              const ldsp src = ximg + l * 576 + (r * 64 + pq * 16) * 2; const ldsp dst = xw + l * 192 + pq * 32;
#pragma unroll
              for (int q = 0; q < 2; ++q) { const u32x4 v = *(const LAS u32x4*)(src + q * 16); u32x4 o;
                  o.x = pk2(lo_f(v.x) * w, hi_f(v.x) * w); o.y = pk2(lo_f(v.y) * w, hi_f(v.y) * w); o.z = pk2(lo_f(v.z) * w, hi_f(v.z) * w); o.w = pk2(lo_f(v.w) * w, hi_f(v.w) * w);
                  lds_st128(dst + q * 16, o); } }
            __syncthreads();
            const int pt = F.wave >> 2, nt = F.wave & 3;
            f32x16 acc;
#pragma unroll
            for (int i = 0; i < 16; ++i) acc[i] = 0.f;
            const ldsp ab = xw + (8 * h + qq) * 192 + (pt * 32 + 16 * blk) * 2 + 8 * pp;
            const ldsp bb = Bimg + (8 * h + qq) * 320 + (nt * 32 + 16 * blk) * 2 + 8 * pp;
#pragma unroll
            for (int ks = 0; ks < 8; ++ks) {
                const bf16x8 a = cat8(lds_tr(ab + ks * 16 * 192), lds_tr(ab + ks * 16 * 192 + 4 * 192));
                const bf16x8 b = cat8(lds_tr(bb + ks * 16 * 320), lds_tr(bb + ks * 16 * 320 + 4 * 320));
                acc = MFMA32(a, b, acc);
            }
            bf16_t* so = states + ((size_t)(ci * 32 + j) * 64 + pt * 32) * 128 + nt * 32 + (lane & 31);
#pragma unroll
            for (int i = 0; i < 16; ++i) so[(size_t)crow(i, h) * 128] = f2bf(acc[i]);
            __syncthreads();
        }
    }
}

DI void phase_scan(Frame& F, int grp) {
    bf16_t* st = (bf16_t*)(F.ws + WS_REGA); const float* decay = (const float*)(F.ws + WS_DECAY);
    const int nlat = 4, nctx = grp == 0 ? 16 : 0;
    const int gt = F.bid * NTHREADS + F.tid, NT = F.G * NTHREADS;
    const int nitems = (nlat + nctx) * 32768;
    for (int it = gt; it < nitems; it += NT) {
        int seq, c0, nc, lat; int rem;
        if (it < nlat * 32768) { seq = it >> 15; rem = it & 32767; lat = 1; nc = 32; c0 = (grp == 0 ? 32 : 0) + 32 * seq; }
        else { const int o = it - nlat * 32768; seq = o >> 15; rem = o & 32767; lat = 0; nc = 2; c0 = 2 * seq; }
        const int j = rem >> 10, e = (rem & 1023) * 8, dir = j >> 4, head = j & 15;
        float hv[8];
        if (lat) { const int b = grp * 4 + seq; const float* s0 = (dir ? F.p.in[I_SSDB] : F.p.in[I_SSDF]) + (size_t)(b * 16 + head) * 8192 + e;
            const f32x4 a = *(const f32x4*)s0, bq = *(const f32x4*)(s0 + 4); hv[0] = a.x; hv[1] = a.y; hv[2] = a.z; hv[3] = a.w; hv[4] = bq.x; hv[5] = bq.y; hv[6] = bq.z; hv[7] = bq.w; }
        else {
#pragma unroll
            for (int i = 0; i < 8; ++i) hv[i] = 0.f; }
        const int cs = dir ? -1 : 1, cb = c0 + (dir ? nc - 1 : 0);
        u32x4 win[4]; float dwin[4];
#pragma unroll
        for (int q = 0; q < 4; ++q) if (q < nc) { const int c = cb + cs * q; win[q] = *(const u32x4*)(st + (size_t)(c * 32 + j) * 8192 + e); dwin[q] = decay[c * 32 + j]; }
        for (int k0 = 0; k0 < nc; k0 += 4) {
#pragma unroll
            for (int q = 0; q < 4; ++q) {
                const int k = k0 + q;
                if (k < nc) {
                    const int c = cb + cs * k;
                    bf16_t* p = st + (size_t)(c * 32 + j) * 8192 + e;
                    const u32x4 sv = win[q]; const float d = dwin[q];
                    if (k + 4 < nc) { const int cn = cb + cs * (k + 4); win[q] = *(const u32x4*)(st + (size_t)(cn * 32 + j) * 8192 + e); dwin[q] = decay[cn * 32 + j]; }
                    u32x4 o; o.x = pk2(hv[0], hv[1]); o.y = pk2(hv[2], hv[3]); o.z = pk2(hv[4], hv[5]); o.w = pk2(hv[6], hv[7]);
                    *(u32x4*)p = o;
                    hv[0] = hv[0] * d + lo_f(sv.x); hv[1] = hv[1] * d + hi_f(sv.x); hv[2] = hv[2] * d + lo_f(sv.y); hv[3] = hv[3] * d + hi_f(sv.y);
                    hv[4] = hv[4] * d + lo_f(sv.z); hv[5] = hv[5] * d + hi_f(sv.z); hv[6] = hv[6] * d + lo_f(sv.w); hv[7] = hv[7] * d + hi_f(sv.w);
                }
            }
        }
        if (!lat) { float* o = F.out + (dir ? OUT_SSD_B : OUT_SSD_F) + (size_t)(seq * 16 + head) * 8192 + e;
            *(f32x4*)o = (f32x4){hv[0], hv[1], hv[2], hv[3]}; *(f32x4*)(o + 4) = (f32x4){hv[4], hv[5], hv[6], hv[7]}; }
    }
}

DI void phase_y(Frame& F, int grp) {
    const int row0 = GRP_ROW0[grp], rows = GRP_ROWS[grp], nch = rows >> 7;
    const bf16_t* xraw = (const bf16_t*)(F.ws + WS_XBCRAW);
    const float* dtv = (const float*)(F.ws + WS_DTV); const float* acs = (const float*)(F.ws + WS_ACS);
    const bf16_t* hprev = (const bf16_t*)(F.ws + WS_REGA);
    const bf16_t* zab = (const bf16_t*)(F.out + OUT_X + (size_t)row0 * DM);
    bf16_t* aout = (bf16_t*)(F.ws + WS_AOUT);
    const ldsp Bimg = F.lds, Cimg = F.lds + 34816, ximg = F.lds + 69632; LAS float* arr = (LAS float*)(F.lds + 143360);
    const int lane = F.lane, h = lane >> 5, r32 = lane & 31, i16 = lane & 15, qq = i16 >> 2, pp = i16 & 3, blk = (lane >> 4) & 1;
    const int lt = F.wave & 3, pt = F.wave >> 2;
    for (int unit = F.bid; unit < nch * 4; unit += F.G) {
        const int ci = unit >> 2, g = unit & 3, rbase = ci * 128;
        { const RowInfo ri = rowinfo(row0 + rbase);
#pragma unroll 1
          for (int id = F.tid; id < 1024; id += 512) { const int chunk = id & 63, rb = id >> 6;
              if (chunk < 16) conv_rows_to_lds(xraw, F.p.in[I_ECONVW], F.p.in[I_ECONVB], rbase, ri.t, ri.T, 1024 + g * 128 + chunk * 8, rb, Bimg + chunk * 16, 272);
              else if (chunk < 32) conv_rows_to_lds(xraw, F.p.in[I_ECONVW], F.p.in[I_ECONVB], rbase, ri.t, ri.T, 1536 + g * 128 + (chunk - 16) * 8, rb, Cimg + (chunk - 16) * 16, 272);
              else conv_rows_to_lds(xraw, F.p.in[I_ECONVW], F.p.in[I_ECONVB], rbase, ri.t, ri.T, g * 256 + (chunk - 32) * 8, rb, ximg + (chunk - 32) * 16, 576); } }
#pragma unroll
        for (int i = 0; i < 4; ++i) { const int v = F.tid + 512 * i, kind = v >> 9, r = (v >> 7) & 3, l = v & 127, j = (kind & 1) * 16 + g * 4 + r;
            arr[v] = (kind < 2 ? acs : dtv)[(size_t)(rbase + l) * 32 + j]; }
#pragma unroll
        for (int i = 0; i < 2; ++i) { const int v = F.tid + 512 * i, dirb = v >> 9, r = (v >> 7) & 3, sidx = v & 127, j = dirb * 16 + g * 4 + r;
            const int e = dirb ? (sidx & ~31) : (sidx | 31);
            arr[2048 + v] = __expf(acs[(size_t)(rbase + e) * 32 + j] - acs[(size_t)(rbase + sidx) * 32 + j]) * dtv[(size_t)(rbase + sidx) * 32 + j]; }
        __syncthreads();
        const int l = lt * 32 + r32;
        const ldsp cfp = Cimg + l * 272 + 8 * h * 2;
        const size_t rl = (size_t)(rbase + l);
        f32x16 cbt[4];
#pragma unroll
        for (int st = 0; st < 4; ++st) {
#pragma unroll
            for (int i = 0; i < 16; ++i) cbt[st][i] = 0.f;
            const ldsp bfp = Bimg + (st * 32 + r32) * 272 + 8 * h * 2;
#pragma unroll
            for (int ks = 0; ks < 8; ++ks) cbt[st] = MFMA32(lds_ld128(bfp + 32 * ks), lds_ld128(cfp + 32 * ks), cbt[st]);
        }
        __syncthreads();
#pragma unroll 1
        for (int r = 0; r < 4; ++r) {
            const int head = g * 4 + r;
            const bf16_t* hf = hprev + ((size_t)(ci * 32 + head) * 64 + pt * 32 + r32) * 128 + 8 * h;
            const bf16_t* hb = hf + (size_t)16 * 8192;
            bf16x8 hfv[8];
#pragma unroll
            for (int ks = 0; ks < 8; ++ks) hfv[ks] = *(const bf16x8*)(hf + 16 * ks);

            const float af_l = arr[(0 * 4 + r) * 128 + l], ab_l = arr[(1 * 4 + r) * 128 + l];
            f32x16 yd;
#pragma unroll
            for (int i = 0; i < 16; ++i) yd[i] = 0.f;
#pragma unroll
            for (int st = 0; st < 4; ++st) {
                const LAS float* as_ = arr + r * 128 + st * 32 + 4 * h;
                f32x16 gm;
                if (st < lt) {
                    const float rf = __expf(fminf(af_l - arr[(0 * 4 + r) * 128 + st * 32 + 31], 0.f));
#pragma unroll
                    for (int q = 0; q < 4; ++q) { const f32x4 cfv = *(const LAS f32x4*)(as_ + 4 * 512 + 8 * q);
#pragma unroll
                        for (int e = 0; e < 4; ++e) gm[4 * q + e] = cbt[st][4 * q + e] * (rf * cfv[e]); }
                } else if (st > lt) {
                    const float rf = __expf(fminf(ab_l - arr[(1 * 4 + r) * 128 + st * 32], 0.f));
#pragma unroll
                    for (int q = 0; q < 4; ++q) { const f32x4 cfv = *(const LAS f32x4*)(as_ + 5 * 512 + 8 * q);
#pragma unroll
                        for (int e = 0; e < 4; ++e) gm[4 * q + e] = cbt[st][4 * q + e] * (rf * cfv[e]); }
                } else {
                    int dq = r32 - 4 * h; asm volatile("" : "+v"(dq));
#pragma unroll
                    for (int i = 0; i < 16; ++i) { const int so = (i & 3) + 8 * (i >> 2);
                        const float ef = __expf(fminf(af_l - as_[so], 0.f)) * as_[2 * 512 + so];
                        const float eb = __expf(fminf(ab_l - as_[1 * 512 + so], 0.f)) * as_[3 * 512 + so];
                        gm[i] = cbt[st][i] * ((dq >= so ? ef : 0.f) + (dq <= so ? eb : 0.f)); }
                }
#pragma unroll
                for (int k2 = 0; k2 < 2; ++k2) {
                    const ldsp xa = ximg + (st * 32 + 16 * k2 + 4 * h + qq) * 576 + (r * 64 + pt * 32 + 16 * blk) * 2 + 8 * pp;
                    yd = MFMA32(cat8(lds_tr(xa), lds_tr(xa + 8 * 576)), pack8(gm, k2), yd);
                }
            }
            f32x16 tf, tb;
#pragma unroll
            for (int i = 0; i < 16; ++i) { tf[i] = 0.f; tb[i] = 0.f; }
#pragma unroll
            for (int ks = 0; ks < 8; ++ks) tf = MFMA32(hfv[ks], lds_ld128(cfp + 32 * ks), tf);
#pragma unroll
            for (int ks = 0; ks < 8; ++ks) tb = MFMA32(*(const bf16x8*)(hb + 16 * ks), lds_ld128(cfp + 32 * ks), tb);
            const float ef_l = __expf(af_l), eb_l = __expf(ab_l), Dh = F.p.in[I_ED][head];
            LAS float* ystg = (LAS float*)Bimg;
#pragma unroll
            for (int q4 = 0; q4 < 4; ++q4) {
                const int p0 = pt * 32 + 8 * q4 + 4 * h;
                const u32x2 xv = *(const LAS u32x2*)(ximg + l * 576 + (r * 64 + p0) * 2);
                f32x4 yv;
                yv[0] = yd[4 * q4 + 0] + tf[4 * q4 + 0] * ef_l + tb[4 * q4 + 0] * eb_l + Dh * lo_f(xv.x);
                yv[1] = yd[4 * q4 + 1] + tf[4 * q4 + 1] * ef_l + tb[4 * q4 + 1] * eb_l + Dh * hi_f(xv.x);
                yv[2] = yd[4 * q4 + 2] + tf[4 * q4 + 2] * ef_l + tb[4 * q4 + 2] * eb_l + Dh * lo_f(xv.y);
                yv[3] = yd[4 * q4 + 3] + tf[4 * q4 + 3] * ef_l + tb[4 * q4 + 3] * eb_l + Dh * hi_f(xv.y);
                *(LAS f32x4*)(ystg + l * 68 + p0) = yv;
            }
            __syncthreads();
            {
                const int row = F.tid >> 2, c16 = (F.tid & 3) * 16; const size_t rg = (size_t)(rbase + row);
                const u32x4 z0 = *(const u32x4*)(zab + rg * 2048 + head * 64 + c16), z1 = *(const u32x4*)(zab + rg * 2048 + head * 64 + c16 + 8);
                const unsigned zz[8] = {z0.x, z0.y, z0.z, z0.w, z1.x, z1.y, z1.z, z1.w};
                float ss = 0.f; unsigned ow[8];
#pragma unroll
                for (int q = 0; q < 4; ++q) { const f32x4 yv = *(const LAS f32x4*)(ystg + row * 68 + c16 + 4 * q); const f32x4 gn = *(const f32x4*)(F.p.in[I_ENORMG] + head * 64 + c16 + 4 * q);
                    const float v0 = yv[0] * silu_f(lo_f(zz[2 * q])), v1 = yv[1] * silu_f(hi_f(zz[2 * q])), v2 = yv[2] * silu_f(lo_f(zz[2 * q + 1])), v3 = yv[3] * silu_f(hi_f(zz[2 * q + 1]));
                    ss += (v0 * v0 + v1 * v1) + (v2 * v2 + v3 * v3);
                    ow[2 * q] = pk2(v0 * gn.x, v1 * gn.y); ow[2 * q + 1] = pk2(v2 * gn.z, v3 * gn.w); }
                *(u32x4*)(aout + rg * 2048 + head * 64 + c16) = (u32x4){ow[0], ow[1], ow[2], ow[3]}; *(u32x4*)(aout + rg * 2048 + head * 64 + c16 + 8) = (u32x4){ow[4], ow[5], ow[6], ow[7]};
                ss += shfl_idx(ss, F.lane ^ 1); ss += shfl_idx(ss, F.lane ^ 2);
                if ((F.tid & 3) == 0 && !F.probe) atomicAdd((float*)(F.ws + WS_SSY) + rg, ss);
            }
            __syncthreads();
        }
        __syncthreads();
    }
}
DI void phase_cachecopy(Frame& F) {
    const bf16_t* u1 = (const bf16_t*)(F.ws + WS_U);
    const int gt = F.bid * NTHREADS + F.tid, NT = F.G * NTHREADS;
    for (int it = gt; it < R_CTX * 320; it += NT) {
        const int row = it / 320, ch = it - row * 320, b = row >> 8, t = row & 255;
        int col; float* o;
        if (ch < 128) { col = 1024 + ch * 8; o = F.out + OUT_DIFF_K + ((size_t)(b * 8 + (ch >> 4)) * 256 + t) * 128 + (ch & 15) * 8; }
        else if (ch < 256) { const int c2 = ch - 128; col = 2048 + c2 * 8; o = F.out + OUT_DIFF_V + ((size_t)(b * 8 + (c2 >> 4)) * 256 + t) * 128 + (c2 & 15) * 8; }
        else if (ch < 288) { const int c2 = ch - 256; col = 5120 + c2 * 8; o = F.out + OUT_WIN_K + ((size_t)(b * 4 + (c2 >> 3)) * 256 + t) * 64 + (c2 & 7) * 8; }
        else { const int c2 = ch - 288; col = 5376 + c2 * 8; o = F.out + OUT_WIN_V + ((size_t)(b * 4 + (c2 >> 3)) * 256 + t) * 64 + (c2 & 7) * 8; }
        const u32x4 v = *(const u32x4*)(u1 + (size_t)row * N_O + col);
        *(f32x4*)o = (f32x4){lo_f(v.x), hi_f(v.x), lo_f(v.y), hi_f(v.y)}; *(f32x4*)(o + 4) = (f32x4){lo_f(v.z), hi_f(v.z), lo_f(v.w), hi_f(v.w)};
    }
}

struct AttnSeg { unsigned k, v; int ldk, ldv, nt; };
struct AttnEpi { unsigned aout, z; float lam, oml; };

#ifndef ATT_LEAD
#define ATT_LEAD(w) ((w) < 4)
#endif
#ifndef ATT_PRIO
#define ATT_PRIO 0
#endif
constexpr float ATT_THR = 8.f;
#ifndef ATT_ROT
#define ATT_ROT(qb) (9 * ((qb) & 7))
#endif
#ifndef ATT_VD
#define ATT_VD 1
#endif
DI void glds16(const void* gsrc, unsigned lds_dst) { unsigned keep;
    asm volatile("s_mov_b32 %0, m0\n\ts_mov_b32 m0, %2\n\ts_nop 0\n\tglobal_load_lds_dwordx4 %1, off\n\ts_mov_b32 m0, %0" : "=&s"(keep) : "v"(gsrc), "s"(lds_dst) : "memory"); }
template <int DV, bool WIN> DI void attn_epilogue(Frame& F, f32x16 (&O)[DV / 32], float lsum, float m, float sink_l2, const AttnEpi E);
template <int DV, int KSLOTS, bool WIN, int PM = 0, bool QPRE = false>
DI void attn_unit(Frame& F, const unsigned qoff, const AttnSeg s0, const AttnSeg s1, int qpos0, int kpos1, bool maskwin, float sink_l2, const AttnEpi E, const int rot, u32x4 (&qpre)[4], const unsigned qnext, const bool more) {
    constexpr int KIMG = 8192, KSTAGE = KSLOTS * KIMG, VROW = DV * 2, VSTAGE = 64 * VROW, VBASE = 3 * KSTAGE, QBASE = VBASE + 4 * VSTAGE, NDV = DV / 32;
    constexpr int VD = ATT_VD;
    constexpr int VP = VSTAGE / 8192, OPS = KSLOTS + VP;
    int lane; asm volatile("v_mbcnt_lo_u32_b32 %0, -1, 0\n\tv_mbcnt_hi_u32_b32 %0, -1, %0" : "=v"(lane));
    const int wave = F.wave, slot = wave & 1, qb = wave >> 1;
    const int h = lane >> 5, r32 = lane & 31, i16 = lane & 15, qq = i16 >> 2, pp = i16 & 3, blk = (lane >> 4) & 1;
    const int NT = s0.nt + s1.nt;
    const unsigned lds0 = (unsigned)(uintptr_t)F.lds;
#define ATT_QF(d0) lds_ld128(qimg + (d0) * 32)
    const int dk_row = 8 * wave + (lane >> 3), dk_col = (((lane & 7) ^ ((dk_row >> 1) & 7)) * 8);
    const int dv_row = DV == 128 ? 4 * wave + (lane >> 4) : 8 * wave + (lane >> 3);
    const int dv_col = DV == 128 ? (((((lane & 15) >> 2) ^ (dv_row & 3)) * 32) + (lane & 3) * 8) : (((((lane & 7) >> 2) ^ ((dv_row >> 1) & 1)) * 32) + (lane & 3) * 8);
#define ATT_DMA(tt0, ks_, vs_) do { int tr_ = (tt0) + rot; tr_ = tr_ >= NT ? tr_ - NT : tr_; const bool in0 = tr_ < s0.nt; const int ldk_ = in0 ? s0.ldk : s1.ldk, ldv_ = in0 ? s0.ldv : s1.ldv; const int tl = in0 ? tr_ : tr_ - s0.nt; \
        const char* kb_ = (const char*)F.ws + (in0 ? s0.k : s1.k) + (size_t)tl * 128 * ldk_; const char* vb_ = (const char*)F.ws + (in0 ? s0.v : s1.v) + (size_t)tl * 128 * ldv_; \
        const unsigned ko_ = (unsigned)(dk_row * ldk_ + dk_col) * 2u; \
        _Pragma("unroll") for (int s_ = 0; s_ < KSLOTS; ++s_) glds16(kb_ + ko_ + s_ * 128, (unsigned)__builtin_amdgcn_readfirstlane((int)(lds0 + (ks_) * KSTAGE + s_ * KIMG + wave * 1024))); \
        const unsigned vo_ = (unsigned)(dv_row * ldv_ + dv_col) * 2u; \
        _Pragma("unroll") for (int j_ = 0; j_ < VP; ++j_) glds16(vb_ + (size_t)j_ * 64 * ldv_ + vo_, (unsigned)__builtin_amdgcn_readfirstlane((int)(lds0 + VBASE + (vs_) * VSTAGE + (wave + 8 * j_) * 1024))); } while (0)
#define ATT_VMWAIT(n) do { if ((n) == 4) asm volatile("s_waitcnt vmcnt(4)" ::: "memory"); else if ((n) == 2) asm volatile("s_waitcnt vmcnt(2)" ::: "memory"); else asm volatile("s_waitcnt vmcnt(0)" ::: "memory"); } while (0)
    int kro[4];
#pragma unroll
    for (int d0 = 0; d0 < 4; ++d0) kro[d0] = r32 * 128 + ((((2 * d0 + h) ^ ((r32 >> 1) & 7))) << 4);
    int vro[NDV];
#pragma unroll
    for (int d = 0; d < NDV; ++d) vro[d] = (4 * h + qq) * VROW + ((d ^ (DV == 128 ? qq : (qq >> 1))) * 64) + blk * 32 + pp * 8;
#define ATT_QK(P0, P1, ks_) do { const ldsp kimg_ = F.lds + (ks_) * KSTAGE + (KSLOTS == 2 ? slot * KIMG : 0); bf16x8 kf_[8]; \
        _Pragma("unroll") for (int d0 = 0; d0 < 4; ++d0) { kf_[2 * d0] = lds_ld128(kimg_ + kro[d0]); kf_[2 * d0 + 1] = lds_ld128(kimg_ + kro[d0] + 4096); } \
        __builtin_amdgcn_sched_barrier(0); \
        bf16x8 qf_[4]; _Pragma("unroll") for (int d0 = 0; d0 < 4; ++d0) qf_[d0] = ATT_QF(d0); \
        P0 = MFMA32(kf_[0], qf_[0], negm); P1 = MFMA32(kf_[1], qf_[0], negm); \
        _Pragma("unroll") for (int d0 = 1; d0 < 4; ++d0) { P0 = MFMA32(kf_[2 * d0], qf_[d0], P0); P1 = MFMA32(kf_[2 * d0 + 1], qf_[d0], P1); } \
        __builtin_amdgcn_sched_barrier(0); } while (0)
    ATT_DMA(0, 0, 0); ATT_DMA(1, 1, 1); ATT_DMA(2, 2, 2);
    const ldsp qimg = F.lds + QBASE + wave * (32 * 144) + r32 * 144 + h * 16;
    { const bf16_t* qp = (const bf16_t*)(F.ws + qoff) + (size_t)(qb * 32 + r32) * N_O + slot * 64 + 8 * h;
#pragma unroll
      for (int d0 = 0; d0 < 4; ++d0) { const u32x4 v = QPRE ? qpre[d0] : *(const u32x4*)(qp + 16 * d0); u32x4 o;
          o.x = pk2(lo_f(v.x) * C2, hi_f(v.x) * C2); o.y = pk2(lo_f(v.y) * C2, hi_f(v.y) * C2); o.z = pk2(lo_f(v.z) * C2, hi_f(v.z) * C2); o.w = pk2(lo_f(v.w) * C2, hi_f(v.w) * C2);
          lds_st128(qimg + d0 * 32, o); } }
    ATT_VMWAIT(OPS);
    bar_lds();
    f32x16 O[NDV];
#pragma unroll
    for (int d = 0; d < NDV; ++d)
#pragma unroll
        for (int i = 0; i < 16; ++i) O[d][i] = 0.f;
    float m = 0.f, lsum = 0.f;
    f32x16 negm;
#pragma unroll
    for (int i = 0; i < 16; ++i) negm[i] = 0.f;
    const int qpos = qpos0 + qb * 32 + r32;
    f32x16 pC0, pC1;
    ATT_QK(pC0, pC1, 0);
    {
        float rm = fmaxf(pC0[0], pC1[0]);
#pragma unroll
        for (int i = 1; i < 16; ++i) asm("v_max3_f32 %0, %0, %1, %2" : "+v"(rm) : "v"(pC0[i]), "v"(pC1[i]));
        { auto rr = __builtin_amdgcn_permlane32_swap(__float_as_uint(rm), __float_as_uint(rm), false, false); rm = fmaxf(__uint_as_float(rr[0]), __uint_as_float(rr[1])); }
        m = rm;
#pragma unroll
        for (int i = 0; i < 16; ++i) { pC0[i] = __builtin_amdgcn_exp2f(pC0[i] - rm); pC1[i] = __builtin_amdgcn_exp2f(pC1[i] - rm); negm[i] = -rm; }
    }
    bar_lds();
    bf16x8 qv[4];
#pragma unroll
    for (int d0 = 0; d0 < 4; ++d0) qv[d0] = ATT_QF(d0);
    int ks1 = 1, ks3 = 0, vs0 = 0, vs3 = 3;
    for (int tt = 0; tt < NT; ++tt) {
        f32x16 pN0, pN1;
        u32x4 w[4];
        {
            const ldsp kimg_ = F.lds + ks1 * KSTAGE + (KSLOTS == 2 ? slot * KIMG : 0);
#define ATT_KF(j) lds_ld128(kimg_ + kro[(j) >> 1] + ((j) & 1) * 4096)
            bf16x8 kf[8];
            kf[0] = ATT_KF(0); kf[1] = ATT_KF(1); kf[2] = ATT_KF(2);
            if (PM < 5 && tt + 3 < NT) ATT_DMA(tt + 3, ks3, vs3);
            asm volatile("" : "+v"(pC0), "+v"(pC1));
            __builtin_amdgcn_sched_barrier(0);
            float ps = 0.f;
#pragma unroll
            for (int j = 0; j < 8; ++j) {
                if (j + 3 < 8) kf[j + 3] = ATT_KF(j + 3);
                if (j & 1) pN1 = MFMA32(kf[j], qv[j >> 1], j < 2 ? negm : pN1); else pN0 = MFMA32(kf[j], qv[j >> 1], j < 2 ? negm : pN0);
                if (PM < 4) { ps += (pC0[2 * j] + pC0[2 * j + 1]) + (pC1[2 * j] + pC1[2 * j + 1]);
                w[j >> 2][j & 3] = pk2(pC0[2 * j], pC0[2 * j + 1]); w[2 + (j >> 2)][j & 3] = pk2(pC1[2 * j], pC1[2 * j + 1]); }
                else if (j == 0) { w[0] = __builtin_bit_cast(u32x4, (f32x4){pC0[0], pC0[1], pC0[2], pC0[3]}); w[1] = __builtin_bit_cast(u32x4, (f32x4){pC0[4], pC0[5], pC0[6], pC0[7]}); w[2] = __builtin_bit_cast(u32x4, (f32x4){pC1[0], pC1[1], pC1[2], pC1[3]}); w[3] = __builtin_bit_cast(u32x4, (f32x4){pC1[4], pC1[5], pC1[6], pC1[7]}); }
            }
#pragma unroll
            for (int j = 0; j < 8; ++j) { __builtin_amdgcn_sched_group_barrier(0x008, 1, 0); __builtin_amdgcn_sched_group_barrier(0x100, 1, 0); if (PM < 4) __builtin_amdgcn_sched_group_barrier(0x002, 6, 0); }
            asm volatile("" : "+v"(ps), "+v"(w[0]), "+v"(w[1]), "+v"(w[2]), "+v"(w[3]));
            __builtin_amdgcn_sched_barrier(0);
            lsum += ps;
#undef ATT_KF
        }
        const ldsp vb = F.lds + VBASE + vs0 * VSTAGE;
        bf16x8 vf[4][NDV];
#define ATT_VF(k4_, d_) (PM == 1 ? lds_ld128(vb + ((d_) * 32 + r32) * 128 + (((2 * (k4_) + h) ^ ((r32 >> 1) & 7)) << 4)) : cat8(lds_tr(vb + vro[d_] + (k4_) * 16 * VROW), lds_tr(vb + vro[d_] + (k4_) * 16 * VROW + 8 * VROW)))
#pragma unroll
        for (int k4 = 0; k4 < VD; ++k4)
#pragma unroll
            for (int d = 0; d < NDV; ++d) vf[k4][d] = ATT_VF(k4, d);
        bf16x8 pk[4];
        pk[0] = __builtin_bit_cast(bf16x8, w[0]); pk[1] = __builtin_bit_cast(bf16x8, w[1]); pk[2] = __builtin_bit_cast(bf16x8, w[2]); pk[3] = __builtin_bit_cast(bf16x8, w[3]);
        float fsc = 1.f; bool resc = false;
        if (PM < 4 && tt + 1 < NT) {
            if (WIN && maskwin && tt + 1 >= s0.nt) {
                const int kb = kpos1 + (tt + 1 - s0.nt) * 64;
#pragma unroll
                for (int i = 0; i < 16; ++i) { const int kp = kb + crow(i, h); int d = qpos - kp; d = d < 0 ? -d : d; if (d > 128) pN0[i] = -INFINITY; int d2 = qpos - kp - 32; d2 = d2 < 0 ? -d2 : d2; if (d2 > 128) pN1[i] = -INFINITY; }
            }
            float rm = fmaxf(pN0[0], pN1[0]), rm1, rm2, rm3;
            asm volatile("v_max_f32 %0, %1, %2" : "=v"(rm1) : "v"(pN0[1]), "v"(pN1[1]));
            asm volatile("v_max_f32 %0, %1, %2" : "=v"(rm2) : "v"(pN0[2]), "v"(pN1[2]));
            asm volatile("v_max_f32 %0, %1, %2" : "=v"(rm3) : "v"(pN0[3]), "v"(pN1[3]));
#pragma unroll
            for (int i = 4; i < 16; i += 4) {
                asm volatile("v_max3_f32 %0, %0, %1, %2" : "+v"(rm) : "v"(pN0[i]), "v"(pN1[i])); asm volatile("v_max3_f32 %0, %0, %1, %2" : "+v"(rm1) : "v"(pN0[i + 1]), "v"(pN1[i + 1]));
                asm volatile("v_max3_f32 %0, %0, %1, %2" : "+v"(rm2) : "v"(pN0[i + 2]), "v"(pN1[i + 2])); asm volatile("v_max3_f32 %0, %0, %1, %2" : "+v"(rm3) : "v"(pN0[i + 3]), "v"(pN1[i + 3])); }
            asm volatile("v_max_f32 %0, %0, %1" : "+v"(rm2) : "v"(rm3));
            asm volatile("v_max3_f32 %0, %0, %1, %2" : "+v"(rm) : "v"(rm1), "v"(rm2));
            { auto rr = __builtin_amdgcn_permlane32_swap(__float_as_uint(rm), __float_as_uint(rm), false, false); rm = fmaxf(__uint_as_float(rr[0]), __uint_as_float(rr[1])); }
            const float delta = rm > ATT_THR ? rm : 0.f;
            if (__any(delta != 0.f)) {
                resc = true; m += delta; fsc = __builtin_amdgcn_exp2f(-delta);
#pragma unroll
                for (int i = 0; i < 16; ++i) { pN0[i] -= delta; pN1[i] -= delta; negm[i] = -m; }
            }
        }
        {
            asm volatile("" : "+v"(pN0), "+v"(pN1));
            __builtin_amdgcn_sched_barrier(0);
            constexpr int EPG = 32 / (NDV * 4);
#pragma unroll
            for (int k4 = 0; k4 < 4; ++k4) {
#pragma unroll
                for (int d = 0; d < NDV; ++d) {
                    if (k4 + VD < 4) vf[k4 + VD][d] = ATT_VF(k4 + VD, d);
                    O[d] = MFMA32(vf[k4][d], pk[k4], O[d]);
#pragma unroll
                    for (int e = 0; e < EPG; ++e) { const int idx = (k4 * NDV + d) * EPG + e;
                        if (PM >= 4) continue; if (idx < 16) pN0[idx] = __builtin_amdgcn_exp2f(pN0[idx]); else pN1[idx - 16] = __builtin_amdgcn_exp2f(pN1[idx - 16]); }
                }
            }
#pragma unroll
            for (int g = 0; g < NDV * 4; ++g) { __builtin_amdgcn_sched_group_barrier(0x008, 1, 0); if (g < NDV * (4 - VD)) __builtin_amdgcn_sched_group_barrier(0x100, PM == 1 ? 1 : 2, 0); if (PM < 4) __builtin_amdgcn_sched_group_barrier(0x400, EPG, 0); }
            asm volatile("" : "+v"(pN0), "+v"(pN1));
            __builtin_amdgcn_sched_barrier(0);
        }
        if (resc) {
            lsum *= fsc;
#pragma unroll
            for (int d = 0; d < NDV; ++d)
#pragma unroll
                for (int i = 0; i < 16; ++i) O[d][i] *= fsc;
        }
        pC0 = pN0; pC1 = pN1;
        ks1 = ks1 == 2 ? 0 : ks1 + 1; ks3 = ks3 == 2 ? 0 : ks3 + 1; vs0 = (vs0 + 1) & 3; vs3 = (vs3 + 1) & 3;
        if (PM < 5 && tt + 3 < NT) ATT_VMWAIT(OPS); else ATT_VMWAIT(0);
        if (PM != 6) bar_lds();
    }
#undef ATT_DMA
#undef ATT_VMWAIT
#undef ATT_QK
#undef ATT_VF
#undef ATT_QF
    if (QPRE && more) { const bf16_t* qn = (const bf16_t*)(F.ws + qnext) + (size_t)(qb * 32 + r32) * N_O + slot * 64 + 8 * h;
#pragma unroll
        for (int d0 = 0; d0 < 4; ++d0) qpre[d0] = *(const u32x4*)(qn + 16 * d0); }
    attn_epilogue<DV, WIN>(F, O, lsum, m, sink_l2, E);
}
template <int DV, bool WIN>
DI void attn_epilogue(Frame& F, f32x16 (&O)[DV / 32], float lsum, float m, float sink_l2, const AttnEpi E) {
    constexpr int NDV = DV / 32;
    int lane; asm volatile("v_mbcnt_lo_u32_b32 %0, -1, 0\n\tv_mbcnt_hi_u32_b32 %0, -1, %0" : "=v"(lane));
    const int wave = F.wave, tid = wave * 64 + lane, slot = wave & 1, qb = wave >> 1, h = lane >> 5, r32 = lane & 31;
    { auto rr = __builtin_amdgcn_permlane32_swap(__float_as_uint(lsum), __float_as_uint(lsum), false, false); lsum = __uint_as_float(rr[0]) + __uint_as_float(rr[1]); }
    if (WIN) lsum += __builtin_amdgcn_exp2f(sink_l2 - m);
    const float inv = 1.f / lsum;
    u32x4 zpre[4];
#pragma unroll
    for (int k = 0; k < 4; ++k) { const int it = tid + 512 * k, q = it >> 4, cc = it & 15; zpre[k] = *(const u32x4*)((const bf16_t*)(F.ws + E.z) + (size_t)q * N_O + cc * 8); }
    LAS float* Y = (LAS float*)F.lds;
    if (!WIN) {
        LAS float* X = (LAS float*)(F.lds + 67584) + qb * 4096;
        if (slot == 1) {
            const float sc = inv * E.lam;
#pragma unroll
            for (int d = 0; d < NDV; ++d)
#pragma unroll
                for (int i = 0; i < 16; ++i) X[(d * 32 + crow(i, h)) * 32 + r32] = O[d][i] * sc;
        }
        bar_lds();
        if (slot == 0) {
            float ss = 0.f;
#pragma unroll
            for (int d = 0; d < NDV; ++d)
#pragma unroll
                for (int i = 0; i < 16; ++i) { const float v = O[d][i] * inv - X[(d * 32 + crow(i, h)) * 32 + r32]; O[d][i] = v; ss += v * v; }
            { auto rr = __builtin_amdgcn_permlane32_swap(__float_as_uint(ss), __float_as_uint(ss), false, false); ss = __uint_as_float(rr[0]) + __uint_as_float(rr[1]); }
            const float rstd = rsqrtf(ss * (1.f / 128.f) + EPS) * E.oml;
#pragma unroll
            for (int d = 0; d < NDV; ++d)
#pragma unroll
                for (int q4 = 0; q4 < 4; ++q4)
                    *(LAS f32x4*)(Y + (qb * 32 + r32) * 132 + d * 32 + 8 * q4 + 4 * h) = (f32x4){O[d][4 * q4] * rstd, O[d][4 * q4 + 1] * rstd, O[d][4 * q4 + 2] * rstd, O[d][4 * q4 + 3] * rstd};
        }
        bar_lds();
    } else {
#pragma unroll
        for (int d = 0; d < NDV; ++d)
#pragma unroll
            for (int q4 = 0; q4 < 4; ++q4)
                *(LAS f32x4*)(Y + (qb * 32 + r32) * 132 + slot * 64 + d * 32 + 8 * q4 + 4 * h) = (f32x4){O[d][4 * q4] * inv, O[d][4 * q4 + 1] * inv, O[d][4 * q4 + 2] * inv, O[d][4 * q4 + 3] * inv};
        bar_lds();
    }
#pragma unroll
    for (int k = 0; k < 4; ++k) {
        const int it = tid + 512 * k, q = it >> 4, cc = it & 15;
        const f32x4 y0 = *(const LAS f32x4*)(Y + q * 132 + cc * 8), y1 = *(const LAS f32x4*)(Y + q * 132 + cc * 8 + 4);
        f32x4 g0 = {1.f, 1.f, 1.f, 1.f}, g1 = g0;
        if (!WIN) { g0 = *(const f32x4*)(F.p.in[I_OSUBG] + cc * 8); g1 = *(const f32x4*)(F.p.in[I_OSUBG] + cc * 8 + 4); }
        const u32x4 z = zpre[k];
        u32x4 o; o.x = pk2(y0.x * g0.x * silu_f(lo_f(z.x)), y0.y * g0.y * silu_f(hi_f(z.x))); o.y = pk2(y0.z * g0.z * silu_f(lo_f(z.y)), y0.w * g0.w * silu_f(hi_f(z.y)));
        o.z = pk2(y1.x * g1.x * silu_f(lo_f(z.z)), y1.y * g1.y * silu_f(hi_f(z.z))); o.w = pk2(y1.z * g1.z * silu_f(lo_f(z.w)), y1.w * g1.w * silu_f(hi_f(z.w)));
        *(u32x4*)((bf16_t*)(F.ws + E.aout) + (size_t)q * 2048 + cc * 8) = o;
    }
    bar_lds();
}

template <int PM = 0, int ONLY = 0>
DI void phase_attn(Frame& F, int grp) {
    const float lam = ((const float*)(F.ws + WS_LAM))[0], oml = ((const float*)(F.ws + WS_LAM))[1];
    const unsigned lat0 = grp == 0 ? R_CTX : 0;
    constexpr unsigned UB = (unsigned)WS_U, AB = (unsigned)WS_AOUT;
    const int NU = 1024 + (grp == 0 ? 256 : 0);
    u32x4 qpre[4];
    const size_t qlane = (size_t)((F.wave >> 1) * 32 + (F.lane & 31)) * N_O + (F.wave & 1) * 64 + 8 * (F.lane >> 5);
    if (ONLY == 0 || ONLY == 1) {
    auto qoff_c = [&](int u) { if (u < 1024) { const int x = u & 7, qb = (u >> 3) & 31, bh = (u >> 8) * 8 + x, bl = bh >> 3, hh = bh & 7; return UB + ((lat0 + bl * 4096 + qb * 128) * N_O + hh * 128) * 2; }
                               const int c = u - 1024, b = c >> 4, hh = (c >> 1) & 7, qb = c & 1; return UB + ((unsigned)(b * 256 + qb * 128) * N_O + hh * 128) * 2; };
    if (F.bid < NU) { const bf16_t* qn = (const bf16_t*)(F.ws + qoff_c(F.bid)) + qlane;
#pragma unroll
        for (int d0 = 0; d0 < 4; ++d0) qpre[d0] = *(const u32x4*)(qn + 16 * d0); }
    for (int u = F.bid; u < NU; u += F.G) {
        AttnSeg s0, s1; AttnEpi E; unsigned q0; int rot;
        if (u < 1024) {
            const int x = u & 7, qb = (u >> 3) & 31, bh = (u >> 8) * 8 + x, bl = bh >> 3, hh = bh & 7, b = grp * 4 + bl;
            const unsigned ls = lat0 + bl * 4096; q0 = qb * 128;
            s0 = AttnSeg{(unsigned)WS_CK + (unsigned)(b * 8 + hh) * 512 * 128 * 2, (unsigned)WS_CV + (unsigned)(b * 8 + hh) * 512 * 128 * 2, 128, 128, 8};
            s1 = AttnSeg{UB + (ls * N_O + 1024 + hh * 128) * 2, UB + (ls * N_O + 2048 + hh * 128) * 2, N_O, N_O, 64};
            E = AttnEpi{AB + ((ls + q0) * 2048 + hh * 128) * 2, UB + ((ls + q0) * N_O + 3072 + hh * 128) * 2, lam, oml};
            rot = ATT_ROT(qb);
        } else {
            const int c = u - 1024, b = c >> 4, hh = (c >> 1) & 7, qb = c & 1; const unsigned ls = b * 256; q0 = qb * 128;
            s0 = AttnSeg{UB, UB, N_O, N_O, 0};
            s1 = AttnSeg{UB + (ls * N_O + 1024 + hh * 128) * 2, UB + (ls * N_O + 2048 + hh * 128) * 2, N_O, N_O, 4};
            E = AttnEpi{AB + ((ls + q0) * 2048 + hh * 128) * 2, UB + ((ls + q0) * N_O + 3072 + hh * 128) * 2, lam, oml};
            rot = 0;
        }
        const bool more = u + F.G < NU;
        attn_unit<128, 2, false, PM, true>(F, qoff_c(u), s0, s1, (int)q0, 0, false, 0.f, E, rot, qpre, more ? qoff_c(u + F.G) : 0u, more);
    } }
    if (ONLY == 0 || ONLY == 2) {
    auto qoff_w = [&](int u) { if (u < 1024) { const int x = u & 7, qb = (u >> 3) & 31, combo = (u >> 8) * 8 + x, bl = combo >> 3, kv = (combo >> 1) & 3, gp = combo & 1; return UB + ((lat0 + bl * 4096 + qb * 128) * N_O + 4096 + (kv * 4 + 2 * gp) * 64) * 2; }
                               const int c = u - 1024, b = c >> 4, kv = (c >> 2) & 3, gp = (c >> 1) & 1, qb = c & 1; return UB + ((unsigned)(b * 256 + qb * 128) * N_O + 4096 + (kv * 4 + 2 * gp) * 64) * 2; };
    if (F.bid < NU) { const bf16_t* qn = (const bf16_t*)(F.ws + qoff_w(F.bid)) + qlane;
#pragma unroll
        for (int d0 = 0; d0 < 4; ++d0) qpre[d0] = *(const u32x4*)(qn + 16 * d0); }
    for (int u = F.bid; u < NU; u += F.G) {
        AttnSeg s0, s1; AttnEpi E; int q0, ks, hd0; bool mw;
        if (u < 1024) {
            const int x = u & 7, qb = (u >> 3) & 31, combo = (u >> 8) * 8 + x, bl = combo >> 3, kv = (combo >> 1) & 3, gp = combo & 1, b = grp * 4 + bl;
            const unsigned ls = lat0 + bl * 4096; q0 = qb * 128; hd0 = kv * 4 + 2 * gp;
            ks = max(0, q0 - 128); const int ke = min(4096, q0 + 256);
            s0 = AttnSeg{(unsigned)WS_WK + (unsigned)(b * 4 + kv) * 512 * 64 * 2, (unsigned)WS_WV + (unsigned)(b * 4 + kv) * 512 * 64 * 2, 64, 64, 8};
            s1 = AttnSeg{UB + ((ls + ks) * N_O + 5120 + kv * 64) * 2, UB + ((ls + ks) * N_O + 5376 + kv * 64) * 2, N_O, N_O, (ke - ks) >> 6};
            E = AttnEpi{AB + ((ls + q0) * 2048 + 1024 + hd0 * 64) * 2, UB + ((ls + q0) * N_O + 5632 + hd0 * 64) * 2, 0.f, 0.f};
            mw = true;
        } else {
            const int c = u - 1024, b = c >> 4, kv = (c >> 2) & 3, gp = (c >> 1) & 1, qb = c & 1; const unsigned ls = b * 256; q0 = qb * 128; hd0 = kv * 4 + 2 * gp; ks = 0;
            s0 = AttnSeg{UB, UB, N_O, N_O, 0};
            s1 = AttnSeg{UB + (ls * N_O + 5120 + kv * 64) * 2, UB + (ls * N_O + 5376 + kv * 64) * 2, N_O, N_O, 4};
            E = AttnEpi{AB + ((ls + q0) * 2048 + 1024 + hd0 * 64) * 2, UB + ((ls + q0) * N_O + 5632 + hd0 * 64) * 2, 0.f, 0.f};
            mw = false;
        }
        const float sk = F.p.in[I_OSINK][hd0 + (F.wave & 1)] * LOG2E;
        const bool more = u + F.G < NU;
        attn_unit<64, 1, true, 0, true>(F, qoff_w(u), s0, s1, q0, ks, mw, sk, E, 0, qpre, more ? qoff_w(u + F.G) : 0u, more);
    } }
}

DI void phase_final(Frame& F, int grp) {
    const int row0 = GRP_ROW0[grp], rows = GRP_ROWS[grp];
    const int gw = F.bid * NWAVES + F.wave, NGW = F.G * NWAVES;
    const float* ng = F.p.in[I_FNORMG];
    const bf16_t* x2b = (const bf16_t*)(F.ws + WS_REGA);
    for (int rl = gw; rl < rows; rl += 2 * NGW) {
        f32x4 v[2][4]; float s[2];
#pragma unroll
        for (int q = 0; q < 2; ++q) { const u32x2* xr = (const u32x2*)(x2b + (size_t)min(rl + q * NGW, rows - 1) * DM) + F.lane;
#pragma unroll
            for (int j = 0; j < 4; ++j) { const u32x2 w = xr[64 * j]; v[q][j] = (f32x4){lo_f(w.x), hi_f(w.x), lo_f(w.y), hi_f(w.y)}; } }
#pragma unroll
        for (int q = 0; q < 2; ++q) { float t = 0.f;
#pragma unroll
            for (int j = 0; j < 4; ++j) t += (v[q][j].x * v[q][j].x + v[q][j].y * v[q][j].y) + (v[q][j].z * v[q][j].z + v[q][j].w * v[q][j].w);
            s[q] = t; }
#pragma unroll
        for (int o = 1; o < 64; o <<= 1) { s[0] += shfl_idx(s[0], F.lane ^ o); s[1] += shfl_idx(s[1], F.lane ^ o); }
#pragma unroll
        for (int q = 0; q < 2; ++q) { if (rl + q * NGW >= rows) continue;
            const float rstd = rsqrtf(s[q] * (1.f / DM) + EPS);
            f32x4* xr = (f32x4*)(F.out + OUT_X + (size_t)(row0 + rl + q * NGW) * DM) + F.lane;
#pragma unroll
            for (int j = 0; j < 4; ++j) { const f32x4 g = *((const f32x4*)ng + F.lane + 64 * j); xr[64 * j] = v[q][j] * rstd * g; } }
    }
}
#define RLX_AGENT __ATOMIC_RELAXED, __HIP_MEMORY_SCOPE_AGENT
#define XB_TMO      128
#define XB_XCNT(j)  (256  + 64 * (j))
#define XB_XSUB(j)  (1280 + 64 * (j))
#define XB_XGEN(j)  (2304 + 64 * (j))
#define XB_TOP      3328
#define XB_TOPGEN   3392
#define XCD_BAR_WORDS 3456
#define XB_SPIN_CAP (1u << 18)

__device__ __forceinline__ unsigned xb_ld(unsigned* p)              { return __hip_atomic_load(p, __ATOMIC_RELAXED, __HIP_MEMORY_SCOPE_AGENT); }
__device__ __forceinline__ unsigned xb_add(unsigned* p, unsigned v) { return __hip_atomic_fetch_add(p, v, __ATOMIC_RELAXED, __HIP_MEMORY_SCOPE_AGENT); }
__device__ __forceinline__ unsigned xb_xcc_id() { return (unsigned)__builtin_amdgcn_s_getreg((3 << 11) | 20) & 0xFu; }
#define XB_SPIN(cond, bar) do { unsigned _sp = 0; while (cond) { __builtin_amdgcn_s_sleep(1); \
    if ((++_sp & 255u) == 0u) { if (xb_ld(&(bar)[XB_TMO])) break; if (_sp > XB_SPIN_CAP) { atomicAdd(&(bar)[XB_TMO], 1u); break; } } } } while (0)

struct XcdBarrier {
    unsigned* bar; unsigned x;
    volatile LAS unsigned* st;
};

__device__ __forceinline__ XcdBarrier xcd_barrier_post(unsigned* bar, volatile LAS unsigned* st) {
    XcdBarrier b; b.bar = bar; b.x = xb_xcc_id(); b.st = st;
    if (threadIdx.x == 0) (void)xb_add(&bar[XB_XCNT(b.x)], 1u);
    return b;
}
__device__ __forceinline__ void xcd_barrier_complete(unsigned* bar, unsigned x, unsigned& nloc, unsigned& nx) {
    const unsigned G = gridDim.x * gridDim.y * gridDim.z;
    unsigned sum, cnt, mine, sp = 0u;
    for (;;) {
        sum = 0u; cnt = 0u; mine = 0u;
#pragma unroll
        for (unsigned j = 0; j < 16; ++j) { const unsigned c = xb_ld(&bar[XB_XCNT(j)]); sum += c; cnt += (c > 0u) ? 1u : 0u; mine = (j == x) ? c : mine; }
        if (sum == G) break;
        __builtin_amdgcn_s_sleep(1);
        if ((++sp & 255u) == 0u) { if (xb_ld(&bar[XB_TMO])) break; if (sp > XB_SPIN_CAP) { atomicAdd(&bar[XB_TMO], 1u); break; } }
    }
    nloc = mine > 0u ? mine : 1u; nx = cnt > 0u ? cnt : 1u;
}

__device__ __forceinline__ void xcd_barrier(const XcdBarrier& b) {
    asm volatile("s_waitcnt vmcnt(0)" ::: "memory");
    __syncthreads();
    if (threadIdx.x == 0) {
        unsigned* bar = b.bar;
        __builtin_amdgcn_s_waitcnt(0);
        unsigned nloc = b.st[0], nx = b.st[1];
        if (nloc == 0u) { xcd_barrier_complete(bar, b.x, nloc, nx); b.st[0] = nloc; b.st[1] = nx; }
        const unsigned old = xb_add(&bar[XB_XSUB(b.x)], 1u);
        const unsigned gen = old / nloc;
        if (old + 1u == (gen + 1u) * nloc) {
            __builtin_amdgcn_fence(__ATOMIC_RELEASE, "agent");
            asm volatile("s_waitcnt vmcnt(0)" ::: "memory");
            const unsigned og = xb_add(&bar[XB_TOP], 1u);
            const unsigned tg = og / nx;
            if (og + 1u == (tg + 1u) * nx) xb_add(&bar[XB_TOPGEN], 1u);
            else XB_SPIN(xb_ld(&bar[XB_TOPGEN]) == tg, bar);
            __builtin_amdgcn_fence(__ATOMIC_ACQUIRE, "agent");
            xb_add(&bar[XB_XGEN(b.x)], 1u);
            asm volatile("s_waitcnt vmcnt(0)" ::: "memory");
        } else {
            XB_SPIN(xb_ld(&bar[XB_XGEN(b.x)]) == gen, bar);
            __builtin_amdgcn_fence(__ATOMIC_ACQUIRE, "agent");
            asm volatile("s_waitcnt vmcnt(0)" ::: "memory");
        }
    }
    __syncthreads();
}

constexpr int NPHG = 13;
constexpr int NPH = 1 + 2 * NPHG;

DI Frame relaunder(const Frame& F0) {
    int ln; asm volatile("v_mbcnt_lo_u32_b32 %0, -1, 0\n\tv_mbcnt_hi_u32_b32 %0, -1, %0" : "=v"(ln));
    int b = F0.bid, G = F0.G, wv = F0.wave; size_t z0 = 0, z1 = 0; asm volatile("" : "+s"(b), "+s"(G), "+s"(z0), "+s"(z1), "+s"(wv));
    float* o = F0.p.out + z0; unsigned char* w = F0.p.ws + z1;
    return Frame{F0.lds, wv * 64 + ln, ln, wv, G, b, F0.p, o, w, F0.probe};
}
DI void run_phase(const Frame& F0, int ph) {
#ifndef PHMASK
#define PHMASK 0xFFFF
#endif
#define PHON(k) ((PHMASK >> (k)) & 1)
    if (ph == 0) { if (PHON(14)) { Frame F = relaunder(F0); phase_p0(F); } return; }
    const int grp = (ph - 1) / NPHG, k = (ph - 1) % NPHG;
    const int row0 = GRP_ROW0[grp], rows = GRP_ROWS[grp];
        switch (k) {
    case 0: if (PHON(0)) { Frame F = relaunder(F0); phase_modnorm(F, grp, 0); } break;
    case 1: if (PHON(1)) { Frame F = relaunder(F0); { pg8::Gemm g{(const bf16_t*)(F.ws + WS_REGA), (const bf16_t*)(F.ws + WS_WT_IN_E), rows, N_E, 1024, 1024, 0};
              pg8::StaticOrder S; S.init(rows, N_E, F.G, F.bid);
              epi::EpiE0 E{(bf16_t*)(F.out + OUT_X + (size_t)row0 * DM), (bf16_t*)(F.ws + WS_XBCRAW), (bf16_t*)(F.ws + WS_XB), (float*)(F.ws + WS_DTRAW)};
              pg8::gemm_phase<epi::EpiE0, pg8::StaticOrder, true, true>(F.lds, g, S, E, F.tid); } } break;
    case 2: if (PHON(2)) { Frame F = relaunder(F0); phase_conv(F, grp); } break;
    case 3: if (PHON(3)) { Frame F = relaunder(F0); phase_states(F, grp); } break;
    case 4: if (PHON(4)) { Frame F = relaunder(F0); phase_scan(F, grp); } break;
    case 5: if (PHON(5)) { Frame F = relaunder(F0); phase_y(F, grp); } break;
    case 6: if (PHON(6)) { Frame F = relaunder(F0); {
              pg8::Gemm g{(const bf16_t*)(F.ws + WS_POOLED), (const bf16_t*)(F.ws + WS_WT_POOL), rows, 1024, 256, 1024, 256};
              pg8::StaticOrder S; S.init(rows, 1024, F.G, F.bid);
              epi::EpiPool E{(bf16_t*)(F.ws + WS_AOUT), (const bf16_t*)(F.out + OUT_X + (size_t)row0 * DM), (const float*)(F.ws + WS_SSY)};
              pg8::gemm_phase<epi::EpiPool, pg8::StaticOrder, true, true>(F.lds, g, S, E, F.tid); } } break;
    case 7: if (PHON(7)) { Frame F = relaunder(F0); { pg8::Gemm g{(const bf16_t*)(F.ws + WS_AOUT), (const bf16_t*)(F.ws + WS_WT_OUT_E), rows, 1024, 2048, 2048, 0};
              pg8::StaticOrder S; S.init(rows, 1024, F.G, F.bid);
              epi::EpiRes<true> E{F.p.in[I_XP], F.p.in[I_XS], nullptr, (const float*)(F.ws + WS_MOD), row0, (const float*)(F.ws + WS_SSY), (bf16_t*)(F.ws + WS_X1B), nullptr};
              pg8::gemm_phase<epi::EpiRes<true>, pg8::StaticOrder, true, true>(F.lds, g, S, E, F.tid); } } break;
    case 8: if (PHON(8)) { Frame F = relaunder(F0); phase_modnorm(F, grp, 1); } break;
    case 9: if (PHON(9)) { Frame F = relaunder(F0); { pg8::Gemm g{(const bf16_t*)(F.ws + WS_REGA), (const bf16_t*)(F.ws + WS_WT_IN_O), rows, N_O, 1024, 1024, 0};
              pg8::StaticOrder S; S.init(rows, N_O, F.G, F.bid);
              epi::EpiO E{(bf16_t*)(F.ws + WS_U), (const float*)(F.ws + WS_ROPE), row0};
              pg8::gemm_phase<epi::EpiO, pg8::StaticOrder, true, true>(F.lds, g, S, E, F.tid); } } break;
    case 10: if (PHON(10)) { Frame F = relaunder(F0); if (grp == 0) phase_cachecopy(F); phase_attn(F, grp); } break;
    case 11: if (PHON(11)) { Frame F = relaunder(F0); { pg8::Gemm g{(const bf16_t*)(F.ws + WS_AOUT), (const bf16_t*)(F.ws + WS_WT_OUT_O), rows, 1024, 2048, 2048, 0};
               pg8::StaticOrder S; S.init(rows, 1024, F.G, F.bid);
               epi::EpiRes<false> E{nullptr, nullptr, F.out + OUT_X, (const float*)(F.ws + WS_MOD) + 9 * 3072, row0, nullptr, (bf16_t*)(F.ws + WS_X1B), (bf16_t*)(F.ws + WS_REGA)};
               pg8::gemm_phase<epi::EpiRes<false>, pg8::StaticOrder, true, true>(F.lds, g, S, E, F.tid); } } break;
    default: if (PHON(12)) { Frame F = relaunder(F0); phase_final(F, grp); } break;
    }
}

__global__ void __launch_bounds__(NTHREADS, 2) mega_fwd(Params p) {
    extern __shared__ __attribute__((aligned(16))) unsigned char lds_raw[];
    cg::grid_group grid = cg::this_grid();
    const int wave_ = __builtin_amdgcn_readfirstlane((int)threadIdx.x >> 6);
    volatile LAS unsigned* bst = (volatile LAS unsigned*)((ldsp)lds_raw + LDS_BYTES - 256);
    if (threadIdx.x < 2) bst[threadIdx.x] = 0u;
    __syncthreads();
    XcdBarrier bar = xcd_barrier_post((unsigned*)(p.ws + WS_BAR), bst);
    for (int ph = p.ph_lo; ph < p.ph_hi; ++ph) {
        int lane_; asm volatile("v_mbcnt_lo_u32_b32 %0, -1, 0\n\tv_mbcnt_hi_u32_b32 %0, -1, %0" : "=v"(lane_));
        Frame F{(ldsp)lds_raw, wave_ * 64 + lane_, lane_, wave_, (int)gridDim.x, (int)blockIdx.x, p, p.out, p.ws, 0};
#ifdef ATT_PROBE
#ifndef ATT_PM
#define ATT_PM 0
#endif
        if (ph > 0 && (ph - 1) % NPHG == 10) { Frame Fp = relaunder(F); phase_attn<ATT_PM, ATT_PROBE>(Fp, (ph - 1) / NPHG); xcd_barrier(bar); }
#endif
#ifdef DUP_MASK
        if (ph > 0 && ((DUP_MASK >> ((ph - 1) % NPHG)) & 1)) { Frame Fp{F.lds, F.tid, F.lane, F.wave, F.G, F.bid, F.p, F.out, F.ws, 1}; run_phase(Fp, ph); xcd_barrier(bar); }
#endif
        run_phase(F, ph);
        if (ph + 1 < p.ph_hi) { if (ph == 0) grid.sync(); else xcd_barrier(bar); }
    }
}

#ifndef MK_MULTI
#define MK_MULTI 0
#endif
extern "C" void kernel_launch(void* const* d_in, const int* in_sizes, int n_in, void* d_out, int out_size, void* d_ws, size_t ws_size, hipStream_t stream) {
    static int grid = 0;
    if (grid == 0) {
        if (n_in != 28 || (size_t)out_size != OUT_END || ws_size < WS_END) { fprintf(stderr, "kernel_launch: unexpected sizes n_in %d out %d ws %zu\n", n_in, out_size, ws_size); grid = -1; return; }
        int dev = 0, cus = 0, per_cu = 0;
        hipGetDevice(&dev); hipDeviceGetAttribute(&cus, hipDeviceAttributeMultiprocessorCount, dev);
        if (hipFuncSetAttribute((const void*)mega_fwd, hipFuncAttributeMaxDynamicSharedMemorySize, LDS_BYTES) != hipSuccess) { fprintf(stderr, "kernel_launch: hipFuncSetAttribute failed\n"); grid = -1; return; }
        if (hipOccupancyMaxActiveBlocksPerMultiprocessor(&per_cu, (const void*)mega_fwd, NTHREADS, LDS_BYTES) != hipSuccess || per_cu < 1) { fprintf(stderr, "kernel_launch: occupancy query failed (%d)\n", per_cu); (void)hipGetLastError(); per_cu = 1; }
        grid = cus * (per_cu > 1 ? 1 : per_cu);
        if (grid > 256) grid = 256;
    }
    if (grid < 0) return;
    if (hipMemsetAsync((char*)d_ws + WS_BAR, 0, 16384, stream) != hipSuccess) { fprintf(stderr, "kernel_launch: memset failed\n"); return; }
    Params p{};
    for (int i = 0; i < 28; ++i) p.in[i] = (const float*)d_in[i];
    p.out = (float*)d_out; p.ws = (unsigned char*)d_ws;
#if MK_MULTI
    for (int ph = 0; ph < NPH; ++ph) { p.ph_lo = ph; p.ph_hi = ph + 1; hipLaunchKernelGGL(mega_fwd, dim3(grid), dim3(NTHREADS), LDS_BYTES, stream, p); }
#else
    p.ph_lo = 0; p.ph_hi = NPH;
    void* args[] = {&p};
    hipError_t e = hipLaunchCooperativeKernel((const void*)mega_fwd, dim3(grid), dim3(NTHREADS), args, LDS_BYTES, stream);
    if (e != hipSuccess) fprintf(stderr, "cooperative launch failed: %s (grid %d)\n", hipGetErrorString(e), grid);
#endif
}
```

```cpp
#include <hip/hip_runtime.h>
#include <hip/hip_cooperative_groups.h>
#include <cstdio>
#include <cstdint>
namespace cg = cooperative_groups;

#define DI __device__ __forceinline__
#define LAS __attribute__((address_space(3)))
typedef unsigned short bf16_t;
typedef short bf16x8 __attribute__((ext_vector_type(8)));
typedef short s16x4 __attribute__((ext_vector_type(4)));
typedef float f32x2 __attribute__((ext_vector_type(2)));
typedef float f32x4 __attribute__((ext_vector_type(4)));
typedef float f32x16 __attribute__((ext_vector_type(16)));
typedef unsigned u32x2 __attribute__((ext_vector_type(2)));
typedef unsigned u32x4 __attribute__((ext_vector_type(4)));
typedef __bf16 bf16x2_t __attribute__((ext_vector_type(2)));
typedef LAS unsigned char* ldsp;

constexpr int DM = 1024;
constexpr int R_CTX = 4096, R_ALL = 36864;
constexpr int GRP_ROW0[2] = {0, 20480};
constexpr int GRP_ROWS[2] = {20480, 16384};
constexpr int MAXROWS = 20480;
constexpr int N_E = 5376;
constexpr int N_O = 6656;
constexpr float EPS = 1e-6f;
constexpr float C2 = 0.125f * 1.4426950408889634f;
constexpr float LOG2E = 1.4426950408889634f;

constexpr size_t MiB = 1u << 20;
constexpr size_t WS_MOD = 0;
constexpr size_t WS_ROPE = 256 * 1024;
constexpr size_t WS_LAM = 300 * 1024;
constexpr size_t WS_BIAS1 = 320 * 1024;
constexpr size_t WS_SSY = 600 * 1024;
constexpr size_t WS_SS1 = 700 * 1024;
constexpr size_t WS_WT_IN_E = 1 * MiB;
constexpr size_t WS_WT_OUT_E = 12 * MiB;
constexpr size_t WS_WT_IN_O = 16 * MiB;
constexpr size_t WS_WT_OUT_O = 29 * MiB;
constexpr size_t WS_WT_POOL = 33 * MiB;
constexpr size_t WS_CK = 34 * MiB;
constexpr size_t WS_CV = 42 * MiB;
constexpr size_t WS_WK = 50 * MiB;
constexpr size_t WS_WV = 52 * MiB;
constexpr size_t WS_DTRAW = 54 * MiB;
constexpr size_t WS_DTV = 57 * MiB;
constexpr size_t WS_ACS = 60 * MiB;
constexpr size_t WS_DECAY = 63 * MiB;
constexpr size_t WS_REGA = 64 * MiB;
constexpr size_t WS_X1B = 64 * MiB + 40 * MiB;
constexpr size_t WS_AOUT = 144 * MiB;
constexpr size_t WS_U = 224 * MiB;
constexpr size_t WS_XBCRAW = WS_U;
constexpr size_t WS_XBC = WS_U + 80 * MiB;
constexpr size_t WS_XB = WS_U + 160 * MiB;
constexpr size_t WS_POOLED = WS_U + 200 * MiB;
constexpr size_t WS_BAR = 484 * MiB;
constexpr size_t WS_END = 485 * MiB;

constexpr size_t OUT_X = 0;
constexpr size_t OUT_SSD_F = (size_t)R_ALL * DM;
constexpr size_t OUT_SSD_B = OUT_SSD_F + 16 * 16 * 64 * 128;
constexpr size_t OUT_DIFF_K = OUT_SSD_B + 16 * 16 * 64 * 128;
constexpr size_t OUT_DIFF_V = OUT_DIFF_K + 16 * 8 * 256 * 128;
constexpr size_t OUT_WIN_K = OUT_DIFF_V + 16 * 8 * 256 * 128;
constexpr size_t OUT_WIN_V = OUT_WIN_K + 16 * 4 * 256 * 64;
constexpr size_t OUT_END = OUT_WIN_V + 16 * 4 * 256 * 64;

constexpr int NTHREADS = 512, NWAVES = 8;
constexpr int LDS_BYTES = 160 * 1024;

DI float bf2f(bf16_t v) { return __uint_as_float((unsigned)v << 16); }
DI unsigned pk2(float lo, float hi) { f32x2 v = {lo, hi}; bf16x2_t b = __builtin_convertvector(v, bf16x2_t); return __builtin_bit_cast(unsigned, b); }
DI bf16_t f2bf(float f) { return (bf16_t)(pk2(f, 0.f) & 0xffffu); }
DI float lo_f(unsigned w) { return __uint_as_float(w << 16); }
DI float hi_f(unsigned w) { return __uint_as_float(w & 0xffff0000u); }
DI float silu_f(float x) { return x * __builtin_amdgcn_rcpf(1.f + __expf(-x)); }
DI void bar_lds() { asm volatile("s_waitcnt lgkmcnt(0)" ::: "memory"); __builtin_amdgcn_s_barrier(); asm volatile("" ::: "memory"); }
DI float shfl_idx(float v, int srclane) { return __uint_as_float((unsigned)__builtin_amdgcn_ds_bpermute(srclane << 2, (int)__float_as_uint(v))); }
DI float wave_sum(float v, int lane) {
#pragma unroll
    for (int o = 1; o < 64; o <<= 1) v += shfl_idx(v, lane ^ o);
    return v;
}
DI bf16x8 lds_ld128(ldsp p) { return *(const LAS bf16x8*)p; }
DI void lds_st128(ldsp p, u32x4 v) { *(LAS u32x4*)p = v; }
typedef short v4i16_t __attribute__((ext_vector_type(4)));
DI s16x4 lds_tr(ldsp p) { return __builtin_bit_cast(s16x4, __builtin_amdgcn_ds_read_tr16_b64_v4i16((LAS v4i16_t*)p)); }
DI bf16x8 cat8(s16x4 lo, s16x4 hi) { return __builtin_shufflevector(lo, hi, 0, 1, 2, 3, 4, 5, 6, 7); }
DI int crow(int reg, int h) { return (reg & 3) + 8 * (reg >> 2) + 4 * h; }
DI bf16x8 pack8(const f32x16& x, int s) {
    u32x4 p; p.x = pk2(x[8 * s], x[8 * s + 1]); p.y = pk2(x[8 * s + 2], x[8 * s + 3]); p.z = pk2(x[8 * s + 4], x[8 * s + 5]); p.w = pk2(x[8 * s + 6], x[8 * s + 7]);
    return __builtin_bit_cast(bf16x8, p);
}
#define MFMA32(a, b, c) __builtin_amdgcn_mfma_f32_32x32x16_bf16((a), (b), (c), 0, 0, 0)

struct RowInfo { int ctx, b, t, T, g; };
DI RowInfo rowinfo(int row) {
    RowInfo r;
    if (row < R_CTX) { r.ctx = 1; r.b = row >> 8; r.t = row & 255; r.T = 256; r.g = 8; }
    else { const int q = row - R_CTX; r.ctx = 0; r.b = q >> 12; r.t = q & 4095; r.T = 4096; r.g = r.b; }
    return r;
}
namespace pg8 {
#define PG8_LAS __attribute__((address_space(3)))
constexpr int BM = 256, BK = 64, HALF = 128, HTB = HALF * BK * 2  , STAGE_BYTES = 8 * HTB, NXCD = 8, WGM = 8;

__host__ __device__ __forceinline__ int lds_byte(int r, int c) { const int st = (r >> 4) * 2 + (c >> 5), rr = r & 15, cc = c & 31, ob = rr * 64 + cc * 2; return st * 1024 + (ob ^ (((ob >> 9) & 1) << 5)); }
__host__ __device__ __forceinline__ void stage_rc(int b, int& R, int& C) { const int st = b / 1024, sb = b % 1024, swz = sb ^ (((sb >> 9) & 1) << 5); R = (st >> 1) * 16 + swz / 64; C = (st & 1) * 32 + (swz % 64) / 2; }
__host__ __device__ __forceinline__ int perm32(int rho) { const int n = rho >> 4, i = rho & 15; return 8 * (i >> 2) + 4 * n + (i & 3); }

struct Unit { int pm, pn; };
struct Gemm { const bf16_t* A; const bf16_t* Bt; int M, N, K, lda, a_pn_off; };

struct StaticOrder {
    int nM, nN, nwg, G, c;
    __host__ __device__ void init(int M, int N, int G_, int c_) { nM = M / BM; nN = N / BM; nwg = nM * nN; G = G_; c = c_; }
    __host__ __device__ bool next(int i, Unit& u) const {
        const long L = (long)i * G + c; if (L >= nwg) return false;
        int wgid = (int)L; { const int q = nwg / NXCD, r = nwg % NXCD, xcd = wgid % NXCD, off = wgid / NXCD; wgid = (xcd < r ? xcd * (q + 1) : r * (q + 1) + (xcd - r) * q) + off; }
        const int nig = WGM * nN, gid = wgid / nig, fm = gid * WGM, gsz = (nM - fm) < WGM ? (nM - fm) : WGM;
        u.pm = fm + ((wgid % nig) % gsz); u.pn = (wgid % nig) / gsz; return true;
    }
    __device__ __forceinline__ void a_ready(const Unit&) const {}
    __device__ __forceinline__ void done(const Unit&) const {}
};


template <class Epi, class Sched, bool ALIGN_EPI = false, bool SP2 = false>
__device__ __forceinline__ void gemm_phase(PG8_LAS unsigned char* lds, const Gemm g, const Sched& S, const Epi& E, const int tid) {
    const int wid = __builtin_amdgcn_readfirstlane(tid >> 6), lane = tid & 63, wr = wid >> 2, wc = wid & 3, fr = lane & 15, fq = lane >> 4;
    const int K = g.K, nt = K / BK;
    unsigned voffA[2], voffB[2];
#pragma unroll
    for (int i = 0; i < 2; ++i) { int R, C; stage_rc(tid * 16 + i * 8192, R, C); const int Rb = Epi::PERM ? ((R & ~31) + perm32(R & 31)) : R;
        voffA[i] = (unsigned)(R * g.lda + C) * 2u; voffB[i] = (unsigned)(Rb * K + C) * 2u; }
    const size_t kstep = (size_t)(BK * 2);
    const size_t hstepA = (size_t)HALF * g.lda * 2, hstepB = (size_t)HALF * K * 2;
    const size_t tstepA = 2 * hstepA, tstepB = 2 * hstepB, pnoff = (size_t)g.a_pn_off * 2;
    const unsigned ldsw = (unsigned)wid * 1024u;
    const int aoff = lds_byte(wr * 64 + fr, fq * 8), boff = lds_byte(wc * 32 + fr, fq * 8);
#define PG8_SA(b, h) (((b) * 2 + (h)) * HTB)
#define PG8_SB(b, h) ((4 + (b) * 2 + (h)) * HTB)
#define PG8_STAGE(bufoff, gbase, voff) do { _Pragma("unroll") for (int _i = 0; _i < 2; ++_i) \
        __builtin_amdgcn_global_load_lds((const unsigned*)((const char*)(gbase) + (voff)[_i]), (PG8_LAS unsigned*)(lds + (bufoff) + ldsw + _i * 8192), 16, 0, 0); } while (0)
#define PG8_LDA(dst, b, h) do { _Pragma("unroll") for (int m = 0; m < 4; ++m) _Pragma("unroll") for (int k = 0; k < 2; ++k) dst[m][k] = *(const PG8_LAS bf16x8*)(lds + PG8_SA(b, h) + aoff + m * 2048 + k * 1024); } while (0)
#define PG8_LDB(dst, b, h) do { _Pragma("unroll") for (int n = 0; n < 2; ++n) _Pragma("unroll") for (int k = 0; k < 2; ++k) dst[n][k] = *(const PG8_LAS bf16x8*)(lds + PG8_SB(b, h) + boff + n * 2048 + k * 1024); } while (0)
#define PG8_MMA(ai, bj, At, Bt) do { __builtin_amdgcn_s_setprio(1); _Pragma("unroll") for (int m = 0; m < 4; ++m) _Pragma("unroll") for (int n = 0; n < 2; ++n) _Pragma("unroll") for (int k = 0; k < 2; ++k) \
        acc[ai][bj][m][n] = __builtin_amdgcn_mfma_f32_16x16x32_bf16(Bt[n][k], At[m][k], acc[ai][bj][m][n], 0, 0, 0); __builtin_amdgcn_s_setprio(0); } while (0)
#define PG8_WAIT_V(n) asm volatile("s_waitcnt vmcnt(" #n ")" ::: "memory")
#define PG8_WAIT_L(n) asm volatile("s_waitcnt lgkmcnt(" #n ")" ::: "memory")
#define PG8_BAR __builtin_amdgcn_s_barrier()
#define PG8_SCHED __builtin_amdgcn_sched_barrier(0)
    Unit cur, nxt; int ui = 0;
    if (!S.next(0, cur)) return;
    f32x4 acc[2][2][4][2];
#pragma unroll
    for (int a = 0; a < 2; ++a)
#pragma unroll
        for (int b = 0; b < 2; ++b)
#pragma unroll
            for (int m = 0; m < 4; ++m)
#pragma unroll
                for (int n = 0; n < 2; ++n) acc[a][b][m][n] = (f32x4){0.f, 0.f, 0.f, 0.f};
    bf16x8 At[4][2], B0[2][2], B1[2][2];
    const char* cA = (const char*)g.A + (size_t)cur.pm * tstepA + (size_t)cur.pn * pnoff; const char* cB = (const char*)g.Bt + (size_t)cur.pn * tstepB;
    S.a_ready(cur);
    if constexpr (SP2) {
        PG8_STAGE(PG8_SB(0, 0), cB, voffB); PG8_STAGE(PG8_SB(0, 1), cB + hstepB, voffB); PG8_STAGE(PG8_SA(0, 0), cA, voffA); PG8_STAGE(PG8_SA(0, 1), cA + hstepA, voffA);
        if (wr == 1) PG8_BAR;
        PG8_WAIT_V(2); PG8_BAR;
        PG8_STAGE(PG8_SB(1, 0), cB + kstep, voffB); PG8_STAGE(PG8_SA(1, 0), cA + kstep, voffA); PG8_STAGE(PG8_SB(1, 1), cB + hstepB + kstep, voffB);
        PG8_WAIT_V(6); PG8_BAR;
    } else {
        PG8_STAGE(PG8_SB(0, 0), cB, voffB); PG8_STAGE(PG8_SA(0, 0), cA, voffA); PG8_STAGE(PG8_SB(0, 1), cB + hstepB, voffB); PG8_STAGE(PG8_SA(0, 1), cA + hstepA, voffA);
        if (wr == 1) PG8_BAR;
        PG8_WAIT_V(4); PG8_BAR;
        PG8_STAGE(PG8_SB(1, 0), cB + kstep, voffB); PG8_STAGE(PG8_SA(1, 0), cA + kstep, voffA); PG8_STAGE(PG8_SB(1, 1), cB + hstepB + kstep, voffB);
        PG8_WAIT_V(6); PG8_BAR;
    }
    for (;;) {
        const bool has_next = S.next(ui + 1, nxt);
        const char* nA = has_next ? (const char*)g.A + (size_t)nxt.pm * tstepA + (size_t)nxt.pn * pnoff : cA; const char* nB = has_next ? (const char*)g.Bt + (size_t)nxt.pn * tstepB : cB;
        for (int t = 0; t < nt; t += 2) {
            const bool last = (t == nt - 2);
            const char* a1 = cA + (size_t)(t + 1) * kstep;
            const char* a2 = last ? nA : cA + (size_t)(t + 2) * kstep; const char* b2 = last ? nB : cB + (size_t)(t + 2) * kstep;
            const char* a3 = a2 + kstep; const char* b3 = b2 + kstep;
            if (last && has_next) S.a_ready(nxt);
            if constexpr (SP2) {
            PG8_LDB(B0, 0, 0); PG8_LDB(B1, 0, 1); PG8_SCHED; PG8_LDA(At, 0, 0); PG8_STAGE(PG8_SA(1, 1), a1 + hstepA, voffA);
            PG8_WAIT_V(8); PG8_WAIT_L(0); PG8_BAR; PG8_MMA(0, 0, At, B0); PG8_MMA(0, 1, At, B1); PG8_BAR; PG8_SCHED;
            PG8_LDA(At, 0, 1); PG8_STAGE(PG8_SB(0, 0), b2, voffB); PG8_STAGE(PG8_SB(0, 1), b2 + hstepB, voffB); PG8_STAGE(PG8_SA(0, 0), a2, voffA);
            PG8_WAIT_V(8); PG8_WAIT_L(0); PG8_BAR; PG8_MMA(1, 0, At, B0); PG8_MMA(1, 1, At, B1); PG8_BAR; PG8_SCHED;
            PG8_LDB(B0, 1, 0); PG8_LDB(B1, 1, 1); PG8_SCHED; PG8_LDA(At, 1, 0); PG8_STAGE(PG8_SA(0, 1), a2 + hstepA, voffA);
            PG8_WAIT_V(8); PG8_WAIT_L(0); PG8_BAR; PG8_MMA(0, 0, At, B0); PG8_MMA(0, 1, At, B1); PG8_BAR; PG8_SCHED;
            PG8_LDA(At, 1, 1); PG8_STAGE(PG8_SB(1, 0), b3, voffB); PG8_STAGE(PG8_SB(1, 1), b3 + hstepB, voffB); PG8_STAGE(PG8_SA(1, 0), a3, voffA);
            PG8_WAIT_V(8); PG8_WAIT_L(0); PG8_BAR; PG8_MMA(1, 0, At, B0); PG8_MMA(1, 1, At, B1); PG8_BAR; PG8_SCHED;
            } else {
            PG8_LDB(B0, 0, 0); PG8_SCHED; PG8_LDA(At, 0, 0); PG8_STAGE(PG8_SA(1, 1), a1 + hstepA, voffA);
            PG8_WAIT_L(8); PG8_BAR; PG8_WAIT_L(0); PG8_MMA(0, 0, At, B0); PG8_BAR; PG8_SCHED;
            PG8_LDB(B1, 0, 1); PG8_STAGE(PG8_SB(0, 0), b2, voffB);
            PG8_BAR; PG8_WAIT_L(0); PG8_MMA(0, 1, At, B1); PG8_BAR;
            PG8_LDA(At, 0, 1); PG8_STAGE(PG8_SA(0, 0), a2, voffA);
            PG8_BAR; PG8_WAIT_L(0); PG8_MMA(1, 0, At, B0); PG8_BAR; PG8_SCHED;
            PG8_STAGE(PG8_SB(0, 1), b2 + hstepB, voffB);
            PG8_WAIT_V(6); PG8_BAR; PG8_MMA(1, 1, At, B1); PG8_BAR;
            PG8_LDB(B0, 1, 0); PG8_SCHED; PG8_LDA(At, 1, 0); PG8_STAGE(PG8_SA(0, 1), a2 + hstepA, voffA);
            PG8_WAIT_L(8); PG8_BAR; PG8_WAIT_L(0); PG8_MMA(0, 0, At, B0); PG8_BAR; PG8_SCHED;
            PG8_LDB(B1, 1, 1); PG8_STAGE(PG8_SB(1, 0), b3, voffB);
            PG8_BAR; PG8_WAIT_L(0); PG8_MMA(0, 1, At, B1); PG8_BAR;
            PG8_LDA(At, 1, 1); PG8_STAGE(PG8_SA(1, 0), a3, voffA);
            PG8_BAR; PG8_WAIT_L(0); PG8_MMA(1, 0, At, B0); PG8_BAR; PG8_SCHED;
            PG8_STAGE(PG8_SB(1, 1), b3 + hstepB, voffB);
            PG8_WAIT_V(6); PG8_BAR; PG8_MMA(1, 1, At, B1); PG8_BAR;
            }
        }
        if constexpr (ALIGN_EPI) { if (wr == 0) PG8_BAR; }
        if constexpr (!Epi::AFTER_DRAIN) { E(acc, cur, wr, wc, fr, fq); S.done(cur); }
        if (!has_next) break;
#pragma unroll
        for (int a = 0; a < 2; ++a)
#pragma unroll
            for (int b = 0; b < 2; ++b)
#pragma unroll
                for (int m = 0; m < 4; ++m)
#pragma unroll
                    for (int n = 0; n < 2; ++n) acc[a][b][m][n] = (f32x4){0.f, 0.f, 0.f, 0.f};
        cur = nxt; cA = nA; cB = nB; ++ui;
        if constexpr (ALIGN_EPI) { if (wr == 1) PG8_BAR; }
    }
    PG8_WAIT_V(0);
    if constexpr (!ALIGN_EPI) { if (wr == 0) PG8_BAR; }
    PG8_BAR;
    if constexpr (Epi::AFTER_DRAIN) { E.fused(acc, cur, wr, wc, fr, fq, lds, wid, lane); S.done(cur); }
#undef PG8_SA
#undef PG8_SB
#undef PG8_STAGE
#undef PG8_LDA
#undef PG8_LDB
#undef PG8_MMA
#undef PG8_WAIT_V
#undef PG8_WAIT_L
#undef PG8_BAR
#undef PG8_SCHED
}
}

namespace epi {
using pg8::Unit; using pg8::HALF; using pg8::BM;

DI void store_bf16_tile(const f32x4 (&acc)[2][2][4][2], bf16_t* base, int ld, int row0, int col0) {
#pragma unroll
    for (int ai = 0; ai < 2; ++ai)
#pragma unroll
        for (int m = 0; m < 4; ++m) { bf16_t* rowp = base + (size_t)(row0 + ai * HALF + m * 16) * ld + col0;
#pragma unroll
            for (int bj = 0; bj < 2; ++bj) { const f32x4 v0 = acc[ai][bj][m][0], v1 = acc[ai][bj][m][1];
                u32x4 w; w.x = pk2(v0[0], v0[1]); w.y = pk2(v0[2], v0[3]); w.z = pk2(v1[0], v1[1]); w.w = pk2(v1[2], v1[3]);
                *(u32x4*)(rowp + bj * HALF) = w; } }
}

struct EpiE0 {
    static constexpr bool PERM = true, AFTER_DRAIN = false;
    bf16_t* zab; bf16_t* xbcraw; bf16_t* xb; float* dtraw;
    DI void operator()(const f32x4 (&acc)[2][2][4][2], const Unit& u, int wr, int wc, int fr, int fq) const {
        const int pn = u.pn, row0 = u.pm * BM + wr * 64 + fr;
        bf16_t* base; int ld, colt;
        if (pn < 4) { base = zab; ld = 2048; colt = pn * 256; }
        else if (pn < 12) { base = xbcraw; ld = 2048; colt = (pn - 4) * 256; }
        else if (pn < 16) { base = zab; ld = 2048; colt = 1024 + (pn - 12) * 256; }
        else if (pn < 20) { base = xb; ld = 1024; colt = (pn - 16) * 256; }
        else {
            if (wc == 0) {
#pragma unroll
                for (int ai = 0; ai < 2; ++ai)
#pragma unroll
                    for (int m = 0; m < 4; ++m) { float* p = dtraw + (size_t)(row0 + ai * HALF + m * 16) * 32 + 8 * fq;
                        *(f32x4*)p = acc[ai][0][m][0]; *(f32x4*)(p + 4) = acc[ai][0][m][1]; }
            }
            return;
        }
        store_bf16_tile(acc, base, ld, row0, colt + wc * 32 + 8 * fq);
    }
};
struct EpiO {
    static constexpr bool PERM = true, AFTER_DRAIN = false;
    bf16_t* u1; const float* rope; int grow0;
    DI void operator()(const f32x4 (&acc)[2][2][4][2], const Unit& u, int wr, int wc, int fr_, int fq_) const {
        int lane; asm volatile("v_mbcnt_lo_u32_b32 %0, -1, 0\n\tv_mbcnt_hi_u32_b32 %0, -1, %0" : "=v"(lane));
        const int fr = lane & 15, fq = lane >> 4;
        const int gr0 = grow0 + u.pm * BM, pn = u.pn;
        const bool rot = gr0 >= R_CTX && (pn < 8 || (pn >= 16 && pn <= 20));
        const int rl0 = u.pm * BM + wr * 64 + fr, col0 = pn * 256 + wc * 32 + 8 * fq;
        if (!rot) { store_bf16_tile(acc, u1, N_O, rl0, col0); return; }
        const int axis = wc & 1;
        const bool upper = lane >= 32;
        const float sgn = upper ? 1.f : -1.f;
#pragma unroll
        for (int ai = 0; ai < 2; ++ai)
#pragma unroll
            for (int m = 0; m < 4; ++m) {
                const int rl = rl0 + ai * HALF + m * 16;
                const int t = (grow0 + rl - R_CTX) & 4095, pos = axis ? (t & 63) : (t >> 6);
                const float* cp = rope + pos * 16 + 8 * (fq & 1);
                const f32x4 c0 = *(const f32x4*)cp, c1 = *(const f32x4*)(cp + 4), s0 = *(const f32x4*)(cp + 1024) * sgn, s1 = *(const f32x4*)(cp + 1028) * sgn;
                bf16_t* rowp = u1 + (size_t)rl * N_O + col0;
#pragma unroll
                for (int bj = 0; bj < 2; ++bj) {
                    f32x4 o[2];
#pragma unroll
                    for (int n = 0; n < 2; ++n) { const f32x4 own = acc[ai][bj][m][n]; f32x4 par;
#pragma unroll
                        for (int q = 0; q < 4; ++q) { auto rr = __builtin_amdgcn_permlane32_swap(__float_as_uint(own[q]), __float_as_uint(own[q]), false, false); par[q] = __uint_as_float(upper ? rr[0] : rr[1]); }
                        o[n] = own * (n ? c1 : c0) + par * (n ? s1 : s0); }
                    u32x4 w; w.x = pk2(o[0][0], o[0][1]); w.y = pk2(o[0][2], o[0][3]); w.z = pk2(o[1][0], o[1][1]); w.w = pk2(o[1][2], o[1][3]);
                    *(u32x4*)(rowp + bj * HALF) = w;
                }
            }
    }
};
struct EpiPool {
    static constexpr bool PERM = true, AFTER_DRAIN = false;
    bf16_t* aout; const bf16_t* zab; const float* ssy;
    DI void operator()(const f32x4 (&acc)[2][2][4][2], const Unit& u, int wr, int wc, int fr_, int fq_) const {
        int lane; asm volatile("v_mbcnt_lo_u32_b32 %0, -1, 0\n\tv_mbcnt_hi_u32_b32 %0, -1, %0" : "=v"(lane));
        const int fr = lane & 15, fq = lane >> 4;
        const int row0 = u.pm * BM + wr * 64 + fr, col0 = u.pn * 256 + wc * 32 + 8 * fq;
#pragma unroll
        for (int ai = 0; ai < 2; ++ai)
#pragma unroll
            for (int m = 0; m < 4; ++m) { const size_t r = (size_t)(row0 + ai * HALF + m * 16); const float irs = sqrtf(ssy[r] * (1.f / 1024.f) + EPS);
#pragma unroll
                for (int bj = 0; bj < 2; ++bj) {
                    const size_t off = r * 2048 + 1024 + col0 + bj * HALF;
                    const u32x4 z = *(const u32x4*)(zab + off);
                    const f32x4 v0 = acc[ai][bj][m][0] * irs, v1 = acc[ai][bj][m][1] * irs;
                    u32x4 w; w.x = pk2(v0[0] * silu_f(lo_f(z.x)), v0[1] * silu_f(hi_f(z.x))); w.y = pk2(v0[2] * silu_f(lo_f(z.y)), v0[3] * silu_f(hi_f(z.y)));
                    w.z = pk2(v1[0] * silu_f(lo_f(z.z)), v1[1] * silu_f(hi_f(z.z))); w.w = pk2(v1[2] * silu_f(lo_f(z.w)), v1[3] * silu_f(hi_f(z.w)));
                    *(u32x4*)(aout + off) = w;
                    asm volatile("" ::: "memory"); } }
    }
};
template <bool L0>
struct EpiRes {
    static constexpr bool PERM = true, AFTER_DRAIN = false;
    const float* xp; const float* xs;
    float* out;
    const float* modl;
    int grow0;
    const float* ssy;
    bf16_t* x1b;
    bf16_t* x2b;
    DI void operator()(const f32x4 (&acc)[2][2][4][2], const Unit& u, int wr, int wc, int fr_, int fq_) const {
        int lane; asm volatile("v_mbcnt_lo_u32_b32 %0, -1, 0\n\tv_mbcnt_hi_u32_b32 %0, -1, %0" : "=v"(lane));
        const int fr = lane & 15, fq = lane >> 4;
        const int gr0 = grow0 + u.pm * BM;
        const int g = gr0 < R_CTX ? 8 : ((gr0 - R_CTX) >> 12);
        const float* gate = modl + g * 3072 + 2048;
        const int col0 = u.pn * 256 + wc * 32 + 8 * fq, rl = wr * 64 + fr;
        f32x4 gv[2][2];
#pragma unroll
        for (int bj = 0; bj < 2; ++bj) { gv[bj][0] = *(const f32x4*)(gate + col0 + bj * HALF); gv[bj][1] = *(const f32x4*)(gate + col0 + bj * HALF + 4); }
#pragma unroll
        for (int ai = 0; ai < 2; ++ai)
#pragma unroll
            for (int m = 0; m < 4; ++m) { const int rt = rl + ai * HALF + m * 16; const size_t loff = (size_t)(u.pm * BM + rt) * DM + col0;
                float rs = 1.f; if (L0) rs = rsqrtf(ssy[u.pm * BM + rt] * (1.f / 1024.f) + EPS);
#pragma unroll
                for (int bj = 0; bj < 2; ++bj) {
                    f32x4 x0, x1;
                    if (L0) { const float* xin = (gr0 < R_CTX ? xp + (size_t)gr0 * DM : xs + (size_t)(gr0 - R_CTX) * DM) + (size_t)rt * DM + col0 + bj * HALF;
                        x0 = *(const f32x4*)xin; x1 = *(const f32x4*)(xin + 4); }
                    else { const u32x4 xb = *(const u32x4*)(x1b + loff + bj * HALF); x0 = (f32x4){lo_f(xb.x), hi_f(xb.x), lo_f(xb.y), hi_f(xb.y)}; x1 = (f32x4){lo_f(xb.z), hi_f(xb.z), lo_f(xb.w), hi_f(xb.w)}; }
                    const f32x4 y0 = x0 + gv[bj][0] * (acc[ai][bj][m][0] * rs), y1 = x1 + gv[bj][1] * (acc[ai][bj][m][1] * rs);
                    u32x4 w; w.x = pk2(y0[0], y0[1]); w.y = pk2(y0[2], y0[3]); w.z = pk2(y1[0], y1[1]); w.w = pk2(y1[2], y1[3]);
                    *(u32x4*)((L0 ? x1b : x2b) + loff + bj * HALF) = w;
                }
                asm volatile("" ::: "memory"); }
    }
};
}
struct Params { const float* in[28]; float* out; unsigned char* ws; int ph_lo, ph_hi; };
struct Frame {
    ldsp lds; int tid, lane, wave, G, bid;
    const Params& p; float* out; unsigned char* ws; int probe;
};
enum { I_XP = 0, I_XS, I_SSDF, I_SSDB, I_CDK, I_CDV, I_CWK, I_CWV, I_C, I_CCTX, I_WADA, I_BADA, I_EWIN, I_ECONVW, I_ECONVB, I_EALOG, I_EDTB, I_ED, I_ENORMG,
       I_EPOOLW, I_EPOOLS, I_EWOUT, I_OWIN, I_OLAM, I_OSUBG, I_OSINK, I_OWOUT, I_FNORMG };

DI void transpose_item(const float* W, int ldw, int srcn0, int K, bf16_t* WT, int dstn0, int k0, LAS float* scr, int lane, const float* nscale = nullptr) {
    if (srcn0 >= 0) {
#pragma unroll 8
        for (int i = 0; i < 32; ++i) { const int kk = 2 * i + (lane >> 5); scr[kk * 33 + (lane & 31)] = W[(size_t)(k0 + kk) * ldw + srcn0 + (lane & 31)]; }
    } else {
#pragma unroll 8
        for (int i = 0; i < 32; ++i) { const int kk = 2 * i + (lane >> 5); scr[kk * 33 + (lane & 31)] = 0.f; }
    }
    asm volatile("s_waitcnt lgkmcnt(0)" ::: "memory");
    const int c = lane & 7;
#pragma unroll
    for (int j = 0; j < 4; ++j) { const int n = (lane >> 3) + 8 * j; const LAS float* s = scr + (8 * c) * 33 + n;
        const float sc = nscale ? nscale[n] : 1.f;
        u32x4 o; o.x = pk2(s[0 * 33] * sc, s[1 * 33] * sc); o.y = pk2(s[2 * 33] * sc, s[3 * 33] * sc); o.z = pk2(s[4 * 33] * sc, s[5 * 33] * sc); o.w = pk2(s[6 * 33] * sc, s[7 * 33] * sc);
        *(u32x4*)(WT + (size_t)(dstn0 + n) * K + k0 + 8 * c) = o; }
    asm volatile("s_waitcnt lgkmcnt(0)" ::: "memory");
}

DI void phase_p0(Frame& F) {
    if (F.bid < 192) {
        LAS float* sv = (LAS float*)F.lds;
        LAS float* red = (LAS float*)(F.lds + 40960);
        for (int i = F.tid; i < 9 * 1024; i += NTHREADS) { const int g = i >> 10, k = i & 1023; const float v = g < 8 ? F.p.in[I_C][g * 1024 + k] : F.p.in[I_CCTX][k]; sv[i] = silu_f(v); }
        __syncthreads();
        const int l = F.bid / 96, n0 = (F.bid % 96) * 32, kg = F.tid >> 5, c = F.tid & 31;
        const float* w = F.p.in[I_WADA] + (size_t)l * 1024 * 3072 + n0 + c;
        float acc[9];
#pragma unroll
        for (int g = 0; g < 9; ++g) acc[g] = 0.f;
#pragma unroll 4
        for (int kk = 0; kk < 64; ++kk) { const int k = kg * 64 + kk; const float wv = w[(size_t)k * 3072];
#pragma unroll
            for (int g = 0; g < 9; ++g) acc[g] += sv[g * 1024 + k] * wv; }
#pragma unroll
        for (int g = 0; g < 9; ++g) red[(kg * 9 + g) * 32 + c] = acc[g];
        __syncthreads();
        if (F.tid < 288) { const int g = F.tid >> 5, cc = F.tid & 31; float s = F.p.in[I_BADA][l * 3072 + n0 + cc];
#pragma unroll
            for (int q = 0; q < 16; ++q) s += red[(q * 9 + g) * 32 + cc];
            ((float*)(F.ws + WS_MOD))[(l * 9 + g) * 3072 + n0 + cc] = s; }
        __syncthreads();
    }
    if (F.bid == F.G - 1) {
        float* rc = (float*)(F.ws + WS_ROPE); float* rs = rc + 1024;
        for (int i = F.tid; i < 1024; i += NTHREADS) { const int pos = i >> 4, f = i & 15; const float inv = __builtin_amdgcn_exp2f(-(float)f * (13.287712379549449f / 16.f)); const float ang = (float)pos * inv; rc[i] = __cosf(ang); rs[i] = __sinf(ang); }
        if (F.tid == 0) { const float* lp = F.p.in[I_OLAM]; float s1 = 0.f, s2 = 0.f;
            for (int i = 0; i < 64; ++i) { s1 += lp[i] * lp[64 + i]; s2 += lp[128 + i] * lp[192 + i]; }
            float lam_init = 0.8f - 0.6f * 0.7408182206817179f; asm volatile("" : "+v"(lam_init));
            float* o = (float*)(F.ws + WS_LAM); o[0] = __expf(s1) - __expf(s2) + lam_init; o[1] = 1.f - lam_init; }
    }
    {
        LAS float* scr = (LAS float*)(F.lds + 65536 + F.wave * 8704);
        const int gw = F.bid * NWAVES + F.wave, NGW = F.G * NWAVES;
        for (int it = gw; it < 8192; it += NGW) {
            int r = it;
            if (r < 2688) { const int kb = r / 168, nb = r % 168; int src;
                if (nb < 96) src = nb * 32; else if (nb < 160) src = (nb + 1) * 32; else if (nb == 160) src = 3072; else src = -1;
                transpose_item(F.p.in[I_EWIN], 5152, src, 1024, (bf16_t*)(F.ws + WS_WT_IN_E), nb * 32, kb * 64, scr, F.lane); continue; }
            r -= 2688;
            if (r < 1024) { const int kb = r >> 5, nb = r & 31; transpose_item(F.p.in[I_EWOUT], 1024, nb * 32, 2048, (bf16_t*)(F.ws + WS_WT_OUT_E), nb * 32, kb * 64, scr, F.lane); continue; }
            r -= 1024;
            if (r < 3328) { const int kb = r / 208, nb = r % 208; transpose_item(F.p.in[I_OWIN], N_O, nb * 32, 1024, (bf16_t*)(F.ws + WS_WT_IN_O), nb * 32, kb * 64, scr, F.lane); continue; }
            r -= 3328;
            if (r < 1024) { const int kb = r >> 5, nb = r & 31; transpose_item(F.p.in[I_OWOUT], 1024, nb * 32, 2048, (bf16_t*)(F.ws + WS_WT_OUT_O), nb * 32, kb * 64, scr, F.lane); continue; }
            r -= 1024;
            { const int g = r >> 5, q = r & 31, kb = q >> 3, nb = q & 7;
              transpose_item(F.p.in[I_EPOOLW] + (size_t)g * 65536, 256, nb * 32, 256, (bf16_t*)(F.ws + WS_WT_POOL) + (size_t)g * 65536, nb * 32, kb * 64, scr, F.lane, F.p.in[I_EPOOLS] + g * 256 + nb * 32); }
        }
    }
    {
        const int gt = F.bid * NTHREADS + F.tid, NT = F.G * NTHREADS;
        for (int it = gt; it < 1310720; it += NT) {
            const float* src; bf16_t* dst; int o = it;
            if (o < 524288) { src = F.p.in[I_CDK]; dst = (bf16_t*)(F.ws + WS_CK); }
            else if (o < 1048576) { o -= 524288; src = F.p.in[I_CDV]; dst = (bf16_t*)(F.ws + WS_CV); }
            else if (o < 1179648) { o -= 1048576; src = F.p.in[I_CWK]; dst = (bf16_t*)(F.ws + WS_WK); }
            else { o -= 1179648; src = F.p.in[I_CWV]; dst = (bf16_t*)(F.ws + WS_WV); }
            const f32x4 a = *(const f32x4*)(src + (size_t)o * 8), b = *(const f32x4*)(src + (size_t)o * 8 + 4);
            u32x4 w; w.x = pk2(a[0], a[1]); w.y = pk2(a[2], a[3]); w.z = pk2(b[0], b[1]); w.w = pk2(b[2], b[3]);
            *(u32x4*)(dst + (size_t)o * 8) = w;
        }
    }
}

DI void phase_modnorm(Frame& F, int grp, int layer) {
    const int row0 = GRP_ROW0[grp], rows = GRP_ROWS[grp];
    const int gw = F.bid * NWAVES + F.wave, NGW = F.G * NWAVES;
    const float* mod = (const float*)(F.ws + WS_MOD) + layer * 9 * 3072;
    bf16_t* H = (bf16_t*)(F.ws + WS_REGA);
    for (int rl = gw; rl < rows; rl += 2 * NGW) {
        f32x4 v[2][4]; float s[2];
#pragma unroll
        for (int q = 0; q < 2; ++q) { const int grow = row0 + min(rl + q * NGW, rows - 1);
            if (layer == 0) { const float* xrow = grow < R_CTX ? F.p.in[I_XP] + (size_t)grow * DM : F.p.in[I_XS] + (size_t)(grow - R_CTX) * DM;
                const f32x4* xr = (const f32x4*)xrow + F.lane;
#pragma unroll
                for (int j = 0; j < 4; ++j) v[q][j] = xr[64 * j]; }
            else { const u32x2* xr = (const u32x2*)((const bf16_t*)(F.ws + WS_X1B) + (size_t)(grow - row0) * DM) + F.lane;
#pragma unroll
                for (int j = 0; j < 4; ++j) { const u32x2 w = xr[64 * j]; v[q][j] = (f32x4){lo_f(w.x), hi_f(w.x), lo_f(w.y), hi_f(w.y)}; } } }
#pragma unroll
        for (int q = 0; q < 2; ++q) { float t = 0.f;
#pragma unroll
            for (int j = 0; j < 4; ++j) t += (v[q][j].x * v[q][j].x + v[q][j].y * v[q][j].y) + (v[q][j].z * v[q][j].z + v[q][j].w * v[q][j].w);
            s[q] = t; }
#pragma unroll
        for (int o = 1; o < 64; o <<= 1) { s[0] += shfl_idx(s[0], F.lane ^ o); s[1] += shfl_idx(s[1], F.lane ^ o); }
#pragma unroll
        for (int q = 0; q < 2; ++q) { const int rq = min(rl + q * NGW, rows - 1), grow = row0 + rq; const RowInfo ri = rowinfo(grow);
            const float rstd = rsqrtf(s[q] * (1.f / DM) + EPS);
            const float* sh = mod + ri.g * 3072; const float* sc = sh + 1024;
            u32x2* o8 = (u32x2*)(H + (size_t)rq * DM) + F.lane;
#pragma unroll
            for (int j = 0; j < 4; ++j) { const f32x4 a = *((const f32x4*)sh + F.lane + 64 * j), b = *((const f32x4*)sc + F.lane + 64 * j);
                const f32x4 y = v[q][j] * rstd * (b + 1.f) + a; u32x2 w; w.x = pk2(y.x, y.y); w.y = pk2(y.z, y.w); o8[64 * j] = w; } }
    }
}

DI float softplus_f(float x) { return x > 15.f ? x : (x < -15.f ? __expf(x) : __logf(1.f + __expf(x))); }
DI void acc8(float (&s)[8], const u32x4 xv, const float sg) {
    s[0] += sg * lo_f(xv.x); s[1] += sg * hi_f(xv.x); s[2] += sg * lo_f(xv.y); s[3] += sg * hi_f(xv.y); s[4] += sg * lo_f(xv.z); s[5] += sg * hi_f(xv.z); s[6] += sg * lo_f(xv.w); s[7] += sg * hi_f(xv.w);
}
template <int W>
DI void pool_task(const bf16_t* xp, bf16_t* op, const int t0, const int T) {
    constexpr int LEFT = W / 2, RIGHT = W - 1 - LEFT, S = 16, NR = S + W - 1;
    const u32x4 zero4 = {0u, 0u, 0u, 0u};
    u32x4 r[NR];
#pragma unroll
    for (int k = 0; k < NR; ++k) { const int pos = t0 - LEFT + k; r[k] = (pos >= 0 && pos < T) ? *(const u32x4*)(xp + (ptrdiff_t)(k - LEFT) * 1024) : zero4; }
    float s[8];
#pragma unroll
    for (int e = 0; e < 8; ++e) s[e] = 0.f;
#pragma unroll
    for (int k = 0; k < W; ++k) acc8(s, r[k], 1.f);
#pragma unroll
    for (int i = 0; i < S; ++i) {
        const int t = t0 + i, lo = max(t - LEFT, 0), hi = min(t + RIGHT + 1, T);
        const float inv = 1.f / (float)(hi - lo);
        const u32x4 xs = r[i + LEFT];
        u32x4 o; o.x = pk2(s[0] * inv - lo_f(xs.x), s[1] * inv - hi_f(xs.x)); o.y = pk2(s[2] * inv - lo_f(xs.y), s[3] * inv - hi_f(xs.y));
        o.z = pk2(s[4] * inv - lo_f(xs.z), s[5] * inv - hi_f(xs.z)); o.w = pk2(s[6] * inv - lo_f(xs.w), s[7] * inv - hi_f(xs.w));
        *(u32x4*)(op + (size_t)i * 1024) = o;
        if (i + 1 < S) { acc8(s, r[i + W], 1.f); acc8(s, r[i], -1.f); }
    }
}
DI void phase_conv(Frame& F, int grp) {
    const int row0 = GRP_ROW0[grp], rows = GRP_ROWS[grp];
    const int gt = F.bid * NTHREADS + F.tid, NT = F.G * NTHREADS;
    { float* ssy = (float*)(F.ws + WS_SSY); float* ss1 = (float*)(F.ws + WS_SS1); for (int i = gt; i < rows; i += NT) { ssy[i] = 0.f; ss1[i] = 0.f; } }
    const bf16_t* xb = (const bf16_t*)(F.ws + WS_XB); bf16_t* pooled = (bf16_t*)(F.ws + WS_POOLED);
    const int nstrip = rows / 16;
    for (int task = gt; task < nstrip * 128; task += NT) {
        const int g = task / (nstrip * 32), rem = task - g * (nstrip * 32), strip = rem >> 5, c0 = g * 256 + (rem & 31) * 8, rl0 = strip * 16;
        const RowInfo ri = rowinfo(row0 + rl0);
        const bf16_t* xp = xb + (size_t)rl0 * 1024 + c0; bf16_t* op = pooled + (size_t)rl0 * 1024 + c0;
        if (g == 0) pool_task<2>(xp, op, ri.t, ri.T); else if (g == 1) pool_task<4>(xp, op, ri.t, ri.T); else if (g == 2) pool_task<8>(xp, op, ri.t, ri.T); else pool_task<16>(xp, op, ri.t, ri.T);
    }
    const float* dtraw = (const float*)(F.ws + WS_DTRAW); float* dtv = (float*)(F.ws + WS_DTV); float* acs = (float*)(F.ws + WS_ACS);
    const int nch = rows >> 7;
    LAS float* tot = (LAS float*)F.lds;
    for (int ci = F.bid; ci < nch; ci += F.G) {
        const int j = F.tid & 31, seg = F.tid >> 5; const size_t r0 = (size_t)ci * 128 + seg * 8;
        const float bias = F.p.in[I_EDTB][j], A = -__expf(F.p.in[I_EALOG][j]);
        float d[8], inc[8], run = 0.f;
#pragma unroll
        for (int i = 0; i < 8; ++i) d[i] = dtraw[(r0 + i) * 32 + j];
#pragma unroll
        for (int i = 0; i < 8; ++i) { d[i] = softplus_f(d[i] + bias); run += d[i] * A; inc[i] = run; }
        tot[seg * 32 + j] = run;
        __syncthreads();
        float before = 0.f, total = 0.f;
#pragma unroll
        for (int s = 0; s < 16; ++s) { const float v = tot[s * 32 + j]; total += v; before += s < seg ? v : 0.f; }
        __syncthreads();
#pragma unroll
        for (int i = 0; i < 8; ++i) { dtv[(r0 + i) * 32 + j] = d[i]; acs[(r0 + i) * 32 + j] = j < 16 ? inc[i] + before : total - (inc[i] + before) + d[i] * A; }
    }
}

DI void phase_bias1(Frame& F) {
    const bf16_t* wt = (const bf16_t*)(F.ws + WS_WT_IN_O); const float* mod1 = (const float*)(F.ws + WS_MOD) + 9 * 3072; float* b1 = (float*)(F.ws + WS_BIAS1);
    const int gw = F.bid * NWAVES + F.wave, NGW = F.G * NWAVES;
    for (int n = gw; n < N_O; n += NGW) {
        const u32x4 w0 = *(const u32x4*)(wt + (size_t)n * 1024 + F.lane * 16), w1 = *(const u32x4*)(wt + (size_t)n * 1024 + F.lane * 16 + 8);
        const float wv[16] = {lo_f(w0.x), hi_f(w0.x), lo_f(w0.y), hi_f(w0.y), lo_f(w0.z), hi_f(w0.z), lo_f(w0.w), hi_f(w0.w), lo_f(w1.x), hi_f(w1.x), lo_f(w1.y), hi_f(w1.y), lo_f(w1.z), hi_f(w1.z), lo_f(w1.w), hi_f(w1.w)};
#pragma unroll 1
        for (int g = 0; g < 9; ++g) { const float* sh = mod1 + g * 3072 + F.lane * 16; float s = 0.f;
#pragma unroll
            for (int q = 0; q < 4; ++q) { const f32x4 v = *(const f32x4*)(sh + 4 * q); s += (v.x * wv[4 * q] + v.y * wv[4 * q + 1]) + (v.z * wv[4 * q + 2] + v.w * wv[4 * q + 3]); }
            s = wave_sum(s, F.lane);
            if (F.lane == 0) b1[g * N_O + n] = s; }
    }
}
template <int NR = 8>
DI void conv_rows_to_lds(const bf16_t* xraw, const float* cw, const float* cb, int rbase, int t0, int T, int col0, int rb, ldsp dst, int dstride) {
    const bf16_t* xp = xraw + (size_t)(rbase + NR * rb) * 2048 + col0;
    const u32x4 zero4 = {0u, 0u, 0u, 0u};
    u32x4 r[NR + 4];
#pragma unroll
    for (int k = 0; k < NR + 4; ++k) { const int pos = t0 + NR * rb + k - 2; r[k] = (pos >= 0 && pos < T) ? *(const u32x4*)(xp + (ptrdiff_t)(k - 2) * 2048) : zero4; }
    float w[5][8], bias[8];
#pragma unroll
    for (int k = 0; k < 5; ++k) { const f32x4 w0 = *(const f32x4*)(cw + k * 2048 + col0), w1 = *(const f32x4*)(cw + k * 2048 + col0 + 4);
        w[k][0] = w0.x; w[k][1] = w0.y; w[k][2] = w0.z; w[k][3] = w0.w; w[k][4] = w1.x; w[k][5] = w1.y; w[k][6] = w1.z; w[k][7] = w1.w; }
    { const f32x4 b0 = *(const f32x4*)(cb + col0), b1 = *(const f32x4*)(cb + col0 + 4); bias[0] = b0.x; bias[1] = b0.y; bias[2] = b0.z; bias[3] = b0.w; bias[4] = b1.x; bias[5] = b1.y; bias[6] = b1.z; bias[7] = b1.w; }
#pragma unroll
    for (int i = 0; i < NR; ++i) {
        float acc[8];
#pragma unroll
        for (int e = 0; e < 8; ++e) acc[e] = bias[e];
#pragma unroll
        for (int k = 0; k < 5; ++k) { const u32x4 xv = r[i + k];
            acc[0] += lo_f(xv.x) * w[k][0]; acc[1] += hi_f(xv.x) * w[k][1]; acc[2] += lo_f(xv.y) * w[k][2]; acc[3] += hi_f(xv.y) * w[k][3];
            acc[4] += lo_f(xv.z) * w[k][4]; acc[5] += hi_f(xv.z) * w[k][5]; acc[6] += lo_f(xv.w) * w[k][6]; acc[7] += hi_f(xv.w) * w[k][7]; }
        u32x4 o; o.x = pk2(silu_f(acc[0]), silu_f(acc[1])); o.y = pk2(silu_f(acc[2]), silu_f(acc[3])); o.z = pk2(silu_f(acc[4]), silu_f(acc[5])); o.w = pk2(silu_f(acc[6]), silu_f(acc[7]));
        lds_st128(dst + (NR * rb + i) * dstride, o);
    }
}

DI void phase_states(Frame& F, int grp) {
    const int row0 = GRP_ROW0[grp], rows = GRP_ROWS[grp], nch = rows >> 7;
    const bf16_t* xraw = (const bf16_t*)(F.ws + WS_XBCRAW);
    const float* dtv = (const float*)(F.ws + WS_DTV); const float* acs = (const float*)(F.ws + WS_ACS);
    float* decay = (float*)(F.ws + WS_DECAY); bf16_t* states = (bf16_t*)(F.ws + WS_REGA);
    const ldsp Bimg = F.lds, ximg = F.lds + 40960, xw = F.lds + 114688; LAS float* wts = (LAS float*)(F.lds + 139264);
    const int lane = F.lane, h = lane >> 5, i16 = lane & 15, qq = i16 >> 2, pp = i16 & 3, blk = (lane >> 4) & 1;
    for (int unit = F.bid; unit < nch * 4; unit += F.G) {
        const int ci = unit >> 2, g = unit & 3, rbase = ci * 128;
        { const RowInfo ri = rowinfo(row0 + rbase);
          conv_rows_to_lds<8>(xraw, F.p.in[I_ECONVW], F.p.in[I_ECONVB], rbase, ri.t, ri.T, g * 256 + (F.tid & 31) * 8, F.tid >> 5, ximg + (F.tid & 31) * 16, 576);
          conv_rows_to_lds<4>(xraw, F.p.in[I_ECONVW], F.p.in[I_ECONVB], rbase, ri.t, ri.T, 1024 + g * 128 + (F.tid & 15) * 8, F.tid >> 4, Bimg + (F.tid & 15) * 16, 320); }
#pragma unroll
        for (int i = 0; i < 2; ++i) { const int v = F.tid + 512 * i, hd = v >> 7, l = v & 127, j = (hd >> 2) * 16 + g * 4 + (hd & 3);
            const float ref = acs[(size_t)(rbase + ((hd >> 2) ? 0 : 127)) * 32 + j];
            wts[v] = __expf(ref - acs[(size_t)(rbase + l) * 32 + j]) * dtv[(size_t)(rbase + l) * 32 + j]; }
        if (F.tid < 8) { const int hd = F.tid, j = (hd >> 2) * 16 + g * 4 + (hd & 3); decay[ci * 32 + j] = __expf(acs[(size_t)(rbase + ((hd >> 2) ? 0 : 127)) * 32 + j]); }
        __syncthreads();
        for (int hd = 0; hd < 8; ++hd) {
            const int r = hd & 3, j = (hd >> 2) * 16 + g * 4 + r;
            { const int l = F.tid >> 2, pq = F.tid & 3; const float w = wts[hd * 128 + l];
              const ldsp src = ximg + l * 576 + (r * 64 + pq * 16) * 2; const ldsp dst = xw + l * 192 + pq * 32;
#pragma unroll
              for (int q = 0; q < 2; ++q) { const u32x4 v = *(const LAS u32x4*)(src + q * 16); u32x4 o;
                  o.x = pk2(lo_f(v.x) * w, hi_f(v.x) * w); o.y = pk2(lo_f(v.y) * w, hi_f(v.y) * w); o.z = pk2(lo_f(v.z) * w, hi_f(v.z) * w); o.w = pk2(lo_f(v.w) * w, hi_f(v.w) * w);
                  lds_st128(dst + q * 16, o); } }
            __syncthreads();
            const int pt = F.wave >> 2, nt = F.wave & 3;
            f32x16 acc;
#pragma unroll
            for (int i = 0; i < 16; ++i) acc[i] = 0.f;
            const ldsp ab = xw + (8 * h + qq) * 192 + (pt * 32 + 16 * blk) * 2 + 8 * pp;
            const ldsp bb = Bimg + (8 * h + qq) * 320 + (nt * 32 + 16 * blk) * 2 + 8 * pp;
#pragma unroll
            for (int ks = 0; ks < 8; ++ks) {
                const bf16x8 a = cat8(lds_tr(ab + ks * 16 * 192), lds_tr(ab + ks * 16 * 192 + 4 * 192));
                const bf16x8 b = cat8(lds_tr(bb + ks * 16 * 320), lds_tr(bb + ks * 16 * 320 + 4 * 320));
                acc = MFMA32(a, b, acc);
            }
            bf16_t* so = states + ((size_t)(ci * 32 + j) * 64 + pt * 32) * 128 + nt * 32 + (lane & 31);
#pragma unroll
            for (int i = 0; i < 16; ++i) so[(size_t)crow(i, h) * 128] = f2bf(acc[i]);
            __syncthreads();
        }
    }
}

DI void phase_scan(Frame& F, int grp) {
    bf16_t* st = (bf16_t*)(F.ws + WS_REGA); const float* decay = (const float*)(F.ws + WS_DECAY);
    const int nlat = 4, nctx = grp == 0 ? 16 : 0;
    const int gt = F.bid * NTHREADS + F.tid, NT = F.G * NTHREADS;
    const int nitems = (nlat + nctx) * 32768;
    for (int it = gt; it < nitems; it += NT) {
        int seq, c0, nc, lat; int rem;
        if (it < nlat * 32768) { seq = it >> 15; rem = it & 32767; lat = 1; nc = 32; c0 = (grp == 0 ? 32 : 0) + 32 * seq; }
        else { const int o = it - nlat * 32768; seq = o >> 15; rem = o & 32767; lat = 0; nc = 2; c0 = 2 * seq; }
        const int j = rem >> 10, e = (rem & 1023) * 8, dir = j >> 4, head = j & 15;
        float hv[8];
        if (lat) { const int b = grp * 4 + seq; const float* s0 = (dir ? F.p.in[I_SSDB] : F.p.in[I_SSDF]) + (size_t)(b * 16 + head) * 8192 + e;
            const f32x4 a = *(const f32x4*)s0, bq = *(const f32x4*)(s0 + 4); hv[0] = a.x; hv[1] = a.y; hv[2] = a.z; hv[3] = a.w; hv[4] = bq.x; hv[5] = bq.y; hv[6] = bq.z; hv[7] = bq.w; }
        else {
#pragma unroll
            for (int i = 0; i < 8; ++i) hv[i] = 0.f; }
        const int cs = dir ? -1 : 1, cb = c0 + (dir ? nc - 1 : 0);
        u32x4 win[4]; float dwin[4];
#pragma unroll
        for (int q = 0; q < 4; ++q) if (q < nc) { const int c = cb + cs * q; win[q] = *(const u32x4*)(st + (size_t)(c * 32 + j) * 8192 + e); dwin[q] = decay[c * 32 + j]; }
        for (int k0 = 0; k0 < nc; k0 += 4) {
#pragma unroll
            for (int q = 0; q < 4; ++q) {
                const int k = k0 + q;
                if (k < nc) {
                    const int c = cb + cs * k;
                    bf16_t* p = st + (size_t)(c * 32 + j) * 8192 + e;
                    const u32x4 sv = win[q]; const float d = dwin[q];
                    if (k + 4 < nc) { const int cn = cb + cs * (k + 4); win[q] = *(const u32x4*)(st + (size_t)(cn * 32 + j) * 8192 + e); dwin[q] = decay[cn * 32 + j]; }
                    u32x4 o; o.x = pk2(hv[0], hv[1]); o.y = pk2(hv[2], hv[3]); o.z = pk2(hv[4], hv[5]); o.w = pk2(hv[6], hv[7]);
                    *(u32x4*)p = o;
                    hv[0] = hv[0] * d + lo_f(sv.x); hv[1] = hv[1] * d + hi_f(sv.x); hv[2] = hv[2] * d + lo_f(sv.y); hv[3] = hv[3] * d + hi_f(sv.y);
                    hv[4] = hv[4] * d + lo_f(sv.z); hv[5] = hv[5] * d + hi_f(sv.z); hv[6] = hv[6] * d + lo_f(sv.w); hv[7] = hv[7] * d + hi_f(sv.w);
                }
            }
        }
        if (!lat) { float* o = F.out + (dir ? OUT_SSD_B : OUT_SSD_F) + (size_t)(seq * 16 + head) * 8192 + e;
            *(f32x4*)o = (f32x4){hv[0], hv[1], hv[2], hv[3]}; *(f32x4*)(o + 4) = (f32x4){hv[4], hv[5], hv[6], hv[7]}; }
    }
}

DI void phase_y(Frame& F, int grp) {
    const int row0 = GRP_ROW0[grp], rows = GRP_ROWS[grp], nch = rows >> 7;
    const bf16_t* xraw = (const bf16_t*)(F.ws + WS_XBCRAW);
    const float* dtv = (const float*)(F.ws + WS_DTV); const float* acs = (const float*)(F.ws + WS_ACS);
    const bf16_t* hprev = (const bf16_t*)(F.ws + WS_REGA);
    const bf16_t* zab = (const bf16_t*)(F.out + OUT_X + (size_t)row0 * DM);
    bf16_t* aout = (bf16_t*)(F.ws + WS_AOUT);
    const ldsp Bimg = F.lds, Cimg = F.lds + 34816, ximg = F.lds + 69632; LAS float* arr = (LAS float*)(F.lds + 143360);
    const int lane = F.lane, h = lane >> 5, r32 = lane & 31, i16 = lane & 15, qq = i16 >> 2, pp = i16 & 3, blk = (lane >> 4) & 1;
    const int lt = F.wave & 3, pt = F.wave >> 2;
    for (int unit = F.bid; unit < nch * 4; unit += F.G) {
        const int ci = unit >> 2, g = unit & 3, rbase = ci * 128;
        { const RowInfo ri = rowinfo(row0 + rbase);
#pragma unroll 1
          for (int id = F.tid; id < 1024; id += 512) { const int chunk = id & 63, rb = id >> 6;
              if (chunk < 16) conv_rows_to_lds(xraw, F.p.in[I_ECONVW], F.p.in[I_ECONVB], rbase, ri.t, ri.T, 1024 + g * 128 + chunk * 8, rb, Bimg + chunk * 16, 272);
              else if (chunk < 32) conv_rows_to_lds(xraw, F.p.in[I_ECONVW], F.p.in[I_ECONVB], rbase, ri.t, ri.T, 1536 + g * 128 + (chunk - 16) * 8, rb, Cimg + (chunk - 16) * 16, 272);
              else conv_rows_to_lds(xraw, F.p.in[I_ECONVW], F.p.in[I_ECONVB], rbase, ri.t, ri.T, g * 256 + (chunk - 32) * 8, rb, ximg + (chunk - 32) * 16, 576); } }
#pragma unroll
        for (int i = 0; i < 4; ++i) { const int v = F.tid + 512 * i, kind = v >> 9, r = (v >> 7) & 3, l = v & 127, j = (kind & 1) * 16 + g * 4 + r;
            arr[v] = (kind < 2 ? acs : dtv)[(size_t)(rbase + l) * 32 + j]; }
#pragma unroll
        for (int i = 0; i < 2; ++i) { const int v = F.tid + 512 * i, dirb = v >> 9, r = (v >> 7) & 3, sidx = v & 127, j = dirb * 16 + g * 4 + r;
            const int e = dirb ? (sidx & ~31) : (sidx | 31);
            arr[2048 + v] = __expf(acs[(size_t)(rbase + e) * 32 + j] - acs[(size_t)(rbase + sidx) * 32 + j]) * dtv[(size_t)(rbase + sidx) * 32 + j]; }
        __syncthreads();
        const int l = lt * 32 + r32;
        const ldsp cfp = Cimg + l * 272 + 8 * h * 2;
        const size_t rl = (size_t)(rbase + l);
        f32x16 cbt[4];
#pragma unroll
        for (int st = 0; st < 4; ++st) {
#pragma unroll
            for (int i = 0; i < 16; ++i) cbt[st][i] = 0.f;
            const ldsp bfp = Bimg + (st * 32 + r32) * 272 + 8 * h * 2;
#pragma unroll
            for (int ks = 0; ks < 8; ++ks) cbt[st] = MFMA32(lds_ld128(bfp + 32 * ks), lds_ld128(cfp + 32 * ks), cbt[st]);
        }
        __syncthreads();
#pragma unroll 1
        for (int r = 0; r < 4; ++r) {
            const int head = g * 4 + r;
            const bf16_t* hf = hprev + ((size_t)(ci * 32 + head) * 64 + pt * 32 + r32) * 128 + 8 * h;
            const bf16_t* hb = hf + (size_t)16 * 8192;
            bf16x8 hfv[8];
#pragma unroll
            for (int ks = 0; ks < 8; ++ks) hfv[ks] = *(const bf16x8*)(hf + 16 * ks);

            const float af_l = arr[(0 * 4 + r) * 128 + l], ab_l = arr[(1 * 4 + r) * 128 + l];
            f32x16 yd;
#pragma unroll
            for (int i = 0; i < 16; ++i) yd[i] = 0.f;
#pragma unroll
            for (int st = 0; st < 4; ++st) {
                const LAS float* as_ = arr + r * 128 + st * 32 + 4 * h;
                f32x16 gm;
                if (st < lt) {
                    const float rf = __expf(fminf(af_l - arr[(0 * 4 + r) * 128 + st * 32 + 31], 0.f));
#pragma unroll
                    for (int q = 0; q < 4; ++q) { const f32x4 cfv = *(const LAS f32x4*)(as_ + 4 * 512 + 8 * q);
#pragma unroll
                        for (int e = 0; e < 4; ++e) gm[4 * q + e] = cbt[st][4 * q + e] * (rf * cfv[e]); }
                } else if (st > lt) {
                    const float rf = __expf(fminf(ab_l - arr[(1 * 4 + r) * 128 + st * 32], 0.f));
#pragma unroll
                    for (int q = 0; q < 4; ++q) { const f32x4 cfv = *(const LAS f32x4*)(as_ + 5 * 512 + 8 * q);
#pragma unroll
                        for (int e = 0; e < 4; ++e) gm[4 * q + e] = cbt[st][4 * q + e] * (rf * cfv[e]); }
                } else {
                    int dq = r32 - 4 * h; asm volatile("" : "+v"(dq));
#pragma unroll
                    for (int i = 0; i < 16; ++i) { const int so = (i & 3) + 8 * (i >> 2);
                        const float ef = __expf(fminf(af_l - as_[so], 0.f)) * as_[2 * 512 + so];
                        const float eb = __expf(fminf(ab_l - as_[1 * 512 + so], 0.f)) * as_[3 * 512 + so];
                        gm[i] = cbt[st][i] * ((dq >= so ? ef : 0.f) + (dq <= so ? eb : 0.f)); }
                }
#pragma unroll
                for (int k2 = 0; k2 < 2; ++k2) {
                    const ldsp xa = ximg + (st * 32 + 16 * k2 + 4 * h + qq) * 576 + (r * 64 + pt * 32 + 16 * blk) * 2 + 8 * pp;
                    yd = MFMA32(cat8(lds_tr(xa), lds_tr(xa + 8 * 576)), pack8(gm, k2), yd);
                }
            }
            f32x16 tf, tb;
#pragma unroll
            for (int i = 0; i < 16; ++i) { tf[i] = 0.f; tb[i] = 0.f; }
#pragma unroll
            for (int ks = 0; ks < 8; ++ks) tf = MFMA32(hfv[ks], lds_ld128(cfp + 32 * ks), tf);
#pragma unroll
            for (int ks = 0; ks < 8; ++ks) tb = MFMA32(*(const bf16x8*)(hb + 16 * ks), lds_ld128(cfp + 32 * ks), tb);
            const float ef_l = __expf(af_l), eb_l = __expf(ab_l), Dh = F.p.in[I_ED][head];
            LAS float* ystg = (LAS float*)Bimg;
#pragma unroll
            for (int q4 = 0; q4 < 4; ++q4) {
                const int p0 = pt * 32 + 8 * q4 + 4 * h;
                const u32x2 xv = *(const LAS u32x2*)(ximg + l * 576 + (r * 64 + p0) * 2);
                f32x4 yv;
                yv[0] = yd[4 * q4 + 0] + tf[4 * q4 + 0] * ef_l + tb[4 * q4 + 0] * eb_l + Dh * lo_f(xv.x);
                yv[1] = yd[4 * q4 + 1] + tf[4 * q4 + 1] * ef_l + tb[4 * q4 + 1] * eb_l + Dh * hi_f(xv.x);
                yv[2] = yd[4 * q4 + 2] + tf[4 * q4 + 2] * ef_l + tb[4 * q4 + 2] * eb_l + Dh * lo_f(xv.y);
                yv[3] = yd[4 * q4 + 3] + tf[4 * q4 + 3] * ef_l + tb[4 * q4 + 3] * eb_l + Dh * hi_f(xv.y);
                *(LAS f32x4*)(ystg + l * 68 + p0) = yv;
            }
            __syncthreads();
            {
                const int row = F.tid >> 2, c16 = (F.tid & 3) * 16; const size_t rg = (size_t)(rbase + row);
                const u32x4 z0 = *(const u32x4*)(zab + rg * 2048 + head * 64 + c16), z1 = *(const u32x4*)(zab + rg * 2048 + head * 64 + c16 + 8);
                const unsigned zz[8] = {z0.x, z0.y, z0.z, z0.w, z1.x, z1.y, z1.z, z1.w};
                float ss = 0.f; unsigned ow[8];
#pragma unroll
                for (int q = 0; q < 4; ++q) { const f32x4 yv = *(const LAS f32x4*)(ystg + row * 68 + c16 + 4 * q); const f32x4 gn = *(const f32x4*)(F.p.in[I_ENORMG] + head * 64 + c16 + 4 * q);
                    const float v0 = yv[0] * silu_f(lo_f(zz[2 * q])), v1 = yv[1] * silu_f(hi_f(zz[2 * q])), v2 = yv[2] * silu_f(lo_f(zz[2 * q + 1])), v3 = yv[3] * silu_f(hi_f(zz[2 * q + 1]));
                    ss += (v0 * v0 + v1 * v1) + (v2 * v2 + v3 * v3);
                    ow[2 * q] = pk2(v0 * gn.x, v1 * gn.y); ow[2 * q + 1] = pk2(v2 * gn.z, v3 * gn.w); }
                *(u32x4*)(aout + rg * 2048 + head * 64 + c16) = (u32x4){ow[0], ow[1], ow[2], ow[3]}; *(u32x4*)(aout + rg * 2048 + head * 64 + c16 + 8) = (u32x4){ow[4], ow[5], ow[6], ow[7]};
                ss += shfl_idx(ss, F.lane ^ 1); ss += shfl_idx(ss, F.lane ^ 2);
                if ((F.tid & 3) == 0 && !F.probe) atomicAdd((float*)(F.ws + WS_SSY) + rg, ss);
            }
            __syncthreads();
        }
        __syncthreads();
    }
}
DI void phase_cachecopy(Frame& F) {
    const bf16_t* u1 = (const bf16_t*)(F.ws + WS_U);
    const int gt = F.bid * NTHREADS + F.tid, NT = F.G * NTHREADS;
    for (int it = gt; it < R_CTX * 320; it += NT) {
        const int row = it / 320, ch = it - row * 320, b = row >> 8, t = row & 255;
        int col; float* o;
        if (ch < 128) { col = 1024 + ch * 8; o = F.out + OUT_DIFF_K + ((size_t)(b * 8 + (ch >> 4)) * 256 + t) * 128 + (ch & 15) * 8; }
        else if (ch < 256) { const int c2 = ch - 128; col = 2048 + c2 * 8; o = F.out + OUT_DIFF_V + ((size_t)(b * 8 + (c2 >> 4)) * 256 + t) * 128 + (c2 & 15) * 8; }
        else if (ch < 288) { const int c2 = ch - 256; col = 5120 + c2 * 8; o = F.out + OUT_WIN_K + ((size_t)(b * 4 + (c2 >> 3)) * 256 + t) * 64 + (c2 & 7) * 8; }
        else { const int c2 = ch - 288; col = 5376 + c2 * 8; o = F.out + OUT_WIN_V + ((size_t)(b * 4 + (c2 >> 3)) * 256 + t) * 64 + (c2 & 7) * 8; }
        const u32x4 v = *(const u32x4*)(u1 + (size_t)row * N_O + col);
        *(f32x4*)o = (f32x4){lo_f(v.x), hi_f(v.x), lo_f(v.y), hi_f(v.y)}; *(f32x4*)(o + 4) = (f32x4){lo_f(v.z), hi_f(v.z), lo_f(v.w), hi_f(v.w)};
    }
}

struct AttnSeg { unsigned k, v; int ldk, ldv, nt; };
struct AttnEpi { unsigned aout, z; float lam, oml; };

#ifndef ATT_LEAD
#define ATT_LEAD(w) ((w) < 4)
#endif
#ifndef ATT_PRIO
#define ATT_PRIO 0
#endif
constexpr float ATT_THR = 8.f;
#ifndef ATT_ROT
#define ATT_ROT(qb) ((2 * (qb)) % 72)
#endif
#ifndef ATT_LA
#define ATT_LA 4
#endif
#ifndef ATT_VD
#define ATT_VD 1
#endif
DI void glds16(const void* gsrc, unsigned lds_dst) { unsigned keep;
    asm volatile("s_mov_b32 %0, m0\n\ts_mov_b32 m0, %2\n\ts_nop 0\n\tglobal_load_lds_dwordx4 %1, off\n\ts_mov_b32 m0, %0" : "=&s"(keep) : "v"(gsrc), "s"(lds_dst) : "memory"); }
template <int DV, bool WIN> DI void attn_epilogue(Frame& F, f32x16 (&O)[DV / 32], float lsum, float m, float sink_l2, const AttnEpi E);
template <int DV, int KSLOTS, bool WIN, int PM = 0, bool QPRE = false>
DI void attn_unit(Frame& F, const unsigned qoff, const AttnSeg s0, const AttnSeg s1, int qpos0, int kpos1, bool maskwin, float sink_l2, const AttnEpi E, const int rot, u32x4 (&qpre)[4], const unsigned qnext, const bool more) {
    constexpr int LA = ATT_LA, KR = LA, VR = LA + 1;
    constexpr int KIMG = 8192, KSTAGE = KSLOTS * KIMG, VROW = DV * 2, VSTAGE = 64 * VROW, VBASE = KR * KSTAGE, NDV = DV / 32;
    static_assert(VBASE + VR * VSTAGE <= LDS_BYTES - 8192, "attention rings exceed LDS");
    constexpr int VD = ATT_VD;
    constexpr int VP = VSTAGE / 8192, OPS = KSLOTS + VP;
    int lane; asm volatile("v_mbcnt_lo_u32_b32 %0, -1, 0\n\tv_mbcnt_hi_u32_b32 %0, -1, %0" : "=v"(lane));
    const int wave = F.wave, slot = wave & 1, qb = wave >> 1;
    const int h = lane >> 5, r32 = lane & 31, i16 = lane & 15, qq = i16 >> 2, pp = i16 & 3, blk = (lane >> 4) & 1;
    const int NT = PM == 7 ? (s0.nt + s1.nt) / 2 : s0.nt + s1.nt;
    const unsigned lds0 = (unsigned)(uintptr_t)F.lds;
    const int dk_row = 8 * wave + (lane >> 3), dk_col = (((lane & 7) ^ ((dk_row >> 1) & 7)) * 8);
    const int dv_row = DV == 128 ? 4 * wave + (lane >> 4) : 8 * wave + (lane >> 3);
    const int dv_col = DV == 128 ? (((((lane & 15) >> 2) ^ (dv_row & 3)) * 32) + (lane & 3) * 8) : (((((lane & 7) >> 2) ^ ((dv_row >> 1) & 1)) * 32) + (lane & 3) * 8);
#define ATT_DMA(tt0, ks_, vs_) do { int tr_ = (tt0) + rot; tr_ = tr_ >= NT ? tr_ - NT : tr_; const bool in0 = tr_ < s0.nt; const int ldk_ = in0 ? s0.ldk : s1.ldk, ldv_ = in0 ? s0.ldv : s1.ldv; const int tl = in0 ? tr_ : tr_ - s0.nt; \
        const char* kb_ = (const char*)F.ws + (in0 ? s0.k : s1.k) + (size_t)tl * 128 * ldk_; const char* vb_ = (const char*)F.ws + (in0 ? s0.v : s1.v) + (size_t)tl * 128 * ldv_; \
        const unsigned ko_ = (unsigned)(dk_row * ldk_ + dk_col) * 2u; \
        _Pragma("unroll") for (int s_ = 0; s_ < KSLOTS; ++s_) glds16(kb_ + ko_ + s_ * 128, (unsigned)__builtin_amdgcn_readfirstlane((int)(lds0 + (ks_) * KSTAGE + s_ * KIMG + wave * 1024))); \
        const unsigned vo_ = (unsigned)(dv_row * ldv_ + dv_col) * 2u; \
        _Pragma("unroll") for (int j_ = 0; j_ < VP; ++j_) glds16(vb_ + (size_t)j_ * 64 * ldv_ + vo_, (unsigned)__builtin_amdgcn_readfirstlane((int)(lds0 + VBASE + (vs_) * VSTAGE + (wave + 8 * j_) * 1024))); } while (0)
#define ATT_VMWAIT(n) do { if ((n) == 8) asm volatile("s_waitcnt vmcnt(8)" ::: "memory"); else if ((n) == 6) asm volatile("s_waitcnt vmcnt(6)" ::: "memory"); else if ((n) == 4) asm volatile("s_waitcnt vmcnt(4)" ::: "memory"); else if ((n) == 3) asm volatile("s_waitcnt vmcnt(3)" ::: "memory"); else if ((n) == 2) asm volatile("s_waitcnt vmcnt(2)" ::: "memory"); else if ((n) == 1) asm volatile("s_waitcnt vmcnt(1)" ::: "memory"); else { static_assert(true, ""); asm volatile("s_waitcnt vmcnt(0)" ::: "memory"); } } while (0)
    int kro[4];
#pragma unroll
    for (int d0 = 0; d0 < 4; ++d0) kro[d0] = r32 * 128 + ((((2 * d0 + h) ^ ((r32 >> 1) & 7))) << 4);
    int vro[NDV];
#pragma unroll
    for (int d = 0; d < NDV; ++d) vro[d] = (4 * h + qq) * VROW + ((d ^ (DV == 128 ? qq : (qq >> 1))) * 64) + blk * 32 + pp * 8;
#define ATT_QK(P0, P1, ks_) do { const ldsp kimg_ = F.lds + (ks_) * KSTAGE + (KSLOTS == 2 ? slot * KIMG : 0); bf16x8 kf_[8]; \
        _Pragma("unroll") for (int d0 = 0; d0 < 4; ++d0) { kf_[2 * d0] = lds_ld128(kimg_ + kro[d0]); kf_[2 * d0 + 1] = lds_ld128(kimg_ + kro[d0] + 4096); } \
        __builtin_amdgcn_sched_barrier(0); \
        P0 = MFMA32(kf_[0], qv[0], negm); P1 = MFMA32(kf_[1], qv[0], negm); \
        _Pragma("unroll") for (int d0 = 1; d0 < 4; ++d0) { P0 = MFMA32(kf_[2 * d0], qv[d0], P0); P1 = MFMA32(kf_[2 * d0 + 1], qv[d0], P1); } \
        __builtin_amdgcn_sched_barrier(0); } while (0)
#pragma unroll
    for (int t = 0; t < LA; ++t) ATT_DMA(t, t, t);
    bf16x8 qv[4];
    { const bf16_t* qp = (const bf16_t*)(F.ws + qoff) + (size_t)(qb * 32 + r32) * N_O + slot * 64 + 8 * h;
#pragma unroll
      for (int d0 = 0; d0 < 4; ++d0) { const u32x4 v = QPRE ? qpre[d0] : *(const u32x4*)(qp + 16 * d0); u32x4 o;
          o.x = pk2(lo_f(v.x) * C2, hi_f(v.x) * C2); o.y = pk2(lo_f(v.y) * C2, hi_f(v.y) * C2); o.z = pk2(lo_f(v.z) * C2, hi_f(v.z) * C2); o.w = pk2(lo_f(v.w) * C2, hi_f(v.w) * C2);
          qv[d0] = __builtin_bit_cast(bf16x8, o); } }
    ATT_VMWAIT((LA - 2) * OPS);
    bar_lds();
    f32x16 O[NDV];
#pragma unroll
    for (int d = 0; d < NDV; ++d)
#pragma unroll
        for (int i = 0; i < 16; ++i) O[d][i] = 0.f;
    float m = 0.f, lsum = 0.f;
    f32x16 negm;
#pragma unroll
    for (int i = 0; i < 16; ++i) negm[i] = 0.f;
    const int qpos = qpos0 + qb * 32 + r32;
    f32x16 pC0, pC1;
    ATT_QK(pC0, pC1, 0);
    {
        float rm = fmaxf(pC0[0], pC1[0]);
#pragma unroll
        for (int i = 1; i < 16; ++i) asm("v_max3_f32 %0, %0, %1, %2" : "+v"(rm) : "v"(pC0[i]), "v"(pC1[i]));
        { auto rr = __builtin_amdgcn_permlane32_swap(__float_as_uint(rm), __float_as_uint(rm), false, false); rm = fmaxf(__uint_as_float(rr[0]), __uint_as_float(rr[1])); }
        m = rm;
#pragma unroll
        for (int i = 0; i < 16; ++i) { pC0[i] = __builtin_amdgcn_exp2f(pC0[i] - rm); pC1[i] = __builtin_amdgcn_exp2f(pC1[i] - rm); negm[i] = -rm; }
    }
    bar_lds();
    int ks1 = 1 % KR, ksI = 0, vs0 = 0, vsI = LA % VR;
    for (int tt = 0; tt < NT; ++tt) {
        f32x16 pN0, pN1;
        u32x4 w[4];
        {
            const ldsp kimg_ = F.lds + ks1 * KSTAGE + (KSLOTS == 2 ? slot * KIMG : 0);
#define ATT_KF(j) lds_ld128(kimg_ + kro[(j) >> 1] + ((j) & 1) * 4096)
            bf16x8 kf[8];
            kf[0] = ATT_KF(0); kf[1] = ATT_KF(1); kf[2] = ATT_KF(2);
            if (PM < 5 && tt + LA < NT) ATT_DMA(tt + LA, ksI, vsI);
            asm volatile("" : "+v"(pC0), "+v"(pC1));
            __builtin_amdgcn_sched_barrier(0);
            float ps = 0.f;
#pragma unroll
            for (int j = 0; j < 8; ++j) {
                if (j + 3 < 8) kf[j + 3] = ATT_KF(j + 3);
                if (j & 1) pN1 = MFMA32(kf[j], qv[j >> 1], j < 2 ? negm : pN1); else pN0 = MFMA32(kf[j], qv[j >> 1], j < 2 ? negm : pN0);
                if (PM < 4) { ps += (pC0[2 * j] + pC0[2 * j + 1]) + (pC1[2 * j] + pC1[2 * j + 1]);
                w[j >> 2][j & 3] = pk2(pC0[2 * j], pC0[2 * j + 1]); w[2 + (j >> 2)][j & 3] = pk2(pC1[2 * j], pC1[2 * j + 1]); }
                else if (j == 0) { w[0] = __builtin_bit_cast(u32x4, (f32x4){pC0[0], pC0[1], pC0[2], pC0[3]}); w[1] = __builtin_bit_cast(u32x4, (f32x4){pC0[4], pC0[5], pC0[6], pC0[7]}); w[2] = __builtin_bit_cast(u32x4, (f32x4){pC1[0], pC1[1], pC1[2], pC1[3]}); w[3] = __builtin_bit_cast(u32x4, (f32x4){pC1[4], pC1[5], pC1[6], pC1[7]}); }
            }
#pragma unroll
            for (int j = 0; j < 8; ++j) { __builtin_amdgcn_sched_group_barrier(0x008, 1, 0); __builtin_amdgcn_sched_group_barrier(0x100, 1, 0); if (PM < 4) __builtin_amdgcn_sched_group_barrier(0x002, 6, 0); }
            asm volatile("" : "+v"(ps), "+v"(w[0]), "+v"(w[1]), "+v"(w[2]), "+v"(w[3]));
            __builtin_amdgcn_sched_barrier(0);
            lsum += ps;
#undef ATT_KF
        }
        const ldsp vb = F.lds + VBASE + vs0 * VSTAGE;
        bf16x8 vf[4][NDV];
#define ATT_VF(k4_, d_) (PM == 1 ? lds_ld128(vb + ((d_) * 32 + r32) * 128 + (((2 * (k4_) + h) ^ ((r32 >> 1) & 7)) << 4)) : cat8(lds_tr(vb + vro[d_] + (k4_) * 16 * VROW), lds_tr(vb + vro[d_] + (k4_) * 16 * VROW + 8 * VROW)))
#pragma unroll
        for (int k4 = 0; k4 < VD; ++k4)
#pragma unroll
            for (int d = 0; d < NDV; ++d) vf[k4][d] = ATT_VF(k4, d);
        bf16x8 pk[4];
        pk[0] = __builtin_bit_cast(bf16x8, w[0]); pk[1] = __builtin_bit_cast(bf16x8, w[1]); pk[2] = __builtin_bit_cast(bf16x8, w[2]); pk[3] = __builtin_bit_cast(bf16x8, w[3]);
        float fsc = 1.f; bool resc = false;
        if (PM < 4 && tt + 1 < NT) {
            if (WIN && maskwin && tt + 1 >= s0.nt) {
                const int kb = kpos1 + (tt + 1 - s0.nt) * 64;
#pragma unroll
                for (int i = 0; i < 16; ++i) { const int kp = kb + crow(i, h); int d = qpos - kp; d = d < 0 ? -d : d; if (d > 128) pN0[i] = -INFINITY; int d2 = qpos - kp - 32; d2 = d2 < 0 ? -d2 : d2; if (d2 > 128) pN1[i] = -INFINITY; }
            }
            float rm = fmaxf(pN0[0], pN1[0]), rm1, rm2, rm3;
            asm volatile("v_max_f32 %0, %1, %2" : "=v"(rm1) : "v"(pN0[1]), "v"(pN1[1]));
            asm volatile("v_max_f32 %0, %1, %2" : "=v"(rm2) : "v"(pN0[2]), "v"(pN1[2]));
            asm volatile("v_max_f32 %0, %1, %2" : "=v"(rm3) : "v"(pN0[3]), "v"(pN1[3]));
#pragma unroll
            for (int i = 4; i < 16; i += 4) {
                asm volatile("v_max3_f32 %0, %0, %1, %2" : "+v"(rm) : "v"(pN0[i]), "v"(pN1[i])); asm volatile("v_max3_f32 %0, %0, %1, %2" : "+v"(rm1) : "v"(pN0[i + 1]), "v"(pN1[i + 1]));
                asm volatile("v_max3_f32 %0, %0, %1, %2" : "+v"(rm2) : "v"(pN0[i + 2]), "v"(pN1[i + 2])); asm volatile("v_max3_f32 %0, %0, %1, %2" : "+v"(rm3) : "v"(pN0[i + 3]), "v"(pN1[i + 3])); }
            asm volatile("v_max_f32 %0, %0, %1" : "+v"(rm2) : "v"(rm3));
            asm volatile("v_max3_f32 %0, %0, %1, %2" : "+v"(rm) : "v"(rm1), "v"(rm2));
            { auto rr = __builtin_amdgcn_permlane32_swap(__float_as_uint(rm), __float_as_uint(rm), false, false); rm = fmaxf(__uint_as_float(rr[0]), __uint_as_float(rr[1])); }
            const float delta = rm > ATT_THR ? rm : 0.f;
            if (__any(delta != 0.f)) {
                resc = true; m += delta; fsc = __builtin_amdgcn_exp2f(-delta);
#pragma unroll
                for (int i = 0; i < 16; ++i) { pN0[i] -= delta; pN1[i] -= delta; negm[i] = -m; }
            }
        }
        {
            asm volatile("" : "+v"(pN0), "+v"(pN1));
            __builtin_amdgcn_sched_barrier(0);
            constexpr int EPG = 32 / (NDV * 4);
#pragma unroll
            for (int k4 = 0; k4 < 4; ++k4) {
#pragma unroll
                for (int d = 0; d < NDV; ++d) {
                    if (k4 + VD < 4) vf[k4 + VD][d] = ATT_VF(k4 + VD, d);
                    O[d] = MFMA32(vf[k4][d], pk[k4], O[d]);
#pragma unroll
                    for (int e = 0; e < EPG; ++e) { const int idx = (k4 * NDV + d) * EPG + e;
                        if (PM >= 4) continue; if (idx < 16) pN0[idx] = __builtin_amdgcn_exp2f(pN0[idx]); else pN1[idx - 16] = __builtin_amdgcn_exp2f(pN1[idx - 16]); }
                }
            }
#pragma unroll
            for (int g = 0; g < NDV * 4; ++g) { __builtin_amdgcn_sched_group_barrier(0x008, 1, 0); if (g < NDV * (4 - VD)) __builtin_amdgcn_sched_group_barrier(0x100, PM == 1 ? 1 : 2, 0); if (PM < 4) __builtin_amdgcn_sched_group_barrier(0x400, EPG, 0); }
            asm volatile("" : "+v"(pN0), "+v"(pN1));
            __builtin_amdgcn_sched_barrier(0);
        }
        if (resc) {
            lsum *= fsc;
#pragma unroll
            for (int d = 0; d < NDV; ++d)
#pragma unroll
                for (int i = 0; i < 16; ++i) O[d][i] *= fsc;
        }
        pC0 = pN0; pC1 = pN1;
        ks1 = ks1 == KR - 1 ? 0 : ks1 + 1; ksI = ksI == KR - 1 ? 0 : ksI + 1; vs0 = vs0 == VR - 1 ? 0 : vs0 + 1; vsI = vsI == VR - 1 ? 0 : vsI + 1;
        if (PM >= 5) ATT_VMWAIT(0); else if (LA == 4 && tt + 4 < NT) ATT_VMWAIT(2 * OPS); else if (tt + 3 < NT) ATT_VMWAIT(OPS); else ATT_VMWAIT(0);
        if (PM != 6) bar_lds();
    }
#undef ATT_DMA
#undef ATT_VMWAIT
#undef ATT_QK
#undef ATT_VF
    if (QPRE && more) { const bf16_t* qn = (const bf16_t*)(F.ws + qnext) + (size_t)(qb * 32 + r32) * N_O + slot * 64 + 8 * h;
#pragma unroll
        for (int d0 = 0; d0 < 4; ++d0) qpre[d0] = *(const u32x4*)(qn + 16 * d0); }
    attn_epilogue<DV, WIN>(F, O, lsum, m, sink_l2, E);
}
template <int DV, bool WIN>
DI void attn_epilogue(Frame& F, f32x16 (&O)[DV / 32], float lsum, float m, float sink_l2, const AttnEpi E) {
    constexpr int NDV = DV / 32;
    int lane; asm volatile("v_mbcnt_lo_u32_b32 %0, -1, 0\n\tv_mbcnt_hi_u32_b32 %0, -1, %0" : "=v"(lane));
    const int wave = F.wave, tid = wave * 64 + lane, slot = wave & 1, qb = wave >> 1, h = lane >> 5, r32 = lane & 31;
    { auto rr = __builtin_amdgcn_permlane32_swap(__float_as_uint(lsum), __float_as_uint(lsum), false, false); lsum = __uint_as_float(rr[0]) + __uint_as_float(rr[1]); }
    if (WIN) lsum += __builtin_amdgcn_exp2f(sink_l2 - m);
    const float inv = 1.f / lsum;
    u32x4 zpre[4];
#pragma unroll
    for (int k = 0; k < 4; ++k) { const int it = tid + 512 * k, q = it >> 4, cc = it & 15; zpre[k] = *(const u32x4*)((const bf16_t*)(F.ws + E.z) + (size_t)q * N_O + cc * 8); }
    LAS float* Y = (LAS float*)F.lds;
    if (!WIN) {
        LAS float* X = (LAS float*)(F.lds + 67584) + qb * 4096;
        if (slot == 1) {
            const float sc = inv * E.lam;
#pragma unroll
            for (int d = 0; d < NDV; ++d)
#pragma unroll
                for (int i = 0; i < 16; ++i) X[(d * 32 + crow(i, h)) * 32 + r32] = O[d][i] * sc;
        }
        bar_lds();
        if (slot == 0) {
            float ss = 0.f;
#pragma unroll
            for (int d = 0; d < NDV; ++d)
#pragma unroll
                for (int i = 0; i < 16; ++i) { const float v = O[d][i] * inv - X[(d * 32 + crow(i, h)) * 32 + r32]; O[d][i] = v; ss += v * v; }
            { auto rr = __builtin_amdgcn_permlane32_swap(__float_as_uint(ss), __float_as_uint(ss), false, false); ss = __uint_as_float(rr[0]) + __uint_as_float(rr[1]); }
            const float rstd = rsqrtf(ss * (1.f / 128.f) + EPS) * E.oml;
#pragma unroll
            for (int d = 0; d < NDV; ++d)
#pragma unroll
                for (int q4 = 0; q4 < 4; ++q4)
                    *(LAS f32x4*)(Y + (qb * 32 + r32) * 132 + d * 32 + 8 * q4 + 4 * h) = (f32x4){O[d][4 * q4] * rstd, O[d][4 * q4 + 1] * rstd, O[d][4 * q4 + 2] * rstd, O[d][4 * q4 + 3] * rstd};
        }
        bar_lds();
    } else {
#pragma unroll
        for (int d = 0; d < NDV; ++d)
#pragma unroll
            for (int q4 = 0; q4 < 4; ++q4)
                *(LAS f32x4*)(Y + (qb * 32 + r32) * 132 + slot * 64 + d * 32 + 8 * q4 + 4 * h) = (f32x4){O[d][4 * q4] * inv, O[d][4 * q4 + 1] * inv, O[d][4 * q4 + 2] * inv, O[d][4 * q4 + 3] * inv};
        bar_lds();
    }
#pragma unroll
    for (int k = 0; k < 4; ++k) {
        const int it = tid + 512 * k, q = it >> 4, cc = it & 15;
        const f32x4 y0 = *(const LAS f32x4*)(Y + q * 132 + cc * 8), y1 = *(const LAS f32x4*)(Y + q * 132 + cc * 8 + 4);
        f32x4 g0 = {1.f, 1.f, 1.f, 1.f}, g1 = g0;
        if (!WIN) { g0 = *(const f32x4*)(F.p.in[I_OSUBG] + cc * 8); g1 = *(const f32x4*)(F.p.in[I_OSUBG] + cc * 8 + 4); }
        const u32x4 z = zpre[k];
        u32x4 o; o.x = pk2(y0.x * g0.x * silu_f(lo_f(z.x)), y0.y * g0.y * silu_f(hi_f(z.x))); o.y = pk2(y0.z * g0.z * silu_f(lo_f(z.y)), y0.w * g0.w * silu_f(hi_f(z.y)));
        o.z = pk2(y1.x * g1.x * silu_f(lo_f(z.z)), y1.y * g1.y * silu_f(hi_f(z.z))); o.w = pk2(y1.z * g1.z * silu_f(lo_f(z.w)), y1.w * g1.w * silu_f(hi_f(z.w)));
        *(u32x4*)((bf16_t*)(F.ws + E.aout) + (size_t)q * 2048 + cc * 8) = o;
    }
    bar_lds();
}

template <int PM = 0, int ONLY = 0>
DI void phase_attn(Frame& F, int grp) {
    const float lam = ((const float*)(F.ws + WS_LAM))[0], oml = ((const float*)(F.ws + WS_LAM))[1];
    const unsigned lat0 = grp == 0 ? R_CTX : 0;
    constexpr unsigned UB = (unsigned)WS_U, AB = (unsigned)WS_AOUT;
    const int NU = 1024 + (grp == 0 ? 256 : 0);
    u32x4 qpre[4];
    const size_t qlane = (size_t)((F.wave >> 1) * 32 + (F.lane & 31)) * N_O + (F.wave & 1) * 64 + 8 * (F.lane >> 5);
    if (ONLY == 0 || ONLY == 1) {
    auto qoff_c = [&](int u) { if (u < 1024) { const int x = u & 7, qb = (u >> 3) & 31, bh = (u >> 8) * 8 + x, bl = bh >> 3, hh = bh & 7; return UB + ((lat0 + bl * 4096 + qb * 128) * N_O + hh * 128) * 2; }
                               const int c = u - 1024, b = c >> 4, hh = (c >> 1) & 7, qb = c & 1; return UB + ((unsigned)(b * 256 + qb * 128) * N_O + hh * 128) * 2; };
    if (F.bid < NU) { const bf16_t* qn = (const bf16_t*)(F.ws + qoff_c(F.bid)) + qlane;
#pragma unroll
        for (int d0 = 0; d0 < 4; ++d0) qpre[d0] = *(const u32x4*)(qn + 16 * d0); }
    for (int u = F.bid; u < NU; u += F.G) {
        AttnSeg s0, s1; AttnEpi E; unsigned q0; int rot;
        if (u < 1024) {
            const int x = u & 7, qb = (u >> 3) & 31, bh = (u >> 8) * 8 + x, bl = bh >> 3, hh = bh & 7, b = grp * 4 + bl;
            const unsigned ls = lat0 + bl * 4096; q0 = qb * 128;
            s0 = AttnSeg{(unsigned)WS_CK + (unsigned)(b * 8 + hh) * 512 * 128 * 2, (unsigned)WS_CV + (unsigned)(b * 8 + hh) * 512 * 128 * 2, 128, 128, 8};
            s1 = AttnSeg{UB + (ls * N_O + 1024 + hh * 128) * 2, UB + (ls * N_O + 2048 + hh * 128) * 2, N_O, N_O, 64};
            E = AttnEpi{AB + ((ls + q0) * 2048 + hh * 128) * 2, UB + ((ls + q0) * N_O + 3072 + hh * 128) * 2, lam, oml};
            rot = ATT_ROT(qb);
        } else {
            const int c = u - 1024, b = c >> 4, hh = (c >> 1) & 7, qb = c & 1; const unsigned ls = b * 256; q0 = qb * 128;
            s0 = AttnSeg{UB, UB, N_O, N_O, 0};
            s1 = AttnSeg{UB + (ls * N_O + 1024 + hh * 128) * 2, UB + (ls * N_O + 2048 + hh * 128) * 2, N_O, N_O, 4};
            E = AttnEpi{AB + ((ls + q0) * 2048 + hh * 128) * 2, UB + ((ls + q0) * N_O + 3072 + hh * 128) * 2, lam, oml};
            rot = 0;
        }
        const bool more = u + F.G < NU;
        attn_unit<128, 2, false, PM, true>(F, qoff_c(u), s0, s1, (int)q0, 0, false, 0.f, E, rot, qpre, more ? qoff_c(u + F.G) : 0u, more);
    } }
    if (ONLY == 0 || ONLY == 2) {
    auto qoff_w = [&](int u) { if (u < 1024) { const int x = u & 7, qb = (u >> 3) & 31, combo = (u >> 8) * 8 + x, bl = combo >> 3, kv = (combo >> 1) & 3, gp = combo & 1; return UB + ((lat0 + bl * 4096 + qb * 128) * N_O + 4096 + (kv * 4 + 2 * gp) * 64) * 2; }
                               const int c = u - 1024, b = c >> 4, kv = (c >> 2) & 3, gp = (c >> 1) & 1, qb = c & 1; return UB + ((unsigned)(b * 256 + qb * 128) * N_O + 4096 + (kv * 4 + 2 * gp) * 64) * 2; };
    if (F.bid < NU) { const bf16_t* qn = (const bf16_t*)(F.ws + qoff_w(F.bid)) + qlane;
#pragma unroll
        for (int d0 = 0; d0 < 4; ++d0) qpre[d0] = *(const u32x4*)(qn + 16 * d0); }
    for (int u = F.bid; u < NU; u += F.G) {
        AttnSeg s0, s1; AttnEpi E; int q0, ks, hd0; bool mw;
        if (u < 1024) {
            const int x = u & 7, qb = (u >> 3) & 31, combo = (u >> 8) * 8 + x, bl = combo >> 3, kv = (combo >> 1) & 3, gp = combo & 1, b = grp * 4 + bl;
            const unsigned ls = lat0 + bl * 4096; q0 = qb * 128; hd0 = kv * 4 + 2 * gp;
            ks = max(0, q0 - 128); const int ke = min(4096, q0 + 256);
            s0 = AttnSeg{(unsigned)WS_WK + (unsigned)(b * 4 + kv) * 512 * 64 * 2, (unsigned)WS_WV + (unsigned)(b * 4 + kv) * 512 * 64 * 2, 64, 64, 8};
            s1 = AttnSeg{UB + ((ls + ks) * N_O + 5120 + kv * 64) * 2, UB + ((ls + ks) * N_O + 5376 + kv * 64) * 2, N_O, N_O, (ke - ks) >> 6};
            E = AttnEpi{AB + ((ls + q0) * 2048 + 1024 + hd0 * 64) * 2, UB + ((ls + q0) * N_O + 5632 + hd0 * 64) * 2, 0.f, 0.f};
            mw = true;
        } else {
            const int c = u - 1024, b = c >> 4, kv = (c >> 2) & 3, gp = (c >> 1) & 1, qb = c & 1; const unsigned ls = b * 256; q0 = qb * 128; hd0 = kv * 4 + 2 * gp; ks = 0;
            s0 = AttnSeg{UB, UB, N_O, N_O, 0};
            s1 = AttnSeg{UB + (ls * N_O + 5120 + kv * 64) * 2, UB + (ls * N_O + 5376 + kv * 64) * 2, N_O, N_O, 4};
            E = AttnEpi{AB + ((ls + q0) * 2048 + 1024 + hd0 * 64) * 2, UB + ((ls + q0) * N_O + 5632 + hd0 * 64) * 2, 0.f, 0.f};
            mw = false;
        }
        const float sk = F.p.in[I_OSINK][hd0 + (F.wave & 1)] * LOG2E;
        const bool more = u + F.G < NU;
        attn_unit<64, 1, true, 0, true>(F, qoff_w(u), s0, s1, q0, ks, mw, sk, E, 0, qpre, more ? qoff_w(u + F.G) : 0u, more);
    } }
}

DI void phase_final(Frame& F, int grp) {
    const int row0 = GRP_ROW0[grp], rows = GRP_ROWS[grp];
    const int gw = F.bid * NWAVES + F.wave, NGW = F.G * NWAVES;
    const float* ng = F.p.in[I_FNORMG];
    const bf16_t* x2b = (const bf16_t*)(F.ws + WS_REGA);
    for (int rl = gw; rl < rows; rl += 2 * NGW) {
        f32x4 v[2][4]; float s[2];
#pragma unroll
        for (int q = 0; q < 2; ++q) { const u32x2* xr = (const u32x2*)(x2b + (size_t)min(rl + q * NGW, rows - 1) * DM) + F.lane;
#pragma unroll
            for (int j = 0; j < 4; ++j) { const u32x2 w = xr[64 * j]; v[q][j] = (f32x4){lo_f(w.x), hi_f(w.x), lo_f(w.y), hi_f(w.y)}; } }
#pragma unroll
        for (int q = 0; q < 2; ++q) { float t = 0.f;
#pragma unroll
            for (int j = 0; j < 4; ++j) t += (v[q][j].x * v[q][j].x + v[q][j].y * v[q][j].y) + (v[q][j].z * v[q][j].z + v[q][j].w * v[q][j].w);
            s[q] = t; }
#pragma unroll
        for (int o = 1; o < 64; o <<= 1) { s[0] += shfl_idx(s[0], F.lane ^ o); s[1] += shfl_idx(s[1], F.lane ^ o); }
#pragma unroll
        for (int q = 0; q < 2; ++q) { if (rl + q * NGW >= rows) continue;
            const float rstd = rsqrtf(s[q] * (1.f / DM) + EPS);
            f32x4* xr = (f32x4*)(F.out + OUT_X + (size_t)(row0 + rl + q * NGW) * DM) + F.lane;
#pragma unroll
            for (int j = 0; j < 4; ++j) { const f32x4 g = *((const f32x4*)ng + F.lane + 64 * j); xr[64 * j] = v[q][j] * rstd * g; } }
    }
}
#define RLX_AGENT __ATOMIC_RELAXED, __HIP_MEMORY_SCOPE_AGENT
#define XB_TMO      128
#define XB_XCNT(j)  (256  + 64 * (j))
#define XB_XSUB(j)  (1280 + 64 * (j))
#define XB_XGEN(j)  (2304 + 64 * (j))
#define XB_TOP      3328
#define XB_TOPGEN   3392
#define XCD_BAR_WORDS 3456
#define XB_SPIN_CAP (1u << 18)

__device__ __forceinline__ unsigned xb_ld(unsigned* p)              { return __hip_atomic_load(p, __ATOMIC_RELAXED, __HIP_MEMORY_SCOPE_AGENT); }
__device__ __forceinline__ unsigned xb_add(unsigned* p, unsigned v) { return __hip_atomic_fetch_add(p, v, __ATOMIC_RELAXED, __HIP_MEMORY_SCOPE_AGENT); }
__device__ __forceinline__ unsigned xb_xcc_id() { return (unsigned)__builtin_amdgcn_s_getreg((3 << 11) | 20) & 0xFu; }
#define XB_SPIN(cond, bar) do { unsigned _sp = 0; while (cond) { __builtin_amdgcn_s_sleep(1); \
    if ((++_sp & 255u) == 0u) { if (xb_ld(&(bar)[XB_TMO])) break; if (_sp > XB_SPIN_CAP) { atomicAdd(&(bar)[XB_TMO], 1u); break; } } } } while (0)

struct XcdBarrier {
    unsigned* bar; unsigned x;
    volatile LAS unsigned* st;
};

__device__ __forceinline__ XcdBarrier xcd_barrier_post(unsigned* bar, volatile LAS unsigned* st) {
    XcdBarrier b; b.bar = bar; b.x = xb_xcc_id(); b.st = st;
    if (threadIdx.x == 0) (void)xb_add(&bar[XB_XCNT(b.x)], 1u);
    return b;
}
__device__ __forceinline__ void xcd_barrier_complete(unsigned* bar, unsigned x, unsigned& nloc, unsigned& nx) {
    const unsigned G = gridDim.x * gridDim.y * gridDim.z;
    unsigned sum, cnt, mine, sp = 0u;
    for (;;) {
        sum = 0u; cnt = 0u; mine = 0u;
#pragma unroll
        for (unsigned j = 0; j < 16; ++j) { const unsigned c = xb_ld(&bar[XB_XCNT(j)]); sum += c; cnt += (c > 0u) ? 1u : 0u; mine = (j == x) ? c : mine; }
        if (sum == G) break;
        __builtin_amdgcn_s_sleep(1);
        if ((++sp & 255u) == 0u) { if (xb_ld(&bar[XB_TMO])) break; if (sp > XB_SPIN_CAP) { atomicAdd(&bar[XB_TMO], 1u); break; } }
    }
    nloc = mine > 0u ? mine : 1u; nx = cnt > 0u ? cnt : 1u;
}

__device__ __forceinline__ void xcd_barrier(const XcdBarrier& b) {
    asm volatile("s_waitcnt vmcnt(0)" ::: "memory");
    __syncthreads();
    if (threadIdx.x == 0) {
        unsigned* bar = b.bar;
        __builtin_amdgcn_s_waitcnt(0);
        unsigned nloc = b.st[0], nx = b.st[1];
        if (nloc == 0u) { xcd_barrier_complete(bar, b.x, nloc, nx); b.st[0] = nloc; b.st[1] = nx; }
        const unsigned old = xb_add(&bar[XB_XSUB(b.x)], 1u);
        const unsigned gen = old / nloc;
        if (old + 1u == (gen + 1u) * nloc) {
            __builtin_amdgcn_fence(__ATOMIC_RELEASE, "agent");
            asm volatile("s_waitcnt vmcnt(0)" ::: "memory");
            const unsigned og = xb_add(&bar[XB_TOP], 1u);
            const unsigned tg = og / nx;
            if (og + 1u == (tg + 1u) * nx) xb_add(&bar[XB_TOPGEN], 1u);
            else XB_SPIN(xb_ld(&bar[XB_TOPGEN]) == tg, bar);
            __builtin_amdgcn_fence(__ATOMIC_ACQUIRE, "agent");
            xb_add(&bar[XB_XGEN(b.x)], 1u);
            asm volatile("s_waitcnt vmcnt(0)" ::: "memory");
        } else {
            XB_SPIN(xb_ld(&bar[XB_XGEN(b.x)]) == gen, bar);
            __builtin_amdgcn_fence(__ATOMIC_ACQUIRE, "agent");
            asm volatile("s_waitcnt vmcnt(0)" ::: "memory");
        }
    }
    __syncthreads();
}

constexpr int NPHG = 13;
constexpr int NPH = 1 + 2 * NPHG;

DI Frame relaunder(const Frame& F0) {
    int ln; asm volatile("v_mbcnt_lo_u32_b32 %0, -1, 0\n\tv_mbcnt_hi_u32_b32 %0, -1, %0" : "=v"(ln));
    int b = F0.bid, G = F0.G, wv = F0.wave; size_t z0 = 0, z1 = 0; asm volatile("" : "+s"(b), "+s"(G), "+s"(z0), "+s"(z1), "+s"(wv));
    float* o = F0.p.out + z0; unsigned char* w = F0.p.ws + z1;
    return Frame{F0.lds, wv * 64 + ln, ln, wv, G, b, F0.p, o, w, F0.probe};
}
DI void run_phase(const Frame& F0, int ph) {
#ifndef PHMASK
#define PHMASK 0xFFFF
#endif
#define PHON(k) ((PHMASK >> (k)) & 1)
    if (ph == 0) { if (PHON(14)) { Frame F = relaunder(F0); phase_p0(F); } return; }
    const int grp = (ph - 1) / NPHG, k = (ph - 1) % NPHG;
    const int row0 = GRP_ROW0[grp], rows = GRP_ROWS[grp];
        switch (k) {
    case 0: if (PHON(0)) { Frame F = relaunder(F0); phase_modnorm(F, grp, 0); } break;
    case 1: if (PHON(1)) { Frame F = relaunder(F0); { pg8::Gemm g{(const bf16_t*)(F.ws + WS_REGA), (const bf16_t*)(F.ws + WS_WT_IN_E), rows, N_E, 1024, 1024, 0};
              pg8::StaticOrder S; S.init(rows, N_E, F.G, F.bid);
              epi::EpiE0 E{(bf16_t*)(F.out + OUT_X + (size_t)row0 * DM), (bf16_t*)(F.ws + WS_XBCRAW), (bf16_t*)(F.ws + WS_XB), (float*)(F.ws + WS_DTRAW)};
              pg8::gemm_phase<epi::EpiE0, pg8::StaticOrder, true, true>(F.lds, g, S, E, F.tid); } } break;
    case 2: if (PHON(2)) { Frame F = relaunder(F0); phase_conv(F, grp); } break;
    case 3: if (PHON(3)) { Frame F = relaunder(F0); phase_states(F, grp); } break;
    case 4: if (PHON(4)) { Frame F = relaunder(F0); phase_scan(F, grp); } break;
    case 5: if (PHON(5)) { Frame F = relaunder(F0); phase_y(F, grp); } break;
    case 6: if (PHON(6)) { Frame F = relaunder(F0); {
              pg8::Gemm g{(const bf16_t*)(F.ws + WS_POOLED), (const bf16_t*)(F.ws + WS_WT_POOL), rows, 1024, 256, 1024, 256};
              pg8::StaticOrder S; S.init(rows, 1024, F.G, F.bid);
              epi::EpiPool E{(bf16_t*)(F.ws + WS_AOUT), (const bf16_t*)(F.out + OUT_X + (size_t)row0 * DM), (const float*)(F.ws + WS_SSY)};
              pg8::gemm_phase<epi::EpiPool, pg8::StaticOrder, true, true>(F.lds, g, S, E, F.tid); } } break;
    case 7: if (PHON(7)) { Frame F = relaunder(F0); { pg8::Gemm g{(const bf16_t*)(F.ws + WS_AOUT), (const bf16_t*)(F.ws + WS_WT_OUT_E), rows, 1024, 2048, 2048, 0};
              pg8::StaticOrder S; S.init(rows, 1024, F.G, F.bid);
              epi::EpiRes<true> E{F.p.in[I_XP], F.p.in[I_XS], nullptr, (const float*)(F.ws + WS_MOD), row0, (const float*)(F.ws + WS_SSY), (bf16_t*)(F.ws + WS_X1B), nullptr};
              pg8::gemm_phase<epi::EpiRes<true>, pg8::StaticOrder, true, true>(F.lds, g, S, E, F.tid); } } break;
    case 8: if (PHON(8)) { Frame F = relaunder(F0); phase_modnorm(F, grp, 1); } break;
    case 9: if (PHON(9)) { Frame F = relaunder(F0); { pg8::Gemm g{(const bf16_t*)(F.ws + WS_REGA), (const bf16_t*)(F.ws + WS_WT_IN_O), rows, N_O, 1024, 1024, 0};
              pg8::StaticOrder S; S.init(rows, N_O, F.G, F.bid);
              epi::EpiO E{(bf16_t*)(F.ws + WS_U), (const float*)(F.ws + WS_ROPE), row0};
              pg8::gemm_phase<epi::EpiO, pg8::StaticOrder, true, true>(F.lds, g, S, E, F.tid); } } break;
    case 10: if (PHON(10)) { Frame F = relaunder(F0); if (grp == 0) phase_cachecopy(F); phase_attn(F, grp); } break;
    case 11: if (PHON(11)) { Frame F = relaunder(F0); { pg8::Gemm g{(const bf16_t*)(F.ws + WS_AOUT), (const bf16_t*)(F.ws + WS_WT_OUT_O), rows, 1024, 2048, 2048, 0};
               pg8::StaticOrder S; S.init(rows, 1024, F.G, F.bid);
               epi::EpiRes<false> E{nullptr, nullptr, F.out + OUT_X, (const float*)(F.ws + WS_MOD) + 9 * 3072, row0, nullptr, (bf16_t*)(F.ws + WS_X1B), (bf16_t*)(F.ws + WS_REGA)};
               pg8::gemm_phase<epi::EpiRes<false>, pg8::StaticOrder, true, true>(F.lds, g, S, E, F.tid); } } break;
    default: if (PHON(12)) { Frame F = relaunder(F0); phase_final(F, grp); } break;
    }
}

__global__ void __launch_bounds__(NTHREADS, 2) mega_fwd(Params p) {
    extern __shared__ __attribute__((aligned(16))) unsigned char lds_raw[];
    cg::grid_group grid = cg::this_grid();
    const int wave_ = __builtin_amdgcn_readfirstlane((int)threadIdx.x >> 6);
    volatile LAS unsigned* bst = (volatile LAS unsigned*)((ldsp)lds_raw + LDS_BYTES - 256);
    if (threadIdx.x < 2) bst[threadIdx.x] = 0u;
    __syncthreads();
    XcdBarrier bar = xcd_barrier_post((unsigned*)(p.ws + WS_BAR), bst);
    for (int ph = p.ph_lo; ph < p.ph_hi; ++ph) {
        int lane_; asm volatile("v_mbcnt_lo_u32_b32 %0, -1, 0\n\tv_mbcnt_hi_u32_b32 %0, -1, %0" : "=v"(lane_));
        Frame F{(ldsp)lds_raw, wave_ * 64 + lane_, lane_, wave_, (int)gridDim.x, (int)blockIdx.x, p, p.out, p.ws, 0};
#ifdef ATT_PROBE
#ifndef ATT_PM
#define ATT_PM 0
#endif
        if (ph > 0 && (ph - 1) % NPHG == 10) { Frame Fp = relaunder(F); phase_attn<ATT_PM, ATT_PROBE>(Fp, (ph - 1) / NPHG); xcd_barrier(bar); }
#endif
#ifdef DUP_MASK
        if (ph > 0 && ((DUP_MASK >> ((ph - 1) % NPHG)) & 1)) { Frame Fp{F.lds, F.tid, F.lane, F.wave, F.G, F.bid, F.p, F.out, F.ws, 1}; run_phase(Fp, ph); xcd_barrier(bar); }
#endif
        run_phase(F, ph);
        if (ph + 1 < p.ph_hi) { if (ph == 0) grid.sync(); else xcd_barrier(bar); }
    }
}

#ifndef MK_MULTI
#define MK_MULTI 0
#endif
extern "C" void kernel_launch(void* const* d_in, const int* in_sizes, int n_in, void* d_out, int out_size, void* d_ws, size_t ws_size, hipStream_t stream) {
    static int grid = 0;
    if (grid == 0) {
        if (n_in != 28 || (size_t)out_size != OUT_END || ws_size < WS_END) { fprintf(stderr, "kernel_launch: unexpected sizes n_in %d out %d ws %zu\n", n_in, out_size, ws_size); grid = -1; return; }
        int dev = 0, cus = 0, per_cu = 0;
        hipGetDevice(&dev); hipDeviceGetAttribute(&cus, hipDeviceAttributeMultiprocessorCount, dev);
        if (hipFuncSetAttribute((const void*)mega_fwd, hipFuncAttributeMaxDynamicSharedMemorySize, LDS_BYTES) != hipSuccess) { fprintf(stderr, "kernel_launch: hipFuncSetAttribute failed\n"); grid = -1; return; }
        if (hipOccupancyMaxActiveBlocksPerMultiprocessor(&per_cu, (const void*)mega_fwd, NTHREADS, LDS_BYTES) != hipSuccess || per_cu < 1) { fprintf(stderr, "kernel_launch: occupancy query failed (%d)\n", per_cu); (void)hipGetLastError(); per_cu = 1; }
        grid = cus * (per_cu > 1 ? 1 : per_cu);
        if (grid > 256) grid = 256;
    }
    if (grid < 0) return;
    if (hipMemsetAsync((char*)d_ws + WS_BAR, 0, 16384, stream) != hipSuccess) { fprintf(stderr, "kernel_launch: memset failed\n"); return; }
    Params p{};
    for (int i = 0; i < 28; ++i) p.in[i] = (const float*)d_in[i];
    p.out = (float*)d_out; p.ws = (unsigned char*)d_ws;
#if MK_MULTI
    for (int ph = 0; ph < NPH; ++ph) { p.ph_lo = ph; p.ph_hi = ph + 1; hipLaunchKernelGGL(mega_fwd, dim3(grid), dim3(NTHREADS), LDS_BYTES, stream, p); }
#else
    p.ph_lo = 0; p.ph_hi = NPH;
    void* args[] = {&p};
    hipError_t e = hipLaunchCooperativeKernel((const void*)mega_fwd, dim3(grid), dim3(NTHREADS), args, LDS_BYTES, stream);
    if (e != hipSuccess) fprintf(stderr, "cooperative launch failed: %s (grid %d)\n", hipGetErrorString(e), grid);
#endif
}
```

```cpp
#include <hip/hip_runtime.h>
#include <hip/hip_cooperative_groups.h>
#include <cstdio>
#include <cstdint>
namespace cg = cooperative_groups;

#define DI __device__ __forceinline__
#define LAS __attribute__((address_space(3)))
typedef unsigned short bf16_t;
typedef short bf16x8 __attribute__((ext_vector_type(8)));
typedef short s16x4 __attribute__((ext_vector_type(4)));
typedef float f32x2 __attribute__((ext_vector_type(2)));
typedef float f32x4 __attribute__((ext_vector_type(4)));
typedef float f32x16 __attribute__((ext_vector_type(16)));
typedef unsigned u32x2 __attribute__((ext_vector_type(2)));
typedef unsigned u32x4 __attribute__((ext_vector_type(4)));
typedef __bf16 bf16x2_t __attribute__((ext_vector_type(2)));
typedef LAS unsigned char* ldsp;

constexpr int DM = 1024;
constexpr int R_CTX = 4096, R_ALL = 36864;
constexpr int GRP_ROW0[2] = {0, 20480};
constexpr int GRP_ROWS[2] = {20480, 16384};
constexpr int MAXROWS = 20480;
constexpr int N_E = 5376;
constexpr int N_O = 6656;
constexpr float EPS = 1e-6f;
constexpr float C2 = 0.125f * 1.4426950408889634f;
constexpr float LOG2E = 1.4426950408889634f;

constexpr size_t MiB = 1u << 20;
constexpr size_t WS_MOD = 0;
constexpr size_t WS_ROPE = 256 * 1024;
constexpr size_t WS_LAM = 300 * 1024;
constexpr size_t WS_BIAS1 = 320 * 1024;
constexpr size_t WS_SSY = 600 * 1024;
constexpr size_t WS_SS1 = 700 * 1024;
constexpr size_t WS_WT_IN_E = 1 * MiB;
constexpr size_t WS_WT_OUT_E = 12 * MiB;
constexpr size_t WS_WT_IN_O = 16 * MiB;
constexpr size_t WS_WT_OUT_O = 29 * MiB;
constexpr size_t WS_WT_POOL = 33 * MiB;
constexpr size_t WS_CK = 34 * MiB;
constexpr size_t WS_CV = 42 * MiB;
constexpr size_t WS_WK = 50 * MiB;
constexpr size_t WS_WV = 52 * MiB;
constexpr size_t WS_DTRAW = 54 * MiB;
constexpr size_t WS_DTV = 57 * MiB;
constexpr size_t WS_ACS = 60 * MiB;
constexpr size_t WS_DECAY = 63 * MiB;
constexpr size_t WS_REGA = 64 * MiB;
constexpr size_t WS_X1B = 64 * MiB + 40 * MiB;
constexpr size_t WS_AOUT = 144 * MiB;
constexpr size_t WS_U = 224 * MiB;
constexpr size_t WS_XBCRAW = WS_U;
constexpr size_t WS_XBC = WS_U + 80 * MiB;
constexpr size_t WS_XB = WS_U + 160 * MiB;
constexpr size_t WS_POOLED = WS_U + 200 * MiB;
constexpr size_t WS_BAR = 484 * MiB;
constexpr size_t WS_END = 485 * MiB;

constexpr size_t OUT_X = 0;
constexpr size_t OUT_SSD_F = (size_t)R_ALL * DM;
constexpr size_t OUT_SSD_B = OUT_SSD_F + 16 * 16 * 64 * 128;
constexpr size_t OUT_DIFF_K = OUT_SSD_B + 16 * 16 * 64 * 128;
constexpr size_t OUT_DIFF_V = OUT_DIFF_K + 16 * 8 * 256 * 128;
constexpr size_t OUT_WIN_K = OUT_DIFF_V + 16 * 8 * 256 * 128;
constexpr size_t OUT_WIN_V = OUT_WIN_K + 16 * 4 * 256 * 64;
constexpr size_t OUT_END = OUT_WIN_V + 16 * 4 * 256 * 64;

constexpr int NTHREADS = 512, NWAVES = 8;
constexpr int LDS_BYTES = 160 * 1024;

DI float bf2f(bf16_t v) { return __uint_as_float((unsigned)v << 16); }
DI unsigned pk2(float lo, float hi) { f32x2 v = {lo, hi}; bf16x2_t b = __builtin_convertvector(v, bf16x2_t); return __builtin_bit_cast(unsigned, b); }
DI bf16_t f2bf(float f) { return (bf16_t)(pk2(f, 0.f) & 0xffffu); }
DI float lo_f(unsigned w) { return __uint_as_float(w << 16); }
DI float hi_f(unsigned w) { return __uint_as_float(w & 0xffff0000u); }
DI float silu_f(float x) { return x * __builtin_amdgcn_rcpf(1.f + __expf(-x)); }
DI void bar_lds() { asm volatile("s_waitcnt lgkmcnt(0)" ::: "memory"); __builtin_amdgcn_s_barrier(); asm volatile("" ::: "memory"); }
DI float shfl_idx(float v, int srclane) { return __uint_as_float((unsigned)__builtin_amdgcn_ds_bpermute(srclane << 2, (int)__float_as_uint(v))); }
DI float wave_sum(float v, int lane) {
#pragma unroll
    for (int o = 1; o < 64; o <<= 1) v += shfl_idx(v, lane ^ o);
    return v;
}
DI bf16x8 lds_ld128(ldsp p) { return *(const LAS bf16x8*)p; }
DI void lds_st128(ldsp p, u32x4 v) { *(LAS u32x4*)p = v; }
typedef short v4i16_t __attribute__((ext_vector_type(4)));
DI s16x4 lds_tr(ldsp p) { return __builtin_bit_cast(s16x4, __builtin_amdgcn_ds_read_tr16_b64_v4i16((LAS v4i16_t*)p)); }
DI bf16x8 cat8(s16x4 lo, s16x4 hi) { return __builtin_shufflevector(lo, hi, 0, 1, 2, 3, 4, 5, 6, 7); }
DI int crow(int reg, int h) { return (reg & 3) + 8 * (reg >> 2) + 4 * h; }
DI bf16x8 pack8(const f32x16& x, int s) {
    u32x4 p; p.x = pk2(x[8 * s], x[8 * s + 1]); p.y = pk2(x[8 * s + 2], x[8 * s + 3]); p.z = pk2(x[8 * s + 4], x[8 * s + 5]); p.w = pk2(x[8 * s + 6], x[8 * s + 7]);
    return __builtin_bit_cast(bf16x8, p);
}
#define MFMA32(a, b, c) __builtin_amdgcn_mfma_f32_32x32x16_bf16((a), (b), (c), 0, 0, 0)

struct RowInfo { int ctx, b, t, T, g; };
DI RowInfo rowinfo(int row) {
    RowInfo r;
    if (row < R_CTX) { r.ctx = 1; r.b = row >> 8; r.t = row & 255; r.T = 256; r.g = 8; }
    else { const int q = row - R_CTX; r.ctx = 0; r.b = q >> 12; r.t = q & 4095; r.T = 4096; r.g = r.b; }
    return r;
}
namespace pg8 {
#define PG8_LAS __attribute__((address_space(3)))
constexpr int BM = 256, BK = 64, HALF = 128, HTB = HALF * BK * 2  , STAGE_BYTES = 8 * HTB, NXCD = 8, WGM = 8;

__host__ __device__ __forceinline__ int lds_byte(int r, int c) { const int st = (r >> 4) * 2 + (c >> 5), rr = r & 15, cc = c & 31, ob = rr * 64 + cc * 2; return st * 1024 + (ob ^ (((ob >> 9) & 1) << 5)); }
__host__ __device__ __forceinline__ void stage_rc(int b, int& R, int& C) { const int st = b / 1024, sb = b % 1024, swz = sb ^ (((sb >> 9) & 1) << 5); R = (st >> 1) * 16 + swz / 64; C = (st & 1) * 32 + (swz % 64) / 2; }
__host__ __device__ __forceinline__ int perm32(int rho) { const int n = rho >> 4, i = rho & 15; return 8 * (i >> 2) + 4 * n + (i & 3); }

struct Unit { int pm, pn; };
struct Gemm { const bf16_t* A; const bf16_t* Bt; int M, N, K, lda, a_pn_off; };

struct StaticOrder {
    int nM, nN, nwg, G, c;
    __host__ __device__ void init(int M, int N, int G_, int c_) { nM = M / BM; nN = N / BM; nwg = nM * nN; G = G_; c = c_; }
    __host__ __device__ bool next(int i, Unit& u) const {
        const long L = (long)i * G + c; if (L >= nwg) return false;
        int wgid = (int)L; { const int q = nwg / NXCD, r = nwg % NXCD, xcd = wgid % NXCD, off = wgid / NXCD; wgid = (xcd < r ? xcd * (q + 1) : r * (q + 1) + (xcd - r) * q) + off; }
        const int nig = WGM * nN, gid = wgid / nig, fm = gid * WGM, gsz = (nM - fm) < WGM ? (nM - fm) : WGM;
        u.pm = fm + ((wgid % nig) % gsz); u.pn = (wgid % nig) / gsz; return true;
    }
    __device__ __forceinline__ void a_ready(const Unit&) const {}
    __device__ __forceinline__ void done(const Unit&) const {}
};


template <class Epi, class Sched, bool ALIGN_EPI = false, bool SP2 = false>
__device__ __forceinline__ void gemm_phase(PG8_LAS unsigned char* lds, const Gemm g, const Sched& S, const Epi& E, const int tid) {
    const int wid = __builtin_amdgcn_readfirstlane(tid >> 6), lane = tid & 63, wr = wid >> 2, wc = wid & 3, fr = lane & 15, fq = lane >> 4;
    const int K = g.K, nt = K / BK;
    unsigned voffA[2], voffB[2];
#pragma unroll
    for (int i = 0; i < 2; ++i) { int R, C; stage_rc(tid * 16 + i * 8192, R, C); const int Rb = Epi::PERM ? ((R & ~31) + perm32(R & 31)) : R;
        voffA[i] = (unsigned)(R * g.lda + C) * 2u; voffB[i] = (unsigned)(Rb * K + C) * 2u; }
    const size_t kstep = (size_t)(BK * 2);
    const size_t hstepA = (size_t)HALF * g.lda * 2, hstepB = (size_t)HALF * K * 2;
    const size_t tstepA = 2 * hstepA, tstepB = 2 * hstepB, pnoff = (size_t)g.a_pn_off * 2;
    const unsigned ldsw = (unsigned)wid * 1024u;
    const int aoff = lds_byte(wr * 64 + fr, fq * 8), boff = lds_byte(wc * 32 + fr, fq * 8);
#define PG8_SA(b, h) (((b) * 2 + (h)) * HTB)
#define PG8_SB(b, h) ((4 + (b) * 2 + (h)) * HTB)
#define PG8_STAGE(bufoff, gbase, voff) do { _Pragma("unroll") for (int _i = 0; _i < 2; ++_i) \
        __builtin_amdgcn_global_load_lds((const unsigned*)((const char*)(gbase) + (voff)[_i]), (PG8_LAS unsigned*)(lds + (bufoff) + ldsw + _i * 8192), 16, 0, 0); } while (0)
#define PG8_LDA(dst, b, h) do { _Pragma("unroll") for (int m = 0; m < 4; ++m) _Pragma("unroll") for (int k = 0; k < 2; ++k) dst[m][k] = *(const PG8_LAS bf16x8*)(lds + PG8_SA(b, h) + aoff + m * 2048 + k * 1024); } while (0)
#define PG8_LDB(dst, b, h) do { _Pragma("unroll") for (int n = 0; n < 2; ++n) _Pragma("unroll") for (int k = 0; k < 2; ++k) dst[n][k] = *(const PG8_LAS bf16x8*)(lds + PG8_SB(b, h) + boff + n * 2048 + k * 1024); } while (0)
#define PG8_MMA(ai, bj, At, Bt) do { __builtin_amdgcn_s_setprio(1); _Pragma("unroll") for (int m = 0; m < 4; ++m) _Pragma("unroll") for (int n = 0; n < 2; ++n) _Pragma("unroll") for (int k = 0; k < 2; ++k) \
        acc[ai][bj][m][n] = __builtin_amdgcn_mfma_f32_16x16x32_bf16(Bt[n][k], At[m][k], acc[ai][bj][m][n], 0, 0, 0); __builtin_amdgcn_s_setprio(0); } while (0)
#define PG8_WAIT_V(n) asm volatile("s_waitcnt vmcnt(" #n ")" ::: "memory")
#define PG8_WAIT_L(n) asm volatile("s_waitcnt lgkmcnt(" #n ")" ::: "memory")
#define PG8_BAR __builtin_amdgcn_s_barrier()
#define PG8_SCHED __builtin_amdgcn_sched_barrier(0)
    Unit cur, nxt; int ui = 0;
    if (!S.next(0, cur)) return;
    f32x4 acc[2][2][4][2];
#pragma unroll
    for (int a = 0; a < 2; ++a)
#pragma unroll
        for (int b = 0; b < 2; ++b)
#pragma unroll
            for (int m = 0; m < 4; ++m)
#pragma unroll
                for (int n = 0; n < 2; ++n) acc[a][b][m][n] = (f32x4){0.f, 0.f, 0.f, 0.f};
    bf16x8 At[4][2], B0[2][2], B1[2][2];
    const char* cA = (const char*)g.A + (size_t)cur.pm * tstepA + (size_t)cur.pn * pnoff; const char* cB = (const char*)g.Bt + (size_t)cur.pn * tstepB;
    S.a_ready(cur);
    if constexpr (SP2) {
        PG8_STAGE(PG8_SB(0, 0), cB, voffB); PG8_STAGE(PG8_SB(0, 1), cB + hstepB, voffB); PG8_STAGE(PG8_SA(0, 0), cA, voffA); PG8_STAGE(PG8_SA(0, 1), cA + hstepA, voffA);
        if (wr == 1) PG8_BAR;
        PG8_WAIT_V(2); PG8_BAR;
        PG8_STAGE(PG8_SB(1, 0), cB + kstep, voffB); PG8_STAGE(PG8_SA(1, 0), cA + kstep, voffA); PG8_STAGE(PG8_SB(1, 1), cB + hstepB + kstep, voffB);
        PG8_WAIT_V(6); PG8_BAR;
    } else {
        PG8_STAGE(PG8_SB(0, 0), cB, voffB); PG8_STAGE(PG8_SA(0, 0), cA, voffA); PG8_STAGE(PG8_SB(0, 1), cB + hstepB, voffB); PG8_STAGE(PG8_SA(0, 1), cA + hstepA, voffA);
        if (wr == 1) PG8_BAR;
        PG8_WAIT_V(4); PG8_BAR;
        PG8_STAGE(PG8_SB(1, 0), cB + kstep, voffB); PG8_STAGE(PG8_SA(1, 0), cA + kstep, voffA); PG8_STAGE(PG8_SB(1, 1), cB + hstepB + kstep, voffB);
        PG8_WAIT_V(6); PG8_BAR;
    }
    for (;;) {
        const bool has_next = S.next(ui + 1, nxt);
        const char* nA = has_next ? (const char*)g.A + (size_t)nxt.pm * tstepA + (size_t)nxt.pn * pnoff : cA; const char* nB = has_next ? (const char*)g.Bt + (size_t)nxt.pn * tstepB : cB;
        for (int t = 0; t < nt; t += 2) {
            const bool last = (t == nt - 2);
            const char* a1 = cA + (size_t)(t + 1) * kstep;
            const char* a2 = last ? nA : cA + (size_t)(t + 2) * kstep; const char* b2 = last ? nB : cB + (size_t)(t + 2) * kstep;
            const char* a3 = a2 + kstep; const char* b3 = b2 + kstep;
            if (last && has_next) S.a_ready(nxt);
            if constexpr (SP2) {
            PG8_LDB(B0, 0, 0); PG8_LDB(B1, 0, 1); PG8_SCHED; PG8_LDA(At, 0, 0); PG8_STAGE(PG8_SA(1, 1), a1 + hstepA, voffA);
            PG8_WAIT_V(8); PG8_WAIT_L(0); PG8_BAR; PG8_MMA(0, 0, At, B0); PG8_MMA(0, 1, At, B1); PG8_BAR; PG8_SCHED;
            PG8_LDA(At, 0, 1); PG8_STAGE(PG8_SB(0, 0), b2, voffB); PG8_STAGE(PG8_SB(0, 1), b2 + hstepB, voffB); PG8_STAGE(PG8_SA(0, 0), a2, voffA);
            PG8_WAIT_V(8); PG8_WAIT_L(0); PG8_BAR; PG8_MMA(1, 0, At, B0); PG8_MMA(1, 1, At, B1); PG8_BAR; PG8_SCHED;
            PG8_LDB(B0, 1, 0); PG8_LDB(B1, 1, 1); PG8_SCHED; PG8_LDA(At, 1, 0); PG8_STAGE(PG8_SA(0, 1), a2 + hstepA, voffA);
            PG8_WAIT_V(8); PG8_WAIT_L(0); PG8_BAR; PG8_MMA(0, 0, At, B0); PG8_MMA(0, 1, At, B1); PG8_BAR; PG8_SCHED;
            PG8_LDA(At, 1, 1); PG8_STAGE(PG8_SB(1, 0), b3, voffB); PG8_STAGE(PG8_SB(1, 1), b3 + hstepB, voffB); PG8_STAGE(PG8_SA(1, 0), a3, voffA);
            PG8_WAIT_V(8); PG8_WAIT_L(0); PG8_BAR; PG8_MMA(1, 0, At, B0); PG8_MMA(1, 1, At, B1); PG8_BAR; PG8_SCHED;
            } else {
            PG8_LDB(B0, 0, 0); PG8_SCHED; PG8_LDA(At, 0, 0); PG8_STAGE(PG8_SA(1, 1), a1 + hstepA, voffA);
            PG8_WAIT_L(8); PG8_BAR; PG8_WAIT_L(0); PG8_MMA(0, 0, At, B0); PG8_BAR; PG8_SCHED;
            PG8_LDB(B1, 0, 1); PG8_STAGE(PG8_SB(0, 0), b2, voffB);
            PG8_BAR; PG8_WAIT_L(0); PG8_MMA(0, 1, At, B1); PG8_BAR;
            PG8_LDA(At, 0, 1); PG8_STAGE(PG8_SA(0, 0), a2, voffA);
            PG8_BAR; PG8_WAIT_L(0); PG8_MMA(1, 0, At, B0); PG8_BAR; PG8_SCHED;
            PG8_STAGE(PG8_SB(0, 1), b2 + hstepB, voffB);
            PG8_WAIT_V(6); PG8_BAR; PG8_MMA(1, 1, At, B1); PG8_BAR;
            PG8_LDB(B0, 1, 0); PG8_SCHED; PG8_LDA(At, 1, 0); PG8_STAGE(PG8_SA(0, 1), a2 + hstepA, voffA);
            PG8_WAIT_L(8); PG8_BAR; PG8_WAIT_L(0); PG8_MMA(0, 0, At, B0); PG8_BAR; PG8_SCHED;
            PG8_LDB(B1, 1, 1); PG8_STAGE(PG8_SB(1, 0), b3, voffB);
            PG8_BAR; PG8_WAIT_L(0); PG8_MMA(0, 1, At, B1); PG8_BAR;
            PG8_LDA(At, 1, 1); PG8_STAGE(PG8_SA(1, 0), a3, voffA);
            PG8_BAR; PG8_WAIT_L(0); PG8_MMA(1, 0, At, B0); PG8_BAR; PG8_SCHED;
            PG8_STAGE(PG8_SB(1, 1), b3 + hstepB, voffB);
            PG8_WAIT_V(6); PG8_BAR; PG8_MMA(1, 1, At, B1); PG8_BAR;
            }
        }
        if constexpr (ALIGN_EPI) { if (wr == 0) PG8_BAR; }
        if constexpr (!Epi::AFTER_DRAIN) { E(acc, cur, wr, wc, fr, fq); S.done(cur); }
        if (!has_next) break;
#pragma unroll
        for (int a = 0; a < 2; ++a)
#pragma unroll
            for (int b = 0; b < 2; ++b)
#pragma unroll
                for (int m = 0; m < 4; ++m)
#pragma unroll
                    for (int n = 0; n < 2; ++n) acc[a][b][m][n] = (f32x4){0.f, 0.f, 0.f, 0.f};
        cur = nxt; cA = nA; cB = nB; ++ui;
        if constexpr (ALIGN_EPI) { if (wr == 1) PG8_BAR; }
    }
    PG8_WAIT_V(0);
    if constexpr (!ALIGN_EPI) { if (wr == 0) PG8_BAR; }
    PG8_BAR;
    if constexpr (Epi::AFTER_DRAIN) { E.fused(acc, cur, wr, wc, fr, fq, lds, wid, lane); S.done(cur); }
#undef PG8_SA
#undef PG8_SB
#undef PG8_STAGE
#undef PG8_LDA
#undef PG8_LDB
#undef PG8_MMA
#undef PG8_WAIT_V
#undef PG8_WAIT_L
#undef PG8_BAR
#undef PG8_SCHED
}
}

namespace epi {
using pg8::Unit; using pg8::HALF; using pg8::BM;

DI void store_bf16_tile(const f32x4 (&acc)[2][2][4][2], bf16_t* base, int ld, int row0, int col0) {
#pragma unroll
    for (int ai = 0; ai < 2; ++ai)
#pragma unroll
        for (int m = 0; m < 4; ++m) { bf16_t* rowp = base + (size_t)(row0 + ai * HALF + m * 16) * ld + col0;
#pragma unroll
            for (int bj = 0; bj < 2; ++bj) { const f32x4 v0 = acc[ai][bj][m][0], v1 = acc[ai][bj][m][1];
                u32x4 w; w.x = pk2(v0[0], v0[1]); w.y = pk2(v0[2], v0[3]); w.z = pk2(v1[0], v1[1]); w.w = pk2(v1[2], v1[3]);
                *(u32x4*)(rowp + bj * HALF) = w; } }
}

struct EpiE0 {
    static constexpr bool PERM = true, AFTER_DRAIN = false;
    bf16_t* zab; bf16_t* xbcraw; bf16_t* xb; float* dtraw;
    DI void operator()(const f32x4 (&acc)[2][2][4][2], const Unit& u, int wr, int wc, int fr, int fq) const {
        const int pn = u.pn, row0 = u.pm * BM + wr * 64 + fr;
        bf16_t* base; int ld, colt;
        if (pn < 4) { base = zab; ld = 2048; colt = pn * 256; }
        else if (pn < 12) { base = xbcraw; ld = 2048; colt = (pn - 4) * 256; }
        else if (pn < 16) { base = zab; ld = 2048; colt = 1024 + (pn - 12) * 256; }
        else if (pn < 20) { base = xb; ld = 1024; colt = (pn - 16) * 256; }
        else {
            if (wc == 0) {
#pragma unroll
                for (int ai = 0; ai < 2; ++ai)
#pragma unroll
                    for (int m = 0; m < 4; ++m) { float* p = dtraw + (size_t)(row0 + ai * HALF + m * 16) * 32 + 8 * fq;
                        *(f32x4*)p = acc[ai][0][m][0]; *(f32x4*)(p + 4) = acc[ai][0][m][1]; }
            }
            return;
        }
        store_bf16_tile(acc, base, ld, row0, colt + wc * 32 + 8 * fq);
    }
};
struct EpiO {
    static constexpr bool PERM = true, AFTER_DRAIN = false;
    bf16_t* u1; const float* rope; int grow0;
    DI void operator()(const f32x4 (&acc)[2][2][4][2], const Unit& u, int wr, int wc, int fr_, int fq_) const {
        int lane; asm volatile("v_mbcnt_lo_u32_b32 %0, -1, 0\n\tv_mbcnt_hi_u32_b32 %0, -1, %0" : "=v"(lane));
        const int fr = lane & 15, fq = lane >> 4;
        const int gr0 = grow0 + u.pm * BM, pn = u.pn;
        const bool rot = gr0 >= R_CTX && (pn < 8 || (pn >= 16 && pn <= 20));
        const int rl0 = u.pm * BM + wr * 64 + fr, col0 = pn * 256 + wc * 32 + 8 * fq;
        if (!rot) { store_bf16_tile(acc, u1, N_O, rl0, col0); return; }
        const int axis = wc & 1;
        const bool upper = lane >= 32;
        const float sgn = upper ? 1.f : -1.f;
#pragma unroll
        for (int ai = 0; ai < 2; ++ai)
#pragma unroll
            for (int m = 0; m < 4; ++m) {
                const int rl = rl0 + ai * HALF + m * 16;
                const int t = (grow0 + rl - R_CTX) & 4095, pos = axis ? (t & 63) : (t >> 6);
                const float* cp = rope + pos * 16 + 8 * (fq & 1);
                const f32x4 c0 = *(const f32x4*)cp, c1 = *(const f32x4*)(cp + 4), s0 = *(const f32x4*)(cp + 1024) * sgn, s1 = *(const f32x4*)(cp + 1028) * sgn;
                bf16_t* rowp = u1 + (size_t)rl * N_O + col0;
#pragma unroll
                for (int bj = 0; bj < 2; ++bj) {
                    f32x4 o[2];
#pragma unroll
                    for (int n = 0; n < 2; ++n) { const f32x4 own = acc[ai][bj][m][n]; f32x4 par;
#pragma unroll
                        for (int q = 0; q < 4; ++q) { auto rr = __builtin_amdgcn_permlane32_swap(__float_as_uint(own[q]), __float_as_uint(own[q]), false, false); par[q] = __uint_as_float(upper ? rr[0] : rr[1]); }
                        o[n] = own * (n ? c1 : c0) + par * (n ? s1 : s0); }
                    u32x4 w; w.x = pk2(o[0][0], o[0][1]); w.y = pk2(o[0][2], o[0][3]); w.z = pk2(o[1][0], o[1][1]); w.w = pk2(o[1][2], o[1][3]);
                    *(u32x4*)(rowp + bj * HALF) = w;
                }
            }
    }
};
struct EpiPool {
    static constexpr bool PERM = true, AFTER_DRAIN = false;
    bf16_t* aout; const bf16_t* zab; const float* ssy;
    DI void operator()(const f32x4 (&acc)[2][2][4][2], const Unit& u, int wr, int wc, int fr_, int fq_) const {
        int lane; asm volatile("v_mbcnt_lo_u32_b32 %0, -1, 0\n\tv_mbcnt_hi_u32_b32 %0, -1, %0" : "=v"(lane));
        const int fr = lane & 15, fq = lane >> 4;
        const int row0 = u.pm * BM + wr * 64 + fr, col0 = u.pn * 256 + wc * 32 + 8 * fq;
#pragma unroll
        for (int ai = 0; ai < 2; ++ai)
#pragma unroll
            for (int m = 0; m < 4; ++m) { const size_t r = (size_t)(row0 + ai * HALF + m * 16); const float irs = sqrtf(ssy[r] * (1.f / 1024.f) + EPS);
#pragma unroll
                for (int bj = 0; bj < 2; ++bj) {
                    const size_t off = r * 2048 + 1024 + col0 + bj * HALF;
                    const u32x4 z = *(const u32x4*)(zab + off);
                    const f32x4 v0 = acc[ai][bj][m][0] * irs, v1 = acc[ai][bj][m][1] * irs;
                    u32x4 w; w.x = pk2(v0[0] * silu_f(lo_f(z.x)), v0[1] * silu_f(hi_f(z.x))); w.y = pk2(v0[2] * silu_f(lo_f(z.y)), v0[3] * silu_f(hi_f(z.y)));
                    w.z = pk2(v1[0] * silu_f(lo_f(z.z)), v1[1] * silu_f(hi_f(z.z))); w.w = pk2(v1[2] * silu_f(lo_f(z.w)), v1[3] * silu_f(hi_f(z.w)));
                    *(u32x4*)(aout + off) = w;
                    asm volatile("" ::: "memory"); } }
    }
};
template <bool L0>
struct EpiRes {
    static constexpr bool PERM = true, AFTER_DRAIN = false;
    const float* xp; const float* xs;
    float* out;
    const float* modl;
    int grow0;
    const float* ssy;
    bf16_t* x1b;
    bf16_t* x2b;
    DI void operator()(const f32x4 (&acc)[2][2][4][2], const Unit& u, int wr, int wc, int fr_, int fq_) const {
        int lane; asm volatile("v_mbcnt_lo_u32_b32 %0, -1, 0\n\tv_mbcnt_hi_u32_b32 %0, -1, %0" : "=v"(lane));
        const int fr = lane & 15, fq = lane >> 4;
        const int gr0 = grow0 + u.pm * BM;
        const int g = gr0 < R_CTX ? 8 : ((gr0 - R_CTX) >> 12);
        const float* gate = modl + g * 3072 + 2048;
        const int col0 = u.pn * 256 + wc * 32 + 8 * fq, rl = wr * 64 + fr;
        f32x4 gv[2][2];
#pragma unroll
        for (int bj = 0; bj < 2; ++bj) { gv[bj][0] = *(const f32x4*)(gate + col0 + bj * HALF); gv[bj][1] = *(const f32x4*)(gate + col0 + bj * HALF + 4); }
#pragma unroll
        for (int ai = 0; ai < 2; ++ai)
#pragma unroll
            for (int m = 0; m < 4; ++m) { const int rt = rl + ai * HALF + m * 16; const size_t loff = (size_t)(u.pm * BM + rt) * DM + col0;
                float rs = 1.f; if (L0) rs = rsqrtf(ssy[u.pm * BM + rt] * (1.f / 1024.f) + EPS);
#pragma unroll
                for (int bj = 0; bj < 2; ++bj) {
                    f32x4 x0, x1;
                    if (L0) { const float* xin = (gr0 < R_CTX ? xp + (size_t)gr0 * DM : xs + (size_t)(gr0 - R_CTX) * DM) + (size_t)rt * DM + col0 + bj * HALF;
                        x0 = *(const f32x4*)xin; x1 = *(const f32x4*)(xin + 4); }
                    else { const u32x4 xb = *(const u32x4*)(x1b + loff + bj * HALF); x0 = (f32x4){lo_f(xb.x), hi_f(xb.x), lo_f(xb.y), hi_f(xb.y)}; x1 = (f32x4){lo_f(xb.z), hi_f(xb.z), lo_f(xb.w), hi_f(xb.w)}; }
                    const f32x4 y0 = x0 + gv[bj][0] * (acc[ai][bj][m][0] * rs), y1 = x1 + gv[bj][1] * (acc[ai][bj][m][1] * rs);
                    u32x4 w; w.x = pk2(y0[0], y0[1]); w.y = pk2(y0[2], y0[3]); w.z = pk2(y1[0], y1[1]); w.w = pk2(y1[2], y1[3]);
                    *(u32x4*)((L0 ? x1b : x2b) + loff + bj * HALF) = w;
                }
                asm volatile("" ::: "memory"); }
    }
};
}
struct Params { const float* in[28]; float* out; unsigned char* ws; int ph_lo, ph_hi; };
struct Frame {
    ldsp lds; int tid, lane, wave, G, bid;
    const Params& p; float* out; unsigned char* ws; int probe;
};
enum { I_XP = 0, I_XS, I_SSDF, I_SSDB, I_CDK, I_CDV, I_CWK, I_CWV, I_C, I_CCTX, I_WADA, I_BADA, I_EWIN, I_ECONVW, I_ECONVB, I_EALOG, I_EDTB, I_ED, I_ENORMG,
       I_EPOOLW, I_EPOOLS, I_EWOUT, I_OWIN, I_OLAM, I_OSUBG, I_OSINK, I_OWOUT, I_FNORMG };

DI void transpose_item(const float* W, int ldw, int srcn0, int K, bf16_t* WT, int dstn0, int k0, LAS float* scr, int lane, const float* nscale = nullptr) {
    if (srcn0 >= 0) {
#pragma unroll 8
        for (int i = 0; i < 32; ++i) { const int kk = 2 * i + (lane >> 5); scr[kk * 33 + (lane & 31)] = W[(size_t)(k0 + kk) * ldw + srcn0 + (lane & 31)]; }
    } else {
#pragma unroll 8
        for (int i = 0; i < 32; ++i) { const int kk = 2 * i + (lane >> 5); scr[kk * 33 + (lane & 31)] = 0.f; }
    }
    asm volatile("s_waitcnt lgkmcnt(0)" ::: "memory");
    const int c = lane & 7;
#pragma unroll
    for (int j = 0; j < 4; ++j) { const int n = (lane >> 3) + 8 * j; const LAS float* s = scr + (8 * c) * 33 + n;
        const float sc = nscale ? nscale[n] : 1.f;
        u32x4 o; o.x = pk2(s[0 * 33] * sc, s[1 * 33] * sc); o.y = pk2(s[2 * 33] * sc, s[3 * 33] * sc); o.z = pk2(s[4 * 33] * sc, s[5 * 33] * sc); o.w = pk2(s[6 * 33] * sc, s[7 * 33] * sc);
        *(u32x4*)(WT + (size_t)(dstn0 + n) * K + k0 + 8 * c) = o; }
    asm volatile("s_waitcnt lgkmcnt(0)" ::: "memory");
}

DI void phase_p0(Frame& F) {
    if (F.bid < 192) {
        LAS float* sv = (LAS float*)F.lds;
        LAS float* red = (LAS float*)(F.lds + 40960);
        for (int i = F.tid; i < 9 * 1024; i += NTHREADS) { const int g = i >> 10, k = i & 1023; const float v = g < 8 ? F.p.in[I_C][g * 1024 + k] : F.p.in[I_CCTX][k]; sv[i] = silu_f(v); }
        __syncthreads();
        const int l = F.bid / 96, n0 = (F.bid % 96) * 32, kg = F.tid >> 5, c = F.tid & 31;
        const float* w = F.p.in[I_WADA] + (size_t)l * 1024 * 3072 + n0 + c;
        float acc[9];
#pragma unroll
        for (int g = 0; g < 9; ++g) acc[g] = 0.f;
#pragma unroll 4
        for (int kk = 0; kk < 64; ++kk) { const int k = kg * 64 + kk; const float wv = w[(size_t)k * 3072];
#pragma unroll
            for (int g = 0; g < 9; ++g) acc[g] += sv[g * 1024 + k] * wv; }
#pragma unroll
        for (int g = 0; g < 9; ++g) red[(kg * 9 + g) * 32 + c] = acc[g];
        __syncthreads();
        if (F.tid < 288) { const int g = F.tid >> 5, cc = F.tid & 31; float s = F.p.in[I_BADA][l * 3072 + n0 + cc];
#pragma unroll
            for (int q = 0; q < 16; ++q) s += red[(q * 9 + g) * 32 + cc];
            ((float*)(F.ws + WS_MOD))[(l * 9 + g) * 3072 + n0 + cc] = s; }
        __syncthreads();
    }
    if (F.bid == F.G - 1) {
        float* rc = (float*)(F.ws + WS_ROPE); float* rs = rc + 1024;
        for (int i = F.tid; i < 1024; i += NTHREADS) { const int pos = i >> 4, f = i & 15; const float inv = __builtin_amdgcn_exp2f(-(float)f * (13.287712379549449f / 16.f)); const float ang = (float)pos * inv; rc[i] = __cosf(ang); rs[i] = __sinf(ang); }
        if (F.tid == 0) { const float* lp = F.p.in[I_OLAM]; float s1 = 0.f, s2 = 0.f;
            for (int i = 0; i < 64; ++i) { s1 += lp[i] * lp[64 + i]; s2 += lp[128 + i] * lp[192 + i]; }
            float lam_init = 0.8f - 0.6f * 0.7408182206817179f; asm volatile("" : "+v"(lam_init));
            float* o = (float*)(F.ws + WS_LAM); o[0] = __expf(s1) - __expf(s2) + lam_init; o[1] = 1.f - lam_init; }
    }
    {
        LAS float* scr = (LAS float*)(F.lds + 65536 + F.wave * 8704);
        const int gw = F.bid * NWAVES + F.wave, NGW = F.G * NWAVES;
        for (int it = gw; it < 8192; it += NGW) {
            int r = it;
            if (r < 2688) { const int kb = r / 168, nb = r % 168; int src;
                if (nb < 96) src = nb * 32; else if (nb < 160) src = (nb + 1) * 32; else if (nb == 160) src = 3072; else src = -1;
                transpose_item(F.p.in[I_EWIN], 5152, src, 1024, (bf16_t*)(F.ws + WS_WT_IN_E), nb * 32, kb * 64, scr, F.lane); continue; }
            r -= 2688;
            if (r < 1024) { const int kb = r >> 5, nb = r & 31; transpose_item(F.p.in[I_EWOUT], 1024, nb * 32, 2048, (bf16_t*)(F.ws + WS_WT_OUT_E), nb * 32, kb * 64, scr, F.lane); continue; }
            r -= 1024;
            if (r < 3328) { const int kb = r / 208, nb = r % 208; transpose_item(F.p.in[I_OWIN], N_O, nb * 32, 1024, (bf16_t*)(F.ws + WS_WT_IN_O), nb * 32, kb * 64, scr, F.lane); continue; }
            r -= 3328;
            if (r < 1024) { const int kb = r >> 5, nb = r & 31; transpose_item(F.p.in[I_OWOUT], 1024, nb * 32, 2048, (bf16_t*)(F.ws + WS_WT_OUT_O), nb * 32, kb * 64, scr, F.lane); continue; }
            r -= 1024;
            { const int g = r >> 5, q = r & 31, kb = q >> 3, nb = q & 7;
              transpose_item(F.p.in[I_EPOOLW] + (size_t)g * 65536, 256, nb * 32, 256, (bf16_t*)(F.ws + WS_WT_POOL) + (size_t)g * 65536, nb * 32, kb * 64, scr, F.lane, F.p.in[I_EPOOLS] + g * 256 + nb * 32); }
        }
    }
    {
        const int gt = F.bid * NTHREADS + F.tid, NT = F.G * NTHREADS;
        for (int it = gt; it < 1310720; it += NT) {
            const float* src; bf16_t* dst; int o = it;
            if (o < 524288) { src = F.p.in[I_CDK]; dst = (bf16_t*)(F.ws + WS_CK); }
            else if (o < 1048576) { o -= 524288; src = F.p.in[I_CDV]; dst = (bf16_t*)(F.ws + WS_CV); }
            else if (o < 1179648) { o -= 1048576; src = F.p.in[I_CWK]; dst = (bf16_t*)(F.ws + WS_WK); }
            else { o -= 1179648; src = F.p.in[I_CWV]; dst = (bf16_t*)(F.ws + WS_WV); }
            const f32x4 a = *(const f32x4*)(src + (size_t)o * 8), b = *(const f32x4*)(src + (size_t)o * 8 + 4);
            u32x4 w; w.x = pk2(a[0], a[1]); w.y = pk2(a[2], a[3]); w.z = pk2(b[0], b[1]); w.w = pk2(b[2], b[3]);
            *(u32x4*)(dst + (size_t)o * 8) = w;
        }
    }
}

DI void phase_modnorm(Frame& F, int grp, int layer) {
    const int row0 = GRP_ROW0[grp], rows = GRP_ROWS[grp];
    const int gw = F.bid * NWAVES + F.wave, NGW = F.G * NWAVES;
    const float* mod = (const float*)(F.ws + WS_MOD) + layer * 9 * 3072;
    bf16_t* H = (bf16_t*)(F.ws + WS_REGA);
    for (int rl = gw; rl < rows; rl += 2 * NGW) {
        f32x4 v[2][4]; float s[2];
#pragma unroll
        for (int q = 0; q < 2; ++q) { const int grow = row0 + min(rl + q * NGW, rows - 1);
            if (layer == 0) { const float* xrow = grow < R_CTX ? F.p.in[I_XP] + (size_t)grow * DM : F.p.in[I_XS] + (size_t)(grow - R_CTX) * DM;
                const f32x4* xr = (const f32x4*)xrow + F.lane;
#pragma unroll
                for (int j = 0; j < 4; ++j) v[q][j] = xr[64 * j]; }
            else { const u32x2* xr = (const u32x2*)((const bf16_t*)(F.ws + WS_X1B) + (size_t)(grow - row0) * DM) + F.lane;
#pragma unroll
                for (int j = 0; j < 4; ++j) { const u32x2 w = xr[64 * j]; v[q][j] = (f32x4){lo_f(w.x), hi_f(w.x), lo_f(w.y), hi_f(w.y)}; } } }
#pragma unroll
        for (int q = 0; q < 2; ++q) { float t = 0.f;
#pragma unroll
            for (int j = 0; j < 4; ++j) t += (v[q][j].x * v[q][j].x + v[q][j].y * v[q][j].y) + (v[q][j].z * v[q][j].z + v[q][j].w * v[q][j].w);
            s[q] = t; }
#pragma unroll
        for (int o = 1; o < 64; o <<= 1) { s[0] += shfl_idx(s[0], F.lane ^ o); s[1] += shfl_idx(s[1], F.lane ^ o); }
#pragma unroll
        for (int q = 0; q < 2; ++q) { const int rq = min(rl + q * NGW, rows - 1), grow = row0 + rq; const RowInfo ri = rowinfo(grow);
            const float rstd = rsqrtf(s[q] * (1.f / DM) + EPS);
            const float* sh = mod + ri.g * 3072; const float* sc = sh + 1024;
            u32x2* o8 = (u32x2*)(H + (size_t)rq * DM) + F.lane;
#pragma unroll
            for (int j = 0; j < 4; ++j) { const f32x4 a = *((const f32x4*)sh + F.lane + 64 * j), b = *((const f32x4*)sc + F.lane + 64 * j);
                const f32x4 y = v[q][j] * rstd * (b + 1.f) + a; u32x2 w; w.x = pk2(y.x, y.y); w.y = pk2(y.z, y.w); o8[64 * j] = w; } }
    }
}

DI float softplus_f(float x) { return x > 15.f ? x : (x < -15.f ? __expf(x) : __logf(1.f + __expf(x))); }
DI void acc8(float (&s)[8], const u32x4 xv, const float sg) {
    s[0] += sg * lo_f(xv.x); s[1] += sg * hi_f(xv.x); s[2] += sg * lo_f(xv.y); s[3] += sg * hi_f(xv.y); s[4] += sg * lo_f(xv.z); s[5] += sg * hi_f(xv.z); s[6] += sg * lo_f(xv.w); s[7] += sg * hi_f(xv.w);
}
template <int W>
DI void pool_task(const bf16_t* xp, bf16_t* op, const int t0, const int T) {
    constexpr int LEFT = W / 2, RIGHT = W - 1 - LEFT, S = 16, NR = S + W - 1;
    const u32x4 zero4 = {0u, 0u, 0u, 0u};
    u32x4 r[NR];
#pragma unroll
    for (int k = 0; k < NR; ++k) { const int pos = t0 - LEFT + k; r[k] = (pos >= 0 && pos < T) ? *(const u32x4*)(xp + (ptrdiff_t)(k - LEFT) * 1024) : zero4; }
    float s[8];
#pragma unroll
    for (int e = 0; e < 8; ++e) s[e] = 0.f;
#pragma unroll
    for (int k = 0; k < W; ++k) acc8(s, r[k], 1.f);
#pragma unroll
    for (int i = 0; i < S; ++i) {
        const int t = t0 + i, lo = max(t - LEFT, 0), hi = min(t + RIGHT + 1, T);
        const float inv = 1.f / (float)(hi - lo);
        const u32x4 xs = r[i + LEFT];
        u32x4 o; o.x = pk2(s[0] * inv - lo_f(xs.x), s[1] * inv - hi_f(xs.x)); o.y = pk2(s[2] * inv - lo_f(xs.y), s[3] * inv - hi_f(xs.y));
        o.z = pk2(s[4] * inv - lo_f(xs.z), s[5] * inv - hi_f(xs.z)); o.w = pk2(s[6] * inv - lo_f(xs.w), s[7] * inv - hi_f(xs.w));
        *(u32x4*)(op + (size_t)i * 1024) = o;
        if (i + 1 < S) { acc8(s, r[i + W], 1.f); acc8(s, r[i], -1.f); }
    }
}
DI void phase_conv(Frame& F, int grp) {
    const int row0 = GRP_ROW0[grp], rows = GRP_ROWS[grp];
    const int gt = F.bid * NTHREADS + F.tid, NT = F.G * NTHREADS;
    { float* ssy = (float*)(F.ws + WS_SSY); float* ss1 = (float*)(F.ws + WS_SS1); for (int i = gt; i < rows; i += NT) { ssy[i] = 0.f; ss1[i] = 0.f; } }
    const bf16_t* xb = (const bf16_t*)(F.ws + WS_XB); bf16_t* pooled = (bf16_t*)(F.ws + WS_POOLED);
    const int nstrip = rows / 16;
    for (int task = gt; task < nstrip * 128; task += NT) {
        const int g = task / (nstrip * 32), rem = task - g * (nstrip * 32), strip = rem >> 5, c0 = g * 256 + (rem & 31) * 8, rl0 = strip * 16;
        const RowInfo ri = rowinfo(row0 + rl0);
        const bf16_t* xp = xb + (size_t)rl0 * 1024 + c0; bf16_t* op = pooled + (size_t)rl0 * 1024 + c0;
        if (g == 0) pool_task<2>(xp, op, ri.t, ri.T); else if (g == 1) pool_task<4>(xp, op, ri.t, ri.T); else if (g == 2) pool_task<8>(xp, op, ri.t, ri.T); else pool_task<16>(xp, op, ri.t, ri.T);
    }
    const float* dtraw = (const float*)(F.ws + WS_DTRAW); float* dtv = (float*)(F.ws + WS_DTV); float* acs = (float*)(F.ws + WS_ACS);
    const int nch = rows >> 7;
    LAS float* tot = (LAS float*)F.lds;
    for (int ci = F.bid; ci < nch; ci += F.G) {
        const int j = F.tid & 31, seg = F.tid >> 5; const size_t r0 = (size_t)ci * 128 + seg * 8;
        const float bias = F.p.in[I_EDTB][j], A = -__expf(F.p.in[I_EALOG][j]);
        float d[8], inc[8], run = 0.f;
#pragma unroll
        for (int i = 0; i < 8; ++i) d[i] = dtraw[(r0 + i) * 32 + j];
#pragma unroll
        for (int i = 0; i < 8; ++i) { d[i] = softplus_f(d[i] + bias); run += d[i] * A; inc[i] = run; }
        tot[seg * 32 + j] = run;
        __syncthreads();
        float before = 0.f, total = 0.f;
#pragma unroll
        for (int s = 0; s < 16; ++s) { const float v = tot[s * 32 + j]; total += v; before += s < seg ? v : 0.f; }
        __syncthreads();
#pragma unroll
        for (int i = 0; i < 8; ++i) { dtv[(r0 + i) * 32 + j] = d[i]; acs[(r0 + i) * 32 + j] = j < 16 ? inc[i] + before : total - (inc[i] + before) + d[i] * A; }
    }
}

DI void phase_bias1(Frame& F) {
    const bf16_t* wt = (const bf16_t*)(F.ws + WS_WT_IN_O); const float* mod1 = (const float*)(F.ws + WS_MOD) + 9 * 3072; float* b1 = (float*)(F.ws + WS_BIAS1);
    const int gw = F.bid * NWAVES + F.wave, NGW = F.G * NWAVES;
    for (int n = gw; n < N_O; n += NGW) {
        const u32x4 w0 = *(const u32x4*)(wt + (size_t)n * 1024 + F.lane * 16), w1 = *(const u32x4*)(wt + (size_t)n * 1024 + F.lane * 16 + 8);
        const float wv[16] = {lo_f(w0.x), hi_f(w0.x), lo_f(w0.y), hi_f(w0.y), lo_f(w0.z), hi_f(w0.z), lo_f(w0.w), hi_f(w0.w), lo_f(w1.x), hi_f(w1.x), lo_f(w1.y), hi_f(w1.y), lo_f(w1.z), hi_f(w1.z), lo_f(w1.w), hi_f(w1.w)};
#pragma unroll 1
        for (int g = 0; g < 9; ++g) { const float* sh = mod1 + g * 3072 + F.lane * 16; float s = 0.f;
#pragma unroll
            for (int q = 0; q < 4; ++q) { const f32x4 v = *(const f32x4*)(sh + 4 * q); s += (v.x * wv[4 * q] + v.y * wv[4 * q + 1]) + (v.z * wv[4 * q + 2] + v.w * wv[4 * q + 3]); }
            s = wave_sum(s, F.lane);
            if (F.lane == 0) b1[g * N_O + n] = s; }
    }
}
template <int NR = 8>
DI void conv_rows_to_lds(const bf16_t* xraw, const float* cw, const float* cb, int rbase, int t0, int T, int col0, int rb, ldsp dst, int dstride) {
    const bf16_t* xp = xraw + (size_t)(rbase + NR * rb) * 2048 + col0;
    const u32x4 zero4 = {0u, 0u, 0u, 0u};
    u32x4 r[NR + 4];
#pragma unroll
    for (int k = 0; k < NR + 4; ++k) { const int pos = t0 + NR * rb + k - 2; r[k] = (pos >= 0 && pos < T) ? *(const u32x4*)(xp + (ptrdiff_t)(k - 2) * 2048) : zero4; }
    float w[5][8], bias[8];
#pragma unroll
    for (int k = 0; k < 5; ++k) { const f32x4 w0 = *(const f32x4*)(cw + k * 2048 + col0), w1 = *(const f32x4*)(cw + k * 2048 + col0 + 4);
        w[k][0] = w0.x; w[k][1] = w0.y; w[k][2] = w0.z; w[k][3] = w0.w; w[k][4] = w1.x; w[k][5] = w1.y; w[k][6] = w1.z; w[k][7] = w1.w; }
    { const f32x4 b0 = *(const f32x4*)(cb + col0), b1 = *(const f32x4*)(cb + col0 + 4); bias[0] = b0.x; bias[1] = b0.y; bias[2] = b0.z; bias[3] = b0.w; bias[4] = b1.x; bias[5] = b1.y; bias[6] = b1.z; bias[7] = b1.w; }
#pragma unroll
    for (int i = 0; i < NR; ++i) {
        float acc[8];
#pragma unroll
        for (int e = 0; e < 8; ++e) acc[e] = bias[e];
#pragma unroll
        for (int k = 0; k < 5; ++k) { const u32x4 xv = r[i + k];
            acc[0] += lo_f(xv.x) * w[k][0]; acc[1] += hi_f(xv.x) * w[k][1]; acc[2] += lo_f(xv.y) * w[k][2]; acc[3] += hi_f(xv.y) * w[k][3];
            acc[4] += lo_f(xv.z) * w[k][4]; acc[5] += hi_f(xv.z) * w[k][5]; acc[6] += lo_f(xv.w) * w[k][6]; acc[7] += hi_f(xv.w) * w[k][7]; }
        u32x4 o; o.x = pk2(silu_f(acc[0]), silu_f(acc[1])); o.y = pk2(silu_f(acc[2]), silu_f(acc[3])); o.z = pk2(silu_f(acc[4]), silu_f(acc[5])); o.w = pk2(silu_f(acc[6]), silu_f(acc[7]));
        lds_st128(dst + (NR * rb + i) * dstride, o);
    }
}

DI void phase_states(Frame& F, int grp) {
    const int row0 = GRP_ROW0[grp], rows = GRP_ROWS[grp], nch = rows >> 7;
    const bf16_t* xraw = (const bf16_t*)(F.ws + WS_XBCRAW);
    const float* dtv = (const float*)(F.ws + WS_DTV); const float* acs = (const float*)(F.ws + WS_ACS);
    float* decay = (float*)(F.ws + WS_DECAY); bf16_t* states = (bf16_t*)(F.ws + WS_REGA);
    const ldsp Bimg = F.lds, ximg = F.lds + 40960, xw = F.lds + 114688; LAS float* wts = (LAS float*)(F.lds + 139264);
    const int lane = F.lane, h = lane >> 5, i16 = lane & 15, qq = i16 >> 2, pp = i16 & 3, blk = (lane >> 4) & 1;
    for (int unit = F.bid; unit < nch * 4; unit += F.G) {
        const int ci = unit >> 2, g = unit & 3, rbase = ci * 128;
        { const RowInfo ri = rowinfo(row0 + rbase);
          conv_rows_to_lds<8>(xraw, F.p.in[I_ECONVW], F.p.in[I_ECONVB], rbase, ri.t, ri.T, g * 256 + (F.tid & 31) * 8, F.tid >> 5, ximg + (F.tid & 31) * 16, 576);
          conv_rows_to_lds<4>(xraw, F.p.in[I_ECONVW], F.p.in[I_ECONVB], rbase, ri.t, ri.T, 1024 + g * 128 + (F.tid & 15) * 8, F.tid >> 4, Bimg + (F.tid & 15) * 16, 320); }
#pragma unroll
        for (int i = 0; i < 2; ++i) { const int v = F.tid + 512 * i, hd = v >> 7, l = v & 127, j = (hd >> 2) * 16 + g * 4 + (hd & 3);
            const float ref = acs[(size_t)(rbase + ((hd >> 2) ? 0 : 127)) * 32 + j];
            wts[v] = __expf(ref - acs[(size_t)(rbase + l) * 32 + j]) * dtv[(size_t)(rbase + l) * 32 + j]; }
        if (F.tid < 8) { const int hd = F.tid, j = (hd >> 2) * 16 + g * 4 + (hd & 3); decay[ci * 32 + j] = __expf(acs[(size_t)(rbase + ((hd >> 2) ? 0 : 127)) * 32 + j]); }
        __syncthreads();
        for (int hd = 0; hd < 8; ++hd) {
            const int r = hd & 3, j = (hd >> 2) * 16 + g * 4 + r;
            { const int l = F.tid >> 2, pq = F.tid & 3; const float w = wts[hd * 128 + l];
              const ldsp src = ximg + l * 576 + (r * 64 + pq * 16) * 2; const ldsp dst = xw + l * 192 + pq * 32;
#pragma unroll
              for (int q = 0; q < 2; ++q) { const u32x4 v = *(const LAS u32x4*)(src + q * 16); u32x4 o;
                  o.x = pk2(lo_f(v.x) * w, hi_f(v.x) * w); o.y = pk2(lo_f(v.y) * w, hi_f(v.y) * w); o.z = pk2(lo_f(v.z) * w, hi_f(v.z) * w); o.w = pk2(lo_f(v.w) * w, hi_f(v.w) * w);
                  lds_st128(dst + q * 16, o); } }
            __syncthreads();
            const int pt = F.wave >> 2, nt = F.wave & 3;
            f32x16 acc;
#pragma unroll
            for (int i = 0; i < 16; ++i) acc[i] = 0.f;
            const ldsp ab = xw + (8 * h + qq) * 192 + (pt * 32 + 16 * blk) * 2 + 8 * pp;
            const ldsp bb = Bimg + (8 * h + qq) * 320 + (nt * 32 + 16 * blk) * 2 + 8 * pp;
#pragma unroll
            for (int ks = 0; ks < 8; ++ks) {
                const bf16x8 a = cat8(lds_tr(ab + ks * 16 * 192), lds_tr(ab + ks * 16 * 192 + 4 * 192));
                const bf16x8 b = cat8(lds_tr(bb + ks * 16 * 320), lds_tr(bb + ks * 16 * 320 + 4 * 320));
                acc = MFMA32(a, b, acc);
            }
            bf16_t* so = states + ((size_t)(ci * 32 + j) * 64 + pt * 32) * 128 + nt * 32 + (lane & 31);
#pragma unroll
            for (int i = 0; i < 16; ++i) so[(size_t)crow(i, h) * 128] = f2bf(acc[i]);
            __syncthreads();
        }
    }
}

DI void phase_scan(Frame& F, int grp) {
    bf16_t* st = (bf16_t*)(F.ws + WS_REGA); const float* decay = (const float*)(F.ws + WS_DECAY);
    const int nlat = 4, nctx = grp == 0 ? 16 : 0;
    const int gt = F.bid * NTHREADS + F.tid, NT = F.G * NTHREADS;
    const int nitems = (nlat + nctx) * 32768;
    for (int it = gt; it < nitems; it += NT) {
        int seq, c0, nc, lat; int rem;
        if (it < nlat * 32768) { seq = it >> 15; rem = it & 32767; lat = 1; nc = 32; c0 = (grp == 0 ? 32 : 0) + 32 * seq; }
        else { const int o = it - nlat * 32768; seq = o >> 15; rem = o & 32767; lat = 0; nc = 2; c0 = 2 * seq; }
        const int j = rem >> 10, e = (rem & 1023) * 8, dir = j >> 4, head = j & 15;
        float hv[8];
        if (lat) { const int b = grp * 4 + seq; const float* s0 = (dir ? F.p.in[I_SSDB] : F.p.in[I_SSDF]) + (size_t)(b * 16 + head) * 8192 + e;
            const f32x4 a = *(const f32x4*)s0, bq = *(const f32x4*)(s0 + 4); hv[0] = a.x; hv[1] = a.y; hv[2] = a.z; hv[3] = a.w; hv[4] = bq.x; hv[5] = bq.y; hv[6] = bq.z; hv[7] = bq.w; }
        else {
#pragma unroll
            for (int i = 0; i < 8; ++i) hv[i] = 0.f; }
        const int cs = dir ? -1 : 1, cb = c0 + (dir ? nc - 1 : 0);
        u32x4 win[4]; float dwin[4];
#pragma unroll
        for (int q = 0; q < 4; ++q) if (q < nc) { const int c = cb + cs * q; win[q] = *(const u32x4*)(st + (size_t)(c * 32 + j) * 8192 + e); dwin[q] = decay[c * 32 + j]; }
        for (int k0 = 0; k0 < nc; k0 += 4) {
#pragma unroll
            for (int q = 0; q < 4; ++q) {
                const int k = k0 + q;
                if (k < nc) {
                    const int c = cb + cs * k;
                    bf16_t* p = st + (size_t)(c * 32 + j) * 8192 + e;
                    const u32x4 sv = win[q]; const float d = dwin[q];
                    if (k + 4 < nc) { const int cn = cb + cs * (k + 4); win[q] = *(const u32x4*)(st + (size_t)(cn * 32 + j) * 8192 + e); dwin[q] = decay[cn * 32 + j]; }
                    u32x4 o; o.x = pk2(hv[0], hv[1]); o.y = pk2(hv[2], hv[3]); o.z = pk2(hv[4], hv[5]); o.w = pk2(hv[6], hv[7]);
                    *(u32x4*)p = o;
                    hv[0] = hv[0] * d + lo_f(sv.x); hv[1] = hv[1] * d + hi_f(sv.x); hv[2] = hv[2] * d + lo_f(sv.y); hv[3] = hv[3] * d + hi_f(sv.y);
                    hv[4] = hv[4] * d + lo_f(sv.z); hv[5] = hv[5] * d + hi_f(sv.z); hv[6] = hv[6] * d + lo_f(sv.w); hv[7] = hv[7] * d + hi_f(sv.w);
                }
            }
        }
        if (!lat) { float* o = F.out + (dir ? OUT_SSD_B : OUT_SSD_F) + (size_t)(seq * 16 + head) * 8192 + e;
            *(f32x4*)o = (f32x4){hv[0], hv[1], hv[2], hv[3]}; *(f32x4*)(o + 4) = (f32x4){hv[4], hv[5], hv[6], hv[7]}; }
    }
}

DI void phase_y(Frame& F, int grp) {
    const int row0 = GRP_ROW0[grp], rows = GRP_ROWS[grp], nch = rows >> 7;
    const bf16_t* xraw = (const bf16_t*)(F.ws + WS_XBCRAW);
    const float* dtv = (const float*)(F.ws + WS_DTV); const float* acs = (const float*)(F.ws + WS_ACS);
    const bf16_t* hprev = (const bf16_t*)(F.ws + WS_REGA);
    const bf16_t* zab = (const bf16_t*)(F.out + OUT_X + (size_t)row0 * DM);
    bf16_t* aout = (bf16_t*)(F.ws + WS_AOUT);
    const ldsp Bimg = F.lds, Cimg = F.lds + 34816, ximg = F.lds + 69632; LAS float* arr = (LAS float*)(F.lds + 143360);
    const int lane = F.lane, h = lane >> 5, r32 = lane & 31, i16 = lane & 15, qq = i16 >> 2, pp = i16 & 3, blk = (lane >> 4) & 1;
    const int lt = F.wave & 3, pt = F.wave >> 2;
    for (int unit = F.bid; unit < nch * 4; unit += F.G) {
        const int ci = unit >> 2, g = unit & 3, rbase = ci * 128;
        { const RowInfo ri = rowinfo(row0 + rbase);
#pragma unroll 1
          for (int id = F.tid; id < 1024; id += 512) { const int chunk = id & 63, rb = id >> 6;
              if (chunk < 16) conv_rows_to_lds(xraw, F.p.in[I_ECONVW], F.p.in[I_ECONVB], rbase, ri.t, ri.T, 1024 + g * 128 + chunk * 8, rb, Bimg + chunk * 16, 272);
              else if (chunk < 32) conv_rows_to_lds(xraw, F.p.in[I_ECONVW], F.p.in[I_ECONVB], rbase, ri.t, ri.T, 1536 + g * 128 + (chunk - 16) * 8, rb, Cimg + (chunk - 16) * 16, 272);
              else conv_rows_to_lds(xraw, F.p.in[I_ECONVW], F.p.in[I_ECONVB], rbase, ri.t, ri.T, g * 256 + (chunk - 32) * 8, rb, ximg + (chunk - 32) * 16, 576); } }
#pragma unroll
        for (int i = 0; i < 4; ++i) { const int v = F.tid + 512 * i, kind = v >> 9, r = (v >> 7) & 3, l = v & 127, j = (kind & 1) * 16 + g * 4 + r;
            arr[v] = (kind < 2 ? acs : dtv)[(size_t)(rbase + l) * 32 + j]; }
#pragma unroll
        for (int i = 0; i < 2; ++i) { const int v = F.tid + 512 * i, dirb = v >> 9, r = (v >> 7) & 3, sidx = v & 127, j = dirb * 16 + g * 4 + r;
            const int e = dirb ? (sidx & ~31) : (sidx | 31);
            arr[2048 + v] = __expf(acs[(size_t)(rbase + e) * 32 + j] - acs[(size_t)(rbase + sidx) * 32 + j]) * dtv[(size_t)(rbase + sidx) * 32 + j]; }
        __syncthreads();
        const int l = lt * 32 + r32;
        const ldsp cfp = Cimg + l * 272 + 8 * h * 2;
        const size_t rl = (size_t)(rbase + l);
        f32x16 cbt[4];
#pragma unroll
        for (int st = 0; st < 4; ++st) {
#pragma unroll
            for (int i = 0; i < 16; ++i) cbt[st][i] = 0.f;
            const ldsp bfp = Bimg + (st * 32 + r32) * 272 + 8 * h * 2;
#pragma unroll
            for (int ks = 0; ks < 8; ++ks) cbt[st] = MFMA32(lds_ld128(bfp + 32 * ks), lds_ld128(cfp + 32 * ks), cbt[st]);
        }
        __syncthreads();
#pragma unroll 1
        for (int r = 0; r < 4; ++r) {
            const int head = g * 4 + r;
            const bf16_t* hf = hprev + ((size_t)(ci * 32 + head) * 64 + pt * 32 + r32) * 128 + 8 * h;
            const bf16_t* hb = hf + (size_t)16 * 8192;
            bf16x8 hfv[8];
#pragma unroll
            for (int ks = 0; ks < 8; ++ks) hfv[ks] = *(const bf16x8*)(hf + 16 * ks);

            const float af_l = arr[(0 * 4 + r) * 128 + l], ab_l = arr[(1 * 4 + r) * 128 + l];
            f32x16 yd;
#pragma unroll
            for (int i = 0; i < 16; ++i) yd[i] = 0.f;
#pragma unroll
            for (int st = 0; st < 4; ++st) {
                const LAS float* as_ = arr + r * 128 + st * 32 + 4 * h;
                f32x16 gm;
                if (st < lt) {
                    const float rf = __expf(fminf(af_l - arr[(0 * 4 + r) * 128 + st * 32 + 31], 0.f));
#pragma unroll
                    for (int q = 0; q < 4; ++q) { const f32x4 cfv = *(const LAS f32x4*)(as_ + 4 * 512 + 8 * q);
#pragma unroll
                        for (int e = 0; e < 4; ++e) gm[4 * q + e] = cbt[st][4 * q + e] * (rf * cfv[e]); }
                } else if (st > lt) {
                    const float rf = __expf(fminf(ab_l - arr[(1 * 4 + r) * 128 + st * 32], 0.f));
#pragma unroll
                    for (int q = 0; q < 4; ++q) { const f32x4 cfv = *(const LAS f32x4*)(as_ + 5 * 512 + 8 * q);
#pragma unroll
                        for (int e = 0; e < 4; ++e) gm[4 * q + e] = cbt[st][4 * q + e] * (rf * cfv[e]); }
                } else {
                    int dq = r32 - 4 * h; asm volatile("" : "+v"(dq));
#pragma unroll
                    for (int i = 0; i < 16; ++i) { const int so = (i & 3) + 8 * (i >> 2);
                        const float ef = __expf(fminf(af_l - as_[so], 0.f)) * as_[2 * 512 + so];
                        const float eb = __expf(fminf(ab_l - as_[1 * 512 + so], 0.f)) * as_[3 * 512 + so];
                        gm[i] = cbt[st][i] * ((dq >= so ? ef : 0.f) + (dq <= so ? eb : 0.f)); }
                }
#pragma unroll
                for (int k2 = 0; k2 < 2; ++k2) {
                    const ldsp xa = ximg + (st * 32 + 16 * k2 + 4 * h + qq) * 576 + (r * 64 + pt * 32 + 16 * blk) * 2 + 8 * pp;
                    yd = MFMA32(cat8(lds_tr(xa), lds_tr(xa + 8 * 576)), pack8(gm, k2), yd);
                }
            }
            f32x16 tf, tb;
#pragma unroll
            for (int i = 0; i < 16; ++i) { tf[i] = 0.f; tb[i] = 0.f; }
#pragma unroll
            for (int ks = 0; ks < 8; ++ks) tf = MFMA32(hfv[ks], lds_ld128(cfp + 32 * ks), tf);
#pragma unroll
            for (int ks = 0; ks < 8; ++ks) tb = MFMA32(*(const bf16x8*)(hb + 16 * ks), lds_ld128(cfp + 32 * ks), tb);
            const float ef_l = __expf(af_l), eb_l = __expf(ab_l), Dh = F.p.in[I_ED][head];
            LAS float* ystg = (LAS float*)Bimg;
#pragma unroll
            for (int q4 = 0; q4 < 4; ++q4) {
                const int p0 = pt * 32 + 8 * q4 + 4 * h;
                const u32x2 xv = *(const LAS u32x2*)(ximg + l * 576 + (r * 64 + p0) * 2);
                f32x4 yv;
                yv[0] = yd[4 * q4 + 0] + tf[4 * q4 + 0] * ef_l + tb[4 * q4 + 0] * eb_l + Dh * lo_f(xv.x);
                yv[1] = yd[4 * q4 + 1] + tf[4 * q4 + 1] * ef_l + tb[4 * q4 + 1] * eb_l + Dh * hi_f(xv.x);
                yv[2] = yd[4 * q4 + 2] + tf[4 * q4 + 2] * ef_l + tb[4 * q4 + 2] * eb_l + Dh * lo_f(xv.y);
                yv[3] = yd[4 * q4 + 3] + tf[4 * q4 + 3] * ef_l + tb[4 * q4 + 3] * eb_l + Dh * hi_f(xv.y);
                *(LAS f32x4*)(ystg + l * 68 + p0) = yv;
            }
            __syncthreads();
            {
                const int row = F.tid >> 2, c16 = (F.tid & 3) * 16; const size_t rg = (size_t)(rbase + row);
                const u32x4 z0 = *(const u32x4*)(zab + rg * 2048 + head * 64 + c16), z1 = *(const u32x4*)(zab + rg * 2048 + head * 64 + c16 + 8);
                const unsigned zz[8] = {z0.x, z0.y, z0.z, z0.w, z1.x, z1.y, z1.z, z1.w};
                float ss = 0.f; unsigned ow[8];
#pragma unroll
                for (int q = 0; q < 4; ++q) { const f32x4 yv = *(const LAS f32x4*)(ystg + row * 68 + c16 + 4 * q); const f32x4 gn = *(const f32x4*)(F.p.in[I_ENORMG] + head * 64 + c16 + 4 * q);
                    const float v0 = yv[0] * silu_f(lo_f(zz[2 * q])), v1 = yv[1] * silu_f(hi_f(zz[2 * q])), v2 = yv[2] * silu_f(lo_f(zz[2 * q + 1])), v3 = yv[3] * silu_f(hi_f(zz[2 * q + 1]));
                    ss += (v0 * v0 + v1 * v1) + (v2 * v2 + v3 * v3);
                    ow[2 * q] = pk2(v0 * gn.x, v1 * gn.y); ow[2 * q + 1] = pk2(v2 * gn.z, v3 * gn.w); }
                *(u32x4*)(aout + rg * 2048 + head * 64 + c16) = (u32x4){ow[0], ow[1], ow[2], ow[3]}; *(u32x4*)(aout + rg * 2048 + head * 64 + c16 + 8) = (u32x4){ow[4], ow[5], ow[6], ow[7]};
                ss += shfl_idx(ss, F.lane ^ 1); ss += shfl_idx(ss, F.lane ^ 2);
                if ((F.tid & 3) == 0 && !F.probe) atomicAdd((float*)(F.ws + WS_SSY) + rg, ss);
            }
            __syncthreads();
        }
        __syncthreads();
    }
}
DI void phase_cachecopy(Frame& F) {
    const bf16_t* u1 = (const bf16_t*)(F.ws + WS_U);
    const int gt = F.bid * NTHREADS + F.tid, NT = F.G * NTHREADS;
    for (int it = gt; it < R_CTX * 320; it += NT) {
        const int row = it / 320, ch = it - row * 320, b = row >> 8, t = row & 255;
        int col; float* o;
        if (ch < 128) { col = 1024 + ch * 8; o = F.out + OUT_DIFF_K + ((size_t)(b * 8 + (ch >> 4)) * 256 + t) * 128 + (ch & 15) * 8; }
        else if (ch < 256) { const int c2 = ch - 128; col = 2048 + c2 * 8; o = F.out + OUT_DIFF_V + ((size_t)(b * 8 + (c2 >> 4)) * 256 + t) * 128 + (c2 & 15) * 8; }
        else if (ch < 288) { const int c2 = ch - 256; col = 5120 + c2 * 8; o = F.out + OUT_WIN_K + ((size_t)(b * 4 + (c2 >> 3)) * 256 + t) * 64 + (c2 & 7) * 8; }
        else { const int c2 = ch - 288; col = 5376 + c2 * 8; o = F.out + OUT_WIN_V + ((size_t)(b * 4 + (c2 >> 3)) * 256 + t) * 64 + (c2 & 7) * 8; }
        const u32x4 v = *(const u32x4*)(u1 + (size_t)row * N_O + col);
        *(f32x4*)o = (f32x4){lo_f(v.x), hi_f(v.x), lo_f(v.y), hi_f(v.y)}; *(f32x4*)(o + 4) = (f32x4){lo_f(v.z), hi_f(v.z), lo_f(v.w), hi_f(v.w)};
    }
}

struct AttnSeg { unsigned k, v; int ldk, ldv, nt; };
struct AttnEpi { unsigned aout, z; float lam, oml; };

#ifndef ATT_LEAD
#define ATT_LEAD(w) ((w) < 4)
#endif
#ifndef ATT_PRIO
#define ATT_PRIO 0
#endif
constexpr float ATT_THR = 8.f;
#ifndef ATT_ROT
#define ATT_ROT(qb) ((2 * (qb)) % 72)
#endif
#ifndef ATT_LA
#define ATT_LA 4
#endif
#ifndef ATT_VD
#define ATT_VD 1
#endif
DI void glds16(const void* gsrc, unsigned lds_dst) { unsigned keep;
    asm volatile("s_mov_b32 %0, m0\n\ts_mov_b32 m0, %2\n\ts_nop 0\n\tglobal_load_lds_dwordx4 %1, off\n\ts_mov_b32 m0, %0" : "=&s"(keep) : "v"(gsrc), "s"(lds_dst) : "memory"); }
template <int DV, bool WIN> DI void attn_epilogue(Frame& F, f32x16 (&O)[DV / 32], float lsum, float m, float sink_l2, const AttnEpi E);
template <int DV, int KSLOTS, bool WIN, int PM = 0, bool QPRE = false>
DI void attn_unit(Frame& F, const unsigned qoff, const AttnSeg s0, const AttnSeg s1, int qpos0, int kpos1, bool maskwin, float sink_l2, const AttnEpi E, const int rot, u32x4 (&qpre)[4], const unsigned qnext, const bool more) {
    constexpr int LA = ATT_LA, KR = LA, VR = LA + 1;
    constexpr int KIMG = 8192, KSTAGE = KSLOTS * KIMG, VROW = DV * 2, VSTAGE = 64 * VROW, VBASE = KR * KSTAGE, NDV = DV / 32;
    static_assert(VBASE + VR * VSTAGE <= LDS_BYTES - 8192, "attention rings exceed LDS");
    constexpr int VD = ATT_VD;
    constexpr int VP = VSTAGE / 8192, OPS = KSLOTS + VP;
    int lane; asm volatile("v_mbcnt_lo_u32_b32 %0, -1, 0\n\tv_mbcnt_hi_u32_b32 %0, -1, %0" : "=v"(lane));
    const int wave = F.wave, slot = wave & 1, qb = wave >> 1;
    const int h = lane >> 5, r32 = lane & 31, i16 = lane & 15, qq = i16 >> 2, pp = i16 & 3, blk = (lane >> 4) & 1;
    const int NT = PM == 7 ? (s0.nt + s1.nt) / 2 : s0.nt + s1.nt;
    const unsigned lds0 = (unsigned)(uintptr_t)F.lds;
    const int dk_row = 8 * wave + (lane >> 3), dk_col = (((lane & 7) ^ ((dk_row >> 1) & 7)) * 8);
    const int dv_row = DV == 128 ? 4 * wave + (lane >> 4) : 8 * wave + (lane >> 3);
    const int dv_col = DV == 128 ? (((((lane & 15) >> 2) ^ (dv_row & 3)) * 32) + (lane & 3) * 8) : (((((lane & 7) >> 2) ^ ((dv_row >> 1) & 1)) * 32) + (lane & 3) * 8);
#define ATT_DMA(tt0, ks_, vs_) do { int tr_ = (tt0) + rot; tr_ = tr_ >= NT ? tr_ - NT : tr_; const bool in0 = tr_ < s0.nt; const int ldk_ = in0 ? s0.ldk : s1.ldk, ldv_ = in0 ? s0.ldv : s1.ldv; const int tl = in0 ? tr_ : tr_ - s0.nt; \
        const char* kb_ = (const char*)F.ws + (in0 ? s0.k : s1.k) + (size_t)tl * 128 * ldk_; const char* vb_ = (const char*)F.ws + (in0 ? s0.v : s1.v) + (size_t)tl * 128 * ldv_; \
        const unsigned ko_ = (unsigned)(dk_row * ldk_ + dk_col) * 2u; \
        _Pragma("unroll") for (int s_ = 0; s_ < KSLOTS; ++s_) glds16(kb_ + ko_ + s_ * 128, (unsigned)__builtin_amdgcn_readfirstlane((int)(lds0 + (ks_) * KSTAGE + s_ * KIMG + wave * 1024))); \
        const unsigned vo_ = (unsigned)(dv_row * ldv_ + dv_col) * 2u; \
        _Pragma("unroll") for (int j_ = 0; j_ < VP; ++j_) glds16(vb_ + (size_t)j_ * 64 * ldv_ + vo_, (unsigned)__builtin_amdgcn_readfirstlane((int)(lds0 + VBASE + (vs_) * VSTAGE + (wave + 8 * j_) * 1024))); } while (0)
#define ATT_VMWAIT(n) do { if ((n) == 8) asm volatile("s_waitcnt vmcnt(8)" ::: "memory"); else if ((n) == 6) asm volatile("s_waitcnt vmcnt(6)" ::: "memory"); else if ((n) == 4) asm volatile("s_waitcnt vmcnt(4)" ::: "memory"); else if ((n) == 3) asm volatile("s_waitcnt vmcnt(3)" ::: "memory"); else if ((n) == 2) asm volatile("s_waitcnt vmcnt(2)" ::: "memory"); else if ((n) == 1) asm volatile("s_waitcnt vmcnt(1)" ::: "memory"); else { static_assert(true, ""); asm volatile("s_waitcnt vmcnt(0)" ::: "memory"); } } while (0)
    int kro[4];
#pragma unroll
    for (int d0 = 0; d0 < 4; ++d0) kro[d0] = r32 * 128 + ((((2 * d0 + h) ^ ((r32 >> 1) & 7))) << 4);
    int vro[NDV];
#pragma unroll
    for (int d = 0; d < NDV; ++d) vro[d] = (4 * h + qq) * VROW + ((d ^ (DV == 128 ? qq : (qq >> 1))) * 64) + blk * 32 + pp * 8;
#define ATT_QK(P0, P1, ks_) do { const ldsp kimg_ = F.lds + (ks_) * KSTAGE + (KSLOTS == 2 ? slot * KIMG : 0); bf16x8 kf_[8]; \
        _Pragma("unroll") for (int d0 = 0; d0 < 4; ++d0) { kf_[2 * d0] = lds_ld128(kimg_ + kro[d0]); kf_[2 * d0 + 1] = lds_ld128(kimg_ + kro[d0] + 4096); } \
        __builtin_amdgcn_sched_barrier(0); \
        P0 = MFMA32(kf_[0], qv[0], negm); P1 = MFMA32(kf_[1], qv[0], negm); \
        _Pragma("unroll") for (int d0 = 1; d0 < 4; ++d0) { P0 = MFMA32(kf_[2 * d0], qv[d0], P0); P1 = MFMA32(kf_[2 * d0 + 1], qv[d0], P1); } \
        __builtin_amdgcn_sched_barrier(0); } while (0)
#pragma unroll
    for (int t = 0; t < LA; ++t) ATT_DMA(t, t, t);
    bf16x8 qv[4];
    { const bf16_t* qp = (const bf16_t*)(F.ws + qoff) + (size_t)(qb * 32 + r32) * N_O + slot * 64 + 8 * h;
#pragma unroll
      for (int d0 = 0; d0 < 4; ++d0) { const u32x4 v = QPRE ? qpre[d0] : *(const u32x4*)(qp + 16 * d0); u32x4 o;
          o.x = pk2(lo_f(v.x) * C2, hi_f(v.x) * C2); o.y = pk2(lo_f(v.y) * C2, hi_f(v.y) * C2); o.z = pk2(lo_f(v.z) * C2, hi_f(v.z) * C2); o.w = pk2(lo_f(v.w) * C2, hi_f(v.w) * C2);
          qv[d0] = __builtin_bit_cast(bf16x8, o); } }
    ATT_VMWAIT((LA - 2) * OPS);
    bar_lds();
    f32x16 O[NDV];
#pragma unroll
    for (int d = 0; d < NDV; ++d)
#pragma unroll
        for (int i = 0; i < 16; ++i) O[d][i] = 0.f;
    float m = 0.f, lsum = 0.f;
    f32x16 negm;
#pragma unroll
    for (int i = 0; i < 16; ++i) negm[i] = 0.f;
    const int qpos = qpos0 + qb * 32 + r32;
    f32x16 pC0, pC1;
    ATT_QK(pC0, pC1, 0);
    {
        float rm = fmaxf(pC0[0], pC1[0]);
#pragma unroll
        for (int i = 1; i < 16; ++i) asm("v_max3_f32 %0, %0, %1, %2" : "+v"(rm) : "v"(pC0[i]), "v"(pC1[i]));
        { auto rr = __builtin_amdgcn_permlane32_swap(__float_as_uint(rm), __float_as_uint(rm), false, false); rm = fmaxf(__uint_as_float(rr[0]), __uint_as_float(rr[1])); }
        m = rm;
#pragma unroll
        for (int i = 0; i < 16; ++i) { pC0[i] = __builtin_amdgcn_exp2f(pC0[i] - rm); pC1[i] = __builtin_amdgcn_exp2f(pC1[i] - rm); negm[i] = -rm; }
    }
    bar_lds();
    int ks1 = 1 % KR, ksI = 0, vs0 = 0, vsI = LA % VR;
    for (int tt = 0; tt < NT; ++tt) {
        f32x16 pN0, pN1;
        u32x4 w[4];
        {
            const ldsp kimg_ = F.lds + ks1 * KSTAGE + (KSLOTS == 2 ? slot * KIMG : 0);
#define ATT_KF(j) lds_ld128(kimg_ + kro[(j) >> 1] + ((j) & 1) * 4096)
            bf16x8 kf[8];
            kf[0] = ATT_KF(0); kf[1] = ATT_KF(1); kf[2] = ATT_KF(2);
            if (PM < 5 && tt + LA < NT) ATT_DMA(tt + LA, ksI, vsI);
            asm volatile("" : "+v"(pC0), "+v"(pC1));
            __builtin_amdgcn_sched_barrier(0);
            float ps = 0.f;
#pragma unroll
            for (int j = 0; j < 8; ++j) {
                if (j + 3 < 8) kf[j + 3] = ATT_KF(j + 3);
                if (j & 1) pN1 = MFMA32(kf[j], qv[j >> 1], j < 2 ? negm : pN1); else pN0 = MFMA32(kf[j], qv[j >> 1], j < 2 ? negm : pN0);
                if (PM < 4) { ps += (pC0[2 * j] + pC0[2 * j + 1]) + (pC1[2 * j] + pC1[2 * j + 1]);
                w[j >> 2][j & 3] = pk2(pC0[2 * j], pC0[2 * j + 1]); w[2 + (j >> 2)][j & 3] = pk2(pC1[2 * j], pC1[2 * j + 1]); }
                else if (j == 0) { w[0] = __builtin_bit_cast(u32x4, (f32x4){pC0[0], pC0[1], pC0[2], pC0[3]}); w[1] = __builtin_bit_cast(u32x4, (f32x4){pC0[4], pC0[5], pC0[6], pC0[7]}); w[2] = __builtin_bit_cast(u32x4, (f32x4){pC1[0], pC1[1], pC1[2], pC1[3]}); w[3] = __builtin_bit_cast(u32x4, (f32x4){pC1[4], pC1[5], pC1[6], pC1[7]}); }
            }
#pragma unroll
            for (int j = 0; j < 8; ++j) { __builtin_amdgcn_sched_group_barrier(0x008, 1, 0); __builtin_amdgcn_sched_group_barrier(0x100, 1, 0); if (PM < 4) __builtin_amdgcn_sched_group_barrier(0x002, 6, 0); }
            asm volatile("" : "+v"(ps), "+v"(w[0]), "+v"(w[1]), "+v"(w[2]), "+v"(w[3]));
            __builtin_amdgcn_sched_barrier(0);
            lsum += ps;
#undef ATT_KF
        }
        const ldsp vb = F.lds + VBASE + vs0 * VSTAGE;
        bf16x8 vf[4][NDV];
#define ATT_VF(k4_, d_) (PM == 1 ? lds_ld128(vb + ((d_) * 32 + r32) * 128 + (((2 * (k4_) + h) ^ ((r32 >> 1) & 7)) << 4)) : cat8(lds_tr(vb + vro[d_] + (k4_) * 16 * VROW), lds_tr(vb + vro[d_] + (k4_) * 16 * VROW + 8 * VROW)))
#pragma unroll
        for (int k4 = 0; k4 < VD; ++k4)
#pragma unroll
            for (int d = 0; d < NDV; ++d) vf[k4][d] = ATT_VF(k4, d);
        bf16x8 pk[4];
        pk[0] = __builtin_bit_cast(bf16x8, w[0]); pk[1] = __builtin_bit_cast(bf16x8, w[1]); pk[2] = __builtin_bit_cast(bf16x8, w[2]); pk[3] = __builtin_bit_cast(bf16x8, w[3]);
        float fsc = 1.f; bool resc = false;
        if (PM < 4 && tt + 1 < NT) {
            if (WIN && maskwin && tt + 1 >= s0.nt) {
                const int kb = kpos1 + (tt + 1 - s0.nt) * 64, qlo = qpos0 + qb * 32;
                if (qlo + 31 - kb > 128 || kb + 63 - qlo > 128) {
                    const int base = kb - qpos + 128 + 4 * h;
#pragma unroll
                    for (int i = 0; i < 16; ++i) { const int ci = (i & 3) + 8 * (i >> 2);
                        if ((unsigned)(base + ci) > 256u) pN0[i] = -INFINITY;
                        if ((unsigned)(base + ci + 32) > 256u) pN1[i] = -INFINITY; }
                }
            }
            float rm = fmaxf(pN0[0], pN1[0]), rm1, rm2, rm3;
            asm volatile("v_max_f32 %0, %1, %2" : "=v"(rm1) : "v"(pN0[1]), "v"(pN1[1]));
            asm volatile("v_max_f32 %0, %1, %2" : "=v"(rm2) : "v"(pN0[2]), "v"(pN1[2]));
            asm volatile("v_max_f32 %0, %1, %2" : "=v"(rm3) : "v"(pN0[3]), "v"(pN1[3]));
#pragma unroll
            for (int i = 4; i < 16; i += 4) {
                asm volatile("v_max3_f32 %0, %0, %1, %2" : "+v"(rm) : "v"(pN0[i]), "v"(pN1[i])); asm volatile("v_max3_f32 %0, %0, %1, %2" : "+v"(rm1) : "v"(pN0[i + 1]), "v"(pN1[i + 1]));
                asm volatile("v_max3_f32 %0, %0, %1, %2" : "+v"(rm2) : "v"(pN0[i + 2]), "v"(pN1[i + 2])); asm volatile("v_max3_f32 %0, %0, %1, %2" : "+v"(rm3) : "v"(pN0[i + 3]), "v"(pN1[i + 3])); }
            asm volatile("v_max_f32 %0, %0, %1" : "+v"(rm2) : "v"(rm3));
            asm volatile("v_max3_f32 %0, %0, %1, %2" : "+v"(rm) : "v"(rm1), "v"(rm2));
            { auto rr = __builtin_amdgcn_permlane32_swap(__float_as_uint(rm), __float_as_uint(rm), false, false); rm = fmaxf(__uint_as_float(rr[0]), __uint_as_float(rr[1])); }
            const float delta = rm > ATT_THR ? rm : 0.f;
            if (__any(delta != 0.f)) {
                resc = true; m += delta; fsc = __builtin_amdgcn_exp2f(-delta);
#pragma unroll
                for (int i = 0; i < 16; ++i) { pN0[i] -= delta; pN1[i] -= delta; negm[i] = -m; }
            }
        }
        {
            asm volatile("" : "+v"(pN0), "+v"(pN1));
            __builtin_amdgcn_sched_barrier(0);
            constexpr int EPG = 32 / (NDV * 4);
#pragma unroll
            for (int k4 = 0; k4 < 4; ++k4) {
#pragma unroll
                for (int d = 0; d < NDV; ++d) {
                    if (k4 + VD < 4) vf[k4 + VD][d] = ATT_VF(k4 + VD, d);
                    O[d] = MFMA32(vf[k4][d], pk[k4], O[d]);
#pragma unroll
                    for (int e = 0; e < EPG; ++e) { const int idx = (k4 * NDV + d) * EPG + e;
                        if (PM >= 4) continue; if (idx < 16) pN0[idx] = __builtin_amdgcn_exp2f(pN0[idx]); else pN1[idx - 16] = __builtin_amdgcn_exp2f(pN1[idx - 16]); }
                }
            }
#pragma unroll
            for (int g = 0; g < NDV * 4; ++g) { __builtin_amdgcn_sched_group_barrier(0x008, 1, 0); if (g < NDV * (4 - VD)) __builtin_amdgcn_sched_group_barrier(0x100, PM == 1 ? 1 : 2, 0); if (PM < 4) __builtin_amdgcn_sched_group_barrier(0x400, EPG, 0); }
            asm volatile("" : "+v"(pN0), "+v"(pN1));
            __builtin_amdgcn_sched_barrier(0);
        }
        if (resc) {
            lsum *= fsc;
#pragma unroll
            for (int d = 0; d < NDV; ++d)
#pragma unroll
                for (int i = 0; i < 16; ++i) O[d][i] *= fsc;
        }
        pC0 = pN0; pC1 = pN1;
        ks1 = ks1 == KR - 1 ? 0 : ks1 + 1; ksI = ksI == KR - 1 ? 0 : ksI + 1; vs0 = vs0 == VR - 1 ? 0 : vs0 + 1; vsI = vsI == VR - 1 ? 0 : vsI + 1;
        if (PM >= 5) ATT_VMWAIT(0); else if (LA == 4 && tt + 4 < NT) ATT_VMWAIT(2 * OPS); else if (tt + 3 < NT) ATT_VMWAIT(OPS); else ATT_VMWAIT(0);
        if (PM != 6) bar_lds();
    }
#undef ATT_DMA
#undef ATT_VMWAIT
#undef ATT_QK
#undef ATT_VF
    if (QPRE && more) { const bf16_t* qn = (const bf16_t*)(F.ws + qnext) + (size_t)(qb * 32 + r32) * N_O + slot * 64 + 8 * h;
#pragma unroll
        for (int d0 = 0; d0 < 4; ++d0) qpre[d0] = *(const u32x4*)(qn + 16 * d0); }
    attn_epilogue<DV, WIN>(F, O, lsum, m, sink_l2, E);
}
template <int DV, bool WIN>
DI void attn_epilogue(Frame& F, f32x16 (&O)[DV / 32], float lsum, float m, float sink_l2, const AttnEpi E) {
    constexpr int NDV = DV / 32;
    int lane; asm volatile("v_mbcnt_lo_u32_b32 %0, -1, 0\n\tv_mbcnt_hi_u32_b32 %0, -1, %0" : "=v"(lane));
    const int wave = F.wave, tid = wave * 64 + lane, slot = wave & 1, qb = wave >> 1, h = lane >> 5, r32 = lane & 31;
    { auto rr = __builtin_amdgcn_permlane32_swap(__float_as_uint(lsum), __float_as_uint(lsum), false, false); lsum = __uint_as_float(rr[0]) + __uint_as_float(rr[1]); }
    if (WIN) lsum += __builtin_amdgcn_exp2f(sink_l2 - m);
    const float inv = 1.f / lsum;
    u32x4 zpre[4];
#pragma unroll
    for (int k = 0; k < 4; ++k) { const int it = tid + 512 * k, q = it >> 4, cc = it & 15; zpre[k] = *(const u32x4*)((const bf16_t*)(F.ws + E.z) + (size_t)q * N_O + cc * 8); }
    LAS float* Y = (LAS float*)F.lds;
    if (!WIN) {
        LAS float* X = (LAS float*)(F.lds + 67584) + qb * 4096;
        if (slot == 1) {
            const float sc = inv * E.lam;
#pragma unroll
            for (int d = 0; d < NDV; ++d)
#pragma unroll
                for (int i = 0; i < 16; ++i) X[(d * 32 + crow(i, h)) * 32 + r32] = O[d][i] * sc;
        }
        bar_lds();
        if (slot == 0) {
            float ss = 0.f;
#pragma unroll
            for (int d = 0; d < NDV; ++d)
#pragma unroll
                for (int i = 0; i < 16; ++i) { const float v = O[d][i] * inv - X[(d * 32 + crow(i, h)) * 32 + r32]; O[d][i] = v; ss += v * v; }
            { auto rr = __builtin_amdgcn_permlane32_swap(__float_as_uint(ss), __float_as_uint(ss), false, false); ss = __uint_as_float(rr[0]) + __uint_as_float(rr[1]); }
            const float rstd = rsqrtf(ss * (1.f / 128.f) + EPS) * E.oml;
#pragma unroll
            for (int d = 0; d < NDV; ++d)
#pragma unroll
                for (int q4 = 0; q4 < 4; ++q4)
                    *(LAS f32x4*)(Y + (qb * 32 + r32) * 132 + d * 32 + 8 * q4 + 4 * h) = (f32x4){O[d][4 * q4] * rstd, O[d][4 * q4 + 1] * rstd, O[d][4 * q4 + 2] * rstd, O[d][4 * q4 + 3] * rstd};
        }
        bar_lds();
    } else {
#pragma unroll
        for (int d = 0; d < NDV; ++d)
#pragma unroll
            for (int q4 = 0; q4 < 4; ++q4)
                *(LAS f32x4*)(Y + (qb * 32 + r32) * 132 + slot * 64 + d * 32 + 8 * q4 + 4 * h) = (f32x4){O[d][4 * q4] * inv, O[d][4 * q4 + 1] * inv, O[d][4 * q4 + 2] * inv, O[d][4 * q4 + 3] * inv};
        bar_lds();
    }
#pragma unroll
    for (int k = 0; k < 4; ++k) {
        const int it = tid + 512 * k, q = it >> 4, cc = it & 15;
        const f32x4 y0 = *(const LAS f32x4*)(Y + q * 132 + cc * 8), y1 = *(const LAS f32x4*)(Y + q * 132 + cc * 8 + 4);
        f32x4 g0 = {1.f, 1.f, 1.f, 1.f}, g1 = g0;
        if (!WIN) { g0 = *(const f32x4*)(F.p.in[I_OSUBG] + cc * 8); g1 = *(const f32x4*)(F.p.in[I_OSUBG] + cc * 8 + 4); }
        const u32x4 z = zpre[k];
        u32x4 o; o.x = pk2(y0.x * g0.x * silu_f(lo_f(z.x)), y0.y * g0.y * silu_f(hi_f(z.x))); o.y = pk2(y0.z * g0.z * silu_f(lo_f(z.y)), y0.w * g0.w * silu_f(hi_f(z.y)));
        o.z = pk2(y1.x * g1.x * silu_f(lo_f(z.z)), y1.y * g1.y * silu_f(hi_f(z.z))); o.w = pk2(y1.z * g1.z * silu_f(lo_f(z.w)), y1.w * g1.w * silu_f(hi_f(z.w)));
        *(u32x4*)((bf16_t*)(F.ws + E.aout) + (size_t)q * 2048 + cc * 8) = o;
    }
    bar_lds();
}

template <int PM = 0, int ONLY = 0>
DI void phase_attn(Frame& F, int grp) {
    const float lam = ((const float*)(F.ws + WS_LAM))[0], oml = ((const float*)(F.ws + WS_LAM))[1];
    const unsigned lat0 = grp == 0 ? R_CTX : 0;
    constexpr unsigned UB = (unsigned)WS_U, AB = (unsigned)WS_AOUT;
    const int NU = 1024 + (grp == 0 ? 256 : 0);
    u32x4 qpre[4];
    const size_t qlane = (size_t)((F.wave >> 1) * 32 + (F.lane & 31)) * N_O + (F.wave & 1) * 64 + 8 * (F.lane >> 5);
    if (ONLY == 0 || ONLY == 1) {
    auto qoff_c = [&](int u) { if (u < 1024) { const int x = u & 7, qb = (u >> 3) & 31, bh = (u >> 8) * 8 + x, bl = bh >> 3, hh = bh & 7; return UB + ((lat0 + bl * 4096 + qb * 128) * N_O + hh * 128) * 2; }
                               const int c = u - 1024, b = c >> 4, hh = (c >> 1) & 7, qb = c & 1; return UB + ((unsigned)(b * 256 + qb * 128) * N_O + hh * 128) * 2; };
    if (F.bid < NU) { const bf16_t* qn = (const bf16_t*)(F.ws + qoff_c(F.bid)) + qlane;
#pragma unroll
        for (int d0 = 0; d0 < 4; ++d0) qpre[d0] = *(const u32x4*)(qn + 16 * d0); }
    for (int u = F.bid; u < NU; u += F.G) {
        AttnSeg s0, s1; AttnEpi E; unsigned q0; int rot;
        if (u < 1024) {
            const int x = u & 7, qb = (u >> 3) & 31, bh = (u >> 8) * 8 + x, bl = bh >> 3, hh = bh & 7, b = grp * 4 + bl;
            const unsigned ls = lat0 + bl * 4096; q0 = qb * 128;
            s0 = AttnSeg{(unsigned)WS_CK + (unsigned)(b * 8 + hh) * 512 * 128 * 2, (unsigned)WS_CV + (unsigned)(b * 8 + hh) * 512 * 128 * 2, 128, 128, 8};
            s1 = AttnSeg{UB + (ls * N_O + 1024 + hh * 128) * 2, UB + (ls * N_O + 2048 + hh * 128) * 2, N_O, N_O, 64};
            E = AttnEpi{AB + ((ls + q0) * 2048 + hh * 128) * 2, UB + ((ls + q0) * N_O + 3072 + hh * 128) * 2, lam, oml};
            rot = ATT_ROT(qb);
        } else {
            const int c = u - 1024, b = c >> 4, hh = (c >> 1) & 7, qb = c & 1; const unsigned ls = b * 256; q0 = qb * 128;
            s0 = AttnSeg{UB, UB, N_O, N_O, 0};
            s1 = AttnSeg{UB + (ls * N_O + 1024 + hh * 128) * 2, UB + (ls * N_O + 2048 + hh * 128) * 2, N_O, N_O, 4};
            E = AttnEpi{AB + ((ls + q0) * 2048 + hh * 128) * 2, UB + ((ls + q0) * N_O + 3072 + hh * 128) * 2, lam, oml};
            rot = 0;
        }
        const bool more = u + F.G < NU;
        attn_unit<128, 2, false, PM, true>(F, qoff_c(u), s0, s1, (int)q0, 0, false, 0.f, E, rot, qpre, more ? qoff_c(u + F.G) : 0u, more);
    } }
    if (ONLY == 0 || ONLY == 2) {
    auto qoff_w = [&](int u) { if (u < 1024) { const int x = u & 7, qb = (u >> 3) & 31, combo = (u >> 8) * 8 + x, bl = combo >> 3, kv = (combo >> 1) & 3, gp = combo & 1; return UB + ((lat0 + bl * 4096 + qb * 128) * N_O + 4096 + (kv * 4 + 2 * gp) * 64) * 2; }
                               const int c = u - 1024, b = c >> 4, kv = (c >> 2) & 3, gp = (c >> 1) & 1, qb = c & 1; return UB + ((unsigned)(b * 256 + qb * 128) * N_O + 4096 + (kv * 4 + 2 * gp) * 64) * 2; };
    if (F.bid < NU) { const bf16_t* qn = (const bf16_t*)(F.ws + qoff_w(F.bid)) + qlane;
#pragma unroll
        for (int d0 = 0; d0 < 4; ++d0) qpre[d0] = *(const u32x4*)(qn + 16 * d0); }
    for (int u = F.bid; u < NU; u += F.G) {
        AttnSeg s0, s1; AttnEpi E; int q0, ks, hd0; bool mw;
        if (u < 1024) {
            const int x = u & 7, qb = (u >> 3) & 31, combo = (u >> 8) * 8 + x, bl = combo >> 3, kv = (combo >> 1) & 3, gp = combo & 1, b = grp * 4 + bl;
            const unsigned ls = lat0 + bl * 4096; q0 = qb * 128; hd0 = kv * 4 + 2 * gp;
            ks = max(0, q0 - 128); const int ke = min(4096, q0 + 256);
            s0 = AttnSeg{(unsigned)WS_WK + (unsigned)(b * 4 + kv) * 512 * 64 * 2, (unsigned)WS_WV + (unsigned)(b * 4 + kv) * 512 * 64 * 2, 64, 64, 8};
            s1 = AttnSeg{UB + ((ls + ks) * N_O + 5120 + kv * 64) * 2, UB + ((ls + ks) * N_O + 5376 + kv * 64) * 2, N_O, N_O, (ke - ks) >> 6};
            E = AttnEpi{AB + ((ls + q0) * 2048 + 1024 + hd0 * 64) * 2, UB + ((ls + q0) * N_O + 5632 + hd0 * 64) * 2, 0.f, 0.f};
            mw = true;
        } else {
            const int c = u - 1024, b = c >> 4, kv = (c >> 2) & 3, gp = (c >> 1) & 1, qb = c & 1; const unsigned ls = b * 256; q0 = qb * 128; hd0 = kv * 4 + 2 * gp; ks = 0;
            s0 = AttnSeg{UB, UB, N_O, N_O, 0};
            s1 = AttnSeg{UB + (ls * N_O + 5120 + kv * 64) * 2, UB + (ls * N_O + 5376 + kv * 64) * 2, N_O, N_O, 4};
            E = AttnEpi{AB + ((ls + q0) * 2048 + 1024 + hd0 * 64) * 2, UB + ((ls + q0) * N_O + 5632 + hd0 * 64) * 2, 0.f, 0.f};
            mw = false;
        }
        const float sk = F.p.in[I_OSINK][hd0 + (F.wave & 1)] * LOG2E;
        const bool more = u + F.G < NU;
        attn_unit<64, 1, true, PM, true>(F, qoff_w(u), s0, s1, q0, ks, mw, sk, E, 0, qpre, more ? qoff_w(u + F.G) : 0u, more);
    } }
}

DI void phase_final(Frame& F, int grp) {
    const int row0 = GRP_ROW0[grp], rows = GRP_ROWS[grp];
    const int gw = F.bid * NWAVES + F.wave, NGW = F.G * NWAVES;
    const float* ng = F.p.in[I_FNORMG];
    const bf16_t* x2b = (const bf16_t*)(F.ws + WS_REGA);
    for (int rl = gw; rl < rows; rl += 2 * NGW) {
        f32x4 v[2][4]; float s[2];
#pragma unroll
        for (int q = 0; q < 2; ++q) { const u32x2* xr = (const u32x2*)(x2b + (size_t)min(rl + q * NGW, rows - 1) * DM) + F.lane;
#pragma unroll
            for (int j = 0; j < 4; ++j) { const u32x2 w = xr[64 * j]; v[q][j] = (f32x4){lo_f(w.x), hi_f(w.x), lo_f(w.y), hi_f(w.y)}; } }
#pragma unroll
        for (int q = 0; q < 2; ++q) { float t = 0.f;
#pragma unroll
            for (int j = 0; j < 4; ++j) t += (v[q][j].x * v[q][j].x + v[q][j].y * v[q][j].y) + (v[q][j].z * v[q][j].z + v[q][j].w * v[q][j].w);
            s[q] = t; }
#pragma unroll
        for (int o = 1; o < 64; o <<= 1) { s[0] += shfl_idx(s[0], F.lane ^ o); s[1] += shfl_idx(s[1], F.lane ^ o); }
#pragma unroll
        for (int q = 0; q < 2; ++q) { if (rl + q * NGW >= rows) continue;
            const float rstd = rsqrtf(s[q] * (1.f / DM) + EPS);
            f32x4* xr = (f32x4*)(F.out + OUT_X + (size_t)(row0 + rl + q * NGW) * DM) + F.lane;
#pragma unroll
            for (int j = 0; j < 4; ++j) { const f32x4 g = *((const f32x4*)ng + F.lane + 64 * j); xr[64 * j] = v[q][j] * rstd * g; } }
    }
}
#define RLX_AGENT __ATOMIC_RELAXED, __HIP_MEMORY_SCOPE_AGENT
#define XB_TMO      128
#define XB_XCNT(j)  (256  + 64 * (j))
#define XB_XSUB(j)  (1280 + 64 * (j))
#define XB_XGEN(j)  (2304 + 64 * (j))
#define XB_TOP      3328
#define XB_TOPGEN   3392
#define XCD_BAR_WORDS 3456
#define XB_SPIN_CAP (1u << 18)

__device__ __forceinline__ unsigned xb_ld(unsigned* p)              { return __hip_atomic_load(p, __ATOMIC_RELAXED, __HIP_MEMORY_SCOPE_AGENT); }
__device__ __forceinline__ unsigned xb_add(unsigned* p, unsigned v) { return __hip_atomic_fetch_add(p, v, __ATOMIC_RELAXED, __HIP_MEMORY_SCOPE_AGENT); }
__device__ __forceinline__ unsigned xb_xcc_id() { return (unsigned)__builtin_amdgcn_s_getreg((3 << 11) | 20) & 0xFu; }
#define XB_SPIN(cond, bar) do { unsigned _sp = 0; while (cond) { __builtin_amdgcn_s_sleep(1); \
    if ((++_sp & 255u) == 0u) { if (xb_ld(&(bar)[XB_TMO])) break; if (_sp > XB_SPIN_CAP) { atomicAdd(&(bar)[XB_TMO], 1u); break; } } } } while (0)

struct XcdBarrier {
    unsigned* bar; unsigned x;
    volatile LAS unsigned* st;
};

__device__ __forceinline__ XcdBarrier xcd_barrier_post(unsigned* bar, volatile LAS unsigned* st) {
    XcdBarrier b; b.bar = bar; b.x = xb_xcc_id(); b.st = st;
    if (threadIdx.x == 0) (void)xb_add(&bar[XB_XCNT(b.x)], 1u);
    return b;
}
__device__ __forceinline__ void xcd_barrier_complete(unsigned* bar, unsigned x, unsigned& nloc, unsigned& nx) {
    const unsigned G = gridDim.x * gridDim.y * gridDim.z;
    unsigned sum, cnt, mine, sp = 0u;
    for (;;) {
        sum = 0u; cnt = 0u; mine = 0u;
#pragma unroll
        for (unsigned j = 0; j < 16; ++j) { const unsigned c = xb_ld(&bar[XB_XCNT(j)]); sum += c; cnt += (c > 0u) ? 1u : 0u; mine = (j == x) ? c : mine; }
        if (sum == G) break;
        __builtin_amdgcn_s_sleep(1);
        if ((++sp & 255u) == 0u) { if (xb_ld(&bar[XB_TMO])) break; if (sp > XB_SPIN_CAP) { atomicAdd(&bar[XB_TMO], 1u); break; } }
    }
    nloc = mine > 0u ? mine : 1u; nx = cnt > 0u ? cnt : 1u;
}

__device__ __forceinline__ void xcd_barrier(const XcdBarrier& b) {
    asm volatile("s_waitcnt vmcnt(0)" ::: "memory");
    __syncthreads();
    if (threadIdx.x == 0) {
        unsigned* bar = b.bar;
        __builtin_amdgcn_s_waitcnt(0);
        unsigned nloc = b.st[0], nx = b.st[1];
        if (nloc == 0u) { xcd_barrier_complete(bar, b.x, nloc, nx); b.st[0] = nloc; b.st[1] = nx; }
        const unsigned old = xb_add(&bar[XB_XSUB(b.x)], 1u);
        const unsigned gen = old / nloc;
        if (old + 1u == (gen + 1u) * nloc) {
            __builtin_amdgcn_fence(__ATOMIC_RELEASE, "agent");
            asm volatile("s_waitcnt vmcnt(0)" ::: "memory");
            const unsigned og = xb_add(&bar[XB_TOP], 1u);
            const unsigned tg = og / nx;
            if (og + 1u == (tg + 1u) * nx) xb_add(&bar[XB_TOPGEN], 1u);
            else XB_SPIN(xb_ld(&bar[XB_TOPGEN]) == tg, bar);
            __builtin_amdgcn_fence(__ATOMIC_ACQUIRE, "agent");
            xb_add(&bar[XB_XGEN(b.x)], 1u);
            asm volatile("s_waitcnt vmcnt(0)" ::: "memory");
        } else {
            XB_SPIN(xb_ld(&bar[XB_XGEN(b.x)]) == gen, bar);
            __builtin_amdgcn_fence(__ATOMIC_ACQUIRE, "agent");
            asm volatile("s_waitcnt vmcnt(0)" ::: "memory");
        }
    }
    __syncthreads();
}

constexpr int NPHG = 13;
constexpr int NPH = 1 + 2 * NPHG;

DI Frame relaunder(const Frame& F0) {
    int ln; asm volatile("v_mbcnt_lo_u32_b32 %0, -1, 0\n\tv_mbcnt_hi_u32_b32 %0, -1, %0" : "=v"(ln));
    int b = F0.bid, G = F0.G, wv = F0.wave; size_t z0 = 0, z1 = 0; asm volatile("" : "+s"(b), "+s"(G), "+s"(z0), "+s"(z1), "+s"(wv));
    float* o = F0.p.out + z0; unsigned char* w = F0.p.ws + z1;
    return Frame{F0.lds, wv * 64 + ln, ln, wv, G, b, F0.p, o, w, F0.probe};
}
DI void run_phase(const Frame& F0, int ph) {
#ifndef PHMASK
#define PHMASK 0xFFFF
#endif
#define PHON(k) ((PHMASK >> (k)) & 1)
    if (ph == 0) { if (PHON(14)) { Frame F = relaunder(F0); phase_p0(F); } return; }
    const int grp = (ph - 1) / NPHG, k = (ph - 1) % NPHG;
    const int row0 = GRP_ROW0[grp], rows = GRP_ROWS[grp];
        switch (k) {
    case 0: if (PHON(0)) { Frame F = relaunder(F0); phase_modnorm(F, grp, 0); } break;
    case 1: if (PHON(1)) { Frame F = relaunder(F0); { pg8::Gemm g{(const bf16_t*)(F.ws + WS_REGA), (const bf16_t*)(F.ws + WS_WT_IN_E), rows, N_E, 1024, 1024, 0};
              pg8::StaticOrder S; S.init(rows, N_E, F.G, F.bid);
              epi::EpiE0 E{(bf16_t*)(F.out + OUT_X + (size_t)row0 * DM), (bf16_t*)(F.ws + WS_XBCRAW), (bf16_t*)(F.ws + WS_XB), (float*)(F.ws + WS_DTRAW)};
              pg8::gemm_phase<epi::EpiE0, pg8::StaticOrder, true, true>(F.lds, g, S, E, F.tid); } } break;
    case 2: if (PHON(2)) { Frame F = relaunder(F0); phase_conv(F, grp); } break;
    case 3: if (PHON(3)) { Frame F = relaunder(F0); phase_states(F, grp); } break;
    case 4: if (PHON(4)) { Frame F = relaunder(F0); phase_scan(F, grp); } break;
    case 5: if (PHON(5)) { Frame F = relaunder(F0); phase_y(F, grp); } break;
    case 6: if (PHON(6)) { Frame F = relaunder(F0); {
              pg8::Gemm g{(const bf16_t*)(F.ws + WS_POOLED), (const bf16_t*)(F.ws + WS_WT_POOL), rows, 1024, 256, 1024, 256};
              pg8::StaticOrder S; S.init(rows, 1024, F.G, F.bid);
              epi::EpiPool E{(bf16_t*)(F.ws + WS_AOUT), (const bf16_t*)(F.out + OUT_X + (size_t)row0 * DM), (const float*)(F.ws + WS_SSY)};
              pg8::gemm_phase<epi::EpiPool, pg8::StaticOrder, true, true>(F.lds, g, S, E, F.tid); } } break;
    case 7: if (PHON(7)) { Frame F = relaunder(F0); { pg8::Gemm g{(const bf16_t*)(F.ws + WS_AOUT), (const bf16_t*)(F.ws + WS_WT_OUT_E), rows, 1024, 2048, 2048, 0};
              pg8::StaticOrder S; S.init(rows, 1024, F.G, F.bid);
              epi::EpiRes<true> E{F.p.in[I_XP], F.p.in[I_XS], nullptr, (const float*)(F.ws + WS_MOD), row0, (const float*)(F.ws + WS_SSY), (bf16_t*)(F.ws + WS_X1B), nullptr};
              pg8::gemm_phase<epi::EpiRes<true>, pg8::StaticOrder, true, true>(F.lds, g, S, E, F.tid); } } break;
    case 8: if (PHON(8)) { Frame F = relaunder(F0); phase_modnorm(F, grp, 1); } break;
    case 9: if (PHON(9)) { Frame F = relaunder(F0); { pg8::Gemm g{(const bf16_t*)(F.ws + WS_REGA), (const bf16_t*)(F.ws + WS_WT_IN_O), rows, N_O, 1024, 1024, 0};
              pg8::StaticOrder S; S.init(rows, N_O, F.G, F.bid);
              epi::EpiO E{(bf16_t*)(F.ws + WS_U), (const float*)(F.ws + WS_ROPE), row0};
              pg8::gemm_phase<epi::EpiO, pg8::StaticOrder, true, true>(F.lds, g, S, E, F.tid); } } break;
    case 10: if (PHON(10)) { Frame F = relaunder(F0); if (grp == 0) phase_cachecopy(F); phase_attn(F, grp); } break;
    case 11: if (PHON(11)) { Frame F = relaunder(F0); { pg8::Gemm g{(const bf16_t*)(F.ws + WS_AOUT), (const bf16_t*)(F.ws + WS_WT_OUT_O), rows, 1024, 2048, 2048, 0};
               pg8::StaticOrder S; S.init(rows, 1024, F.G, F.bid);
               epi::EpiRes<false> E{nullptr, nullptr, F.out + OUT_X, (const float*)(F.ws + WS_MOD) + 9 * 3072, row0, nullptr, (bf16_t*)(F.ws + WS_X1B), (bf16_t*)(F.ws + WS_REGA)};
               pg8::gemm_phase<epi::EpiRes<false>, pg8::StaticOrder, true, true>(F.lds, g, S, E, F.tid); } } break;
    default: if (PHON(12)) { Frame F = relaunder(F0); phase_final(F, grp); } break;
    }
}

__global__ void __launch_bounds__(NTHREADS, 2) mega_fwd(Params p) {
    extern __shared__ __attribute__((aligned(16))) unsigned char lds_raw[];
    cg::grid_group grid = cg::this_grid();
    const int wave_ = __builtin_amdgcn_readfirstlane((int)threadIdx.x >> 6);
    volatile LAS unsigned* bst = (volatile LAS unsigned*)((ldsp)lds_raw + LDS_BYTES - 256);
    if (threadIdx.x < 2) bst[threadIdx.x] = 0u;
    __syncthreads();
    XcdBarrier bar = xcd_barrier_post((unsigned*)(p.ws + WS_BAR), bst);
    for (int ph = p.ph_lo; ph < p.ph_hi; ++ph) {
        int lane_; asm volatile("v_mbcnt_lo_u32_b32 %0, -1, 0\n\tv_mbcnt_hi_u32_b32 %0, -1, %0" : "=v"(lane_));
        Frame F{(ldsp)lds_raw, wave_ * 64 + lane_, lane_, wave_, (int)gridDim.x, (int)blockIdx.x, p, p.out, p.ws, 0};
#ifdef ATT_PROBE
#ifndef ATT_PM
#define ATT_PM 0
#endif
        if (ph > 0 && (ph - 1) % NPHG == 10) { Frame Fp = relaunder(F); phase_attn<ATT_PM, ATT_PROBE>(Fp, (ph - 1) / NPHG); xcd_barrier(bar); }
#endif
#ifdef DUP_MASK
        if (ph > 0 && ((DUP_MASK >> ((ph - 1) % NPHG)) & 1)) { Frame Fp{F.lds, F.tid, F.lane, F.wave, F.G, F.bid, F.p, F.out, F.ws, 1}; run_phase(Fp, ph); xcd_barrier(bar); }
#endif
        run_phase(F, ph);
        if (ph + 1 < p.ph_hi) { if (ph == 0) grid.sync(); else xcd_barrier(bar); }
    }
}

#ifndef MK_MULTI
#define MK_MULTI 0
#endif
extern "C" void kernel_launch(void* const* d_in, const int* in_sizes, int n_in, void* d_out, int out_size, void* d_ws, size_t ws_size, hipStream_t stream) {
    static int grid = 0;
    if (grid == 0) {
        if (n_in != 28 || (size_t)out_size != OUT_END || ws_size < WS_END) { fprintf(stderr, "kernel_launch: unexpected sizes n_in %d out %d ws %zu\n", n_in, out_size, ws_size); grid = -1; return; }
        int dev = 0, cus = 0, per_cu = 0;
        hipGetDevice(&dev); hipDeviceGetAttribute(&cus, hipDeviceAttributeMultiprocessorCount, dev);
        if (hipFuncSetAttribute((const void*)mega_fwd, hipFuncAttributeMaxDynamicSharedMemorySize, LDS_BYTES) != hipSuccess) { fprintf(stderr, "kernel_launch: hipFuncSetAttribute failed\n"); grid = -1; return; }
        if (hipOccupancyMaxActiveBlocksPerMultiprocessor(&per_cu, (const void*)mega_fwd, NTHREADS, LDS_BYTES) != hipSuccess || per_cu < 1) { fprintf(stderr, "kernel_launch: occupancy query failed (%d)\n", per_cu); (void)hipGetLastError(); per_cu = 1; }
        grid = cus * (per_cu > 1 ? 1 : per_cu);
        if (grid > 256) grid = 256;
    }
    if (grid < 0) return;
    if (hipMemsetAsync((char*)d_ws + WS_BAR, 0, 16384, stream) != hipSuccess) { fprintf(stderr, "kernel_launch: memset failed\n"); return; }
    Params p{};
    for (int i = 0; i < 28; ++i) p.in[i] = (const float*)d_in[i];
    p.out = (float*)d_out; p.ws = (unsigned char*)d_ws;
#if MK_MULTI
    for (int ph = 0; ph < NPH; ++ph) { p.ph_lo = ph; p.ph_hi = ph + 1; hipLaunchKernelGGL(mega_fwd, dim3(grid), dim3(NTHREADS), LDS_BYTES, stream, p); }
#else
    p.ph_lo = 0; p.ph_hi = NPH;
    void* args[] = {&p};
    hipError_t e = hipLaunchCooperativeKernel((const void*)mega_fwd, dim3(grid), dim3(NTHREADS), args, LDS_BYTES, stream);
    if (e != hipSuccess) fprintf(stderr, "cooperative launch failed: %s (grid %d)\n", hipGetErrorString(e), grid);
#endif
}
```

```cpp
#include <hip/hip_runtime.h>
#include <hip/hip_cooperative_groups.h>
#include <cstdio>
#include <cstdint>
namespace cg = cooperative_groups;

#define DI __device__ __forceinline__
#define LAS __attribute__((address_space(3)))
typedef unsigned short bf16_t;
typedef short bf16x8 __attribute__((ext_vector_type(8)));
typedef short s16x4 __attribute__((ext_vector_type(4)));
typedef float f32x2 __attribute__((ext_vector_type(2)));
typedef float f32x4 __attribute__((ext_vector_type(4)));
typedef float f32x16 __attribute__((ext_vector_type(16)));
typedef unsigned u32x2 __attribute__((ext_vector_type(2)));
typedef unsigned u32x4 __attribute__((ext_vector_type(4)));
typedef __bf16 bf16x2_t __attribute__((ext_vector_type(2)));
typedef LAS unsigned char* ldsp;

constexpr int DM = 1024;
constexpr int R_CTX = 4096, R_ALL = 36864;
constexpr int GRP_ROW0[2] = {0, 20480};
constexpr int GRP_ROWS[2] = {20480, 16384};
constexpr int MAXROWS = 20480;
constexpr int N_E = 5376;
constexpr int N_O = 6656;
constexpr float EPS = 1e-6f;
constexpr float C2 = 0.125f * 1.4426950408889634f;
constexpr float LOG2E = 1.4426950408889634f;

constexpr size_t MiB = 1u << 20;
constexpr size_t WS_MOD = 0;
constexpr size_t WS_ROPE = 256 * 1024;
constexpr size_t WS_LAM = 300 * 1024;
constexpr size_t WS_BIAS1 = 320 * 1024;
constexpr size_t WS_SSY = 600 * 1024;
constexpr size_t WS_SS1 = 700 * 1024;
constexpr size_t WS_WT_IN_E = 1 * MiB;
constexpr size_t WS_WT_OUT_E = 12 * MiB;
constexpr size_t WS_WT_IN_O = 16 * MiB;
constexpr size_t WS_WT_OUT_O = 29 * MiB;
constexpr size_t WS_WT_POOL = 33 * MiB;
constexpr size_t WS_CK = 34 * MiB;
constexpr size_t WS_CV = 42 * MiB;
constexpr size_t WS_WK = 50 * MiB;
constexpr size_t WS_WV = 52 * MiB;
constexpr size_t WS_DTRAW = 54 * MiB;
constexpr size_t WS_DTV = 57 * MiB;
constexpr size_t WS_ACS = 60 * MiB;
constexpr size_t WS_DECAY = 63 * MiB;
constexpr size_t WS_REGA = 64 * MiB;
constexpr size_t WS_X1B = 64 * MiB + 40 * MiB;
constexpr size_t WS_AOUT = 144 * MiB;
constexpr size_t WS_U = 224 * MiB;
constexpr size_t WS_XBCRAW = WS_U;
constexpr size_t WS_XBC = WS_U + 80 * MiB;
constexpr size_t WS_XB = WS_U + 160 * MiB;
constexpr size_t WS_POOLED = WS_U + 200 * MiB;
constexpr size_t WS_BAR = 484 * MiB;
constexpr size_t WS_KC = 485 * MiB;
constexpr size_t WS_VC = 517 * MiB;
constexpr size_t WS_KD = 549 * MiB;
constexpr size_t WS_VD = 557 * MiB;
constexpr size_t WS_END = 565 * MiB;

constexpr size_t OUT_X = 0;
constexpr size_t OUT_SSD_F = (size_t)R_ALL * DM;
constexpr size_t OUT_SSD_B = OUT_SSD_F + 16 * 16 * 64 * 128;
constexpr size_t OUT_DIFF_K = OUT_SSD_B + 16 * 16 * 64 * 128;
constexpr size_t OUT_DIFF_V = OUT_DIFF_K + 16 * 8 * 256 * 128;
constexpr size_t OUT_WIN_K = OUT_DIFF_V + 16 * 8 * 256 * 128;
constexpr size_t OUT_WIN_V = OUT_WIN_K + 16 * 4 * 256 * 64;
constexpr size_t OUT_END = OUT_WIN_V + 16 * 4 * 256 * 64;

constexpr int NTHREADS = 512, NWAVES = 8;
constexpr int LDS_BYTES = 160 * 1024;

DI float bf2f(bf16_t v) { return __uint_as_float((unsigned)v << 16); }
DI unsigned pk2(float lo, float hi) { f32x2 v = {lo, hi}; bf16x2_t b = __builtin_convertvector(v, bf16x2_t); return __builtin_bit_cast(unsigned, b); }
DI bf16_t f2bf(float f) { return (bf16_t)(pk2(f, 0.f) & 0xffffu); }
DI float lo_f(unsigned w) { return __uint_as_float(w << 16); }
DI float hi_f(unsigned w) { return __uint_as_float(w & 0xffff0000u); }
DI float silu_f(float x) { return x * __builtin_amdgcn_rcpf(1.f + __expf(-x)); }
DI void bar_lds() { asm volatile("s_waitcnt lgkmcnt(0)" ::: "memory"); __builtin_amdgcn_s_barrier(); asm volatile("" ::: "memory"); }
DI float shfl_idx(float v, int srclane) { return __uint_as_float((unsigned)__builtin_amdgcn_ds_bpermute(srclane << 2, (int)__float_as_uint(v))); }
DI float wave_sum(float v, int lane) {
#pragma unroll
    for (int o = 1; o < 64; o <<= 1) v += shfl_idx(v, lane ^ o);
    return v;
}
DI bf16x8 lds_ld128(ldsp p) { return *(const LAS bf16x8*)p; }
DI void lds_st128(ldsp p, u32x4 v) { *(LAS u32x4*)p = v; }
typedef short v4i16_t __attribute__((ext_vector_type(4)));
DI s16x4 lds_tr(ldsp p) { return __builtin_bit_cast(s16x4, __builtin_amdgcn_ds_read_tr16_b64_v4i16((LAS v4i16_t*)p)); }
DI bf16x8 cat8(s16x4 lo, s16x4 hi) { return __builtin_shufflevector(lo, hi, 0, 1, 2, 3, 4, 5, 6, 7); }
DI int crow(int reg, int h) { return (reg & 3) + 8 * (reg >> 2) + 4 * h; }
DI bf16x8 pack8(const f32x16& x, int s) {
    u32x4 p; p.x = pk2(x[8 * s], x[8 * s + 1]); p.y = pk2(x[8 * s + 2], x[8 * s + 3]); p.z = pk2(x[8 * s + 4], x[8 * s + 5]); p.w = pk2(x[8 * s + 6], x[8 * s + 7]);
    return __builtin_bit_cast(bf16x8, p);
}
#define MFMA32(a, b, c) __builtin_amdgcn_mfma_f32_32x32x16_bf16((a), (b), (c), 0, 0, 0)

struct RowInfo { int ctx, b, t, T, g; };
DI RowInfo rowinfo(int row) {
    RowInfo r;
    if (row < R_CTX) { r.ctx = 1; r.b = row >> 8; r.t = row & 255; r.T = 256; r.g = 8; }
    else { const int q = row - R_CTX; r.ctx = 0; r.b = q >> 12; r.t = q & 4095; r.T = 4096; r.g = r.b; }
    return r;
}
namespace pg8 {
#define PG8_LAS __attribute__((address_space(3)))
constexpr int BM = 256, BK = 64, HALF = 128, HTB = HALF * BK * 2  , STAGE_BYTES = 8 * HTB, NXCD = 8, WGM = 8;

__host__ __device__ __forceinline__ int lds_byte(int r, int c) { const int st = (r >> 4) * 2 + (c >> 5), rr = r & 15, cc = c & 31, ob = rr * 64 + cc * 2; return st * 1024 + (ob ^ (((ob >> 9) & 1) << 5)); }
__host__ __device__ __forceinline__ void stage_rc(int b, int& R, int& C) { const int st = b / 1024, sb = b % 1024, swz = sb ^ (((sb >> 9) & 1) << 5); R = (st >> 1) * 16 + swz / 64; C = (st & 1) * 32 + (swz % 64) / 2; }
__host__ __device__ __forceinline__ int perm32(int rho) { const int n = rho >> 4, i = rho & 15; return 8 * (i >> 2) + 4 * n + (i & 3); }

struct Unit { int pm, pn; };
struct Gemm { const bf16_t* A; const bf16_t* Bt; int M, N, K, lda, a_pn_off; };

struct StaticOrder {
    int nM, nN, nwg, G, c;
    __host__ __device__ void init(int M, int N, int G_, int c_) { nM = M / BM; nN = N / BM; nwg = nM * nN; G = G_; c = c_; }
    __host__ __device__ bool next(int i, Unit& u) const {
        const long L = (long)i * G + c; if (L >= nwg) return false;
        int wgid = (int)L; { const int q = nwg / NXCD, r = nwg % NXCD, xcd = wgid % NXCD, off = wgid / NXCD; wgid = (xcd < r ? xcd * (q + 1) : r * (q + 1) + (xcd - r) * q) + off; }
        const int nig = WGM * nN, gid = wgid / nig, fm = gid * WGM, gsz = (nM - fm) < WGM ? (nM - fm) : WGM;
        u.pm = fm + ((wgid % nig) % gsz); u.pn = (wgid % nig) / gsz; return true;
    }
    __device__ __forceinline__ void a_ready(const Unit&) const {}
    __device__ __forceinline__ void done(const Unit&) const {}
};


template <class Epi, class Sched, bool ALIGN_EPI = false, bool SP2 = false>
__device__ __forceinline__ void gemm_phase(PG8_LAS unsigned char* lds, const Gemm g, const Sched& S, const Epi& E, const int tid) {
    const int wid = __builtin_amdgcn_readfirstlane(tid >> 6), lane = tid & 63, wr = wid >> 2, wc = wid & 3, fr = lane & 15, fq = lane >> 4;
    const int K = g.K, nt = K / BK;
    unsigned voffA[2], voffB[2];
#pragma unroll
    for (int i = 0; i < 2; ++i) { int R, C; stage_rc(tid * 16 + i * 8192, R, C); const int Rb = Epi::PERM ? ((R & ~31) + perm32(R & 31)) : R;
        voffA[i] = (unsigned)(R * g.lda + C) * 2u; voffB[i] = (unsigned)(Rb * K + C) * 2u; }
    const size_t kstep = (size_t)(BK * 2);
    const size_t hstepA = (size_t)HALF * g.lda * 2, hstepB = (size_t)HALF * K * 2;
    const size_t tstepA = 2 * hstepA, tstepB = 2 * hstepB, pnoff = (size_t)g.a_pn_off * 2;
    const unsigned ldsw = (unsigned)wid * 1024u;
    const int aoff = lds_byte(wr * 64 + fr, fq * 8), boff = lds_byte(wc * 32 + fr, fq * 8);
#define PG8_SA(b, h) (((b) * 2 + (h)) * HTB)
#define PG8_SB(b, h) ((4 + (b) * 2 + (h)) * HTB)
#define PG8_STAGE(bufoff, gbase, voff) do { _Pragma("unroll") for (int _i = 0; _i < 2; ++_i) \
        __builtin_amdgcn_global_load_lds((const unsigned*)((const char*)(gbase) + (voff)[_i]), (PG8_LAS unsigned*)(lds + (bufoff) + ldsw + _i * 8192), 16, 0, 0); } while (0)
#define PG8_LDA(dst, b, h) do { _Pragma("unroll") for (int m = 0; m < 4; ++m) _Pragma("unroll") for (int k = 0; k < 2; ++k) dst[m][k] = *(const PG8_LAS bf16x8*)(lds + PG8_SA(b, h) + aoff + m * 2048 + k * 1024); } while (0)
#define PG8_LDB(dst, b, h) do { _Pragma("unroll") for (int n = 0; n < 2; ++n) _Pragma("unroll") for (int k = 0; k < 2; ++k) dst[n][k] = *(const PG8_LAS bf16x8*)(lds + PG8_SB(b, h) + boff + n * 2048 + k * 1024); } while (0)
#define PG8_MMA(ai, bj, At, Bt) do { __builtin_amdgcn_s_setprio(1); _Pragma("unroll") for (int m = 0; m < 4; ++m) _Pragma("unroll") for (int n = 0; n < 2; ++n) _Pragma("unroll") for (int k = 0; k < 2; ++k) \
        acc[ai][bj][m][n] = __builtin_amdgcn_mfma_f32_16x16x32_bf16(Bt[n][k], At[m][k], acc[ai][bj][m][n], 0, 0, 0); __builtin_amdgcn_s_setprio(0); } while (0)
#define PG8_WAIT_V(n) asm volatile("s_waitcnt vmcnt(" #n ")" ::: "memory")
#define PG8_WAIT_L(n) asm volatile("s_waitcnt lgkmcnt(" #n ")" ::: "memory")
#define PG8_BAR __builtin_amdgcn_s_barrier()
#define PG8_SCHED __builtin_amdgcn_sched_barrier(0)
    Unit cur, nxt; int ui = 0;
    if (!S.next(0, cur)) return;
    f32x4 acc[2][2][4][2];
#pragma unroll
    for (int a = 0; a < 2; ++a)
#pragma unroll
        for (int b = 0; b < 2; ++b)
#pragma unroll
            for (int m = 0; m < 4; ++m)
#pragma unroll
                for (int n = 0; n < 2; ++n) acc[a][b][m][n] = (f32x4){0.f, 0.f, 0.f, 0.f};
    bf16x8 At[4][2], B0[2][2], B1[2][2];
    const char* cA = (const char*)g.A + (size_t)cur.pm * tstepA + (size_t)cur.pn * pnoff; const char* cB = (const char*)g.Bt + (size_t)cur.pn * tstepB;
    S.a_ready(cur);
    if constexpr (SP2) {
        PG8_STAGE(PG8_SB(0, 0), cB, voffB); PG8_STAGE(PG8_SB(0, 1), cB + hstepB, voffB); PG8_STAGE(PG8_SA(0, 0), cA, voffA); PG8_STAGE(PG8_SA(0, 1), cA + hstepA, voffA);
        if (wr == 1) PG8_BAR;
        PG8_WAIT_V(2); PG8_BAR;
        PG8_STAGE(PG8_SB(1, 0), cB + kstep, voffB); PG8_STAGE(PG8_SA(1, 0), cA + kstep, voffA); PG8_STAGE(PG8_SB(1, 1), cB + hstepB + kstep, voffB);
        PG8_WAIT_V(6); PG8_BAR;
    } else {
        PG8_STAGE(PG8_SB(0, 0), cB, voffB); PG8_STAGE(PG8_SA(0, 0), cA, voffA); PG8_STAGE(PG8_SB(0, 1), cB + hstepB, voffB); PG8_STAGE(PG8_SA(0, 1), cA + hstepA, voffA);
        if (wr == 1) PG8_BAR;
        PG8_WAIT_V(4); PG8_BAR;
        PG8_STAGE(PG8_SB(1, 0), cB + kstep, voffB); PG8_STAGE(PG8_SA(1, 0), cA + kstep, voffA); PG8_STAGE(PG8_SB(1, 1), cB + hstepB + kstep, voffB);
        PG8_WAIT_V(6); PG8_BAR;
    }
    for (;;) {
        const bool has_next = S.next(ui + 1, nxt);
        const char* nA = has_next ? (const char*)g.A + (size_t)nxt.pm * tstepA + (size_t)nxt.pn * pnoff : cA; const char* nB = has_next ? (const char*)g.Bt + (size_t)nxt.pn * tstepB : cB;
        for (int t = 0; t < nt; t += 2) {
            const bool last = (t == nt - 2);
            const char* a1 = cA + (size_t)(t + 1) * kstep;
            const char* a2 = last ? nA : cA + (size_t)(t + 2) * kstep; const char* b2 = last ? nB : cB + (size_t)(t + 2) * kstep;
            const char* a3 = a2 + kstep; const char* b3 = b2 + kstep;
            if (last && has_next) S.a_ready(nxt);
            if constexpr (SP2) {
            PG8_LDB(B0, 0, 0); PG8_LDB(B1, 0, 1); PG8_SCHED; PG8_LDA(At, 0, 0); PG8_STAGE(PG8_SA(1, 1), a1 + hstepA, voffA);
            PG8_WAIT_V(8); PG8_WAIT_L(0); PG8_BAR; PG8_MMA(0, 0, At, B0); PG8_MMA(0, 1, At, B1); PG8_BAR; PG8_SCHED;
            PG8_LDA(At, 0, 1); PG8_STAGE(PG8_SB(0, 0), b2, voffB); PG8_STAGE(PG8_SB(0, 1), b2 + hstepB, voffB); PG8_STAGE(PG8_SA(0, 0), a2, voffA);
            PG8_WAIT_V(8); PG8_WAIT_L(0); PG8_BAR; PG8_MMA(1, 0, At, B0); PG8_MMA(1, 1, At, B1); PG8_BAR; PG8_SCHED;
            PG8_LDB(B0, 1, 0); PG8_LDB(B1, 1, 1); PG8_SCHED; PG8_LDA(At, 1, 0); PG8_STAGE(PG8_SA(0, 1), a2 + hstepA, voffA);
            PG8_WAIT_V(8); PG8_WAIT_L(0); PG8_BAR; PG8_MMA(0, 0, At, B0); PG8_MMA(0, 1, At, B1); PG8_BAR; PG8_SCHED;
            PG8_LDA(At, 1, 1); PG8_STAGE(PG8_SB(1, 0), b3, voffB); PG8_STAGE(PG8_SB(1, 1), b3 + hstepB, voffB); PG8_STAGE(PG8_SA(1, 0), a3, voffA);
            PG8_WAIT_V(8); PG8_WAIT_L(0); PG8_BAR; PG8_MMA(1, 0, At, B0); PG8_MMA(1, 1, At, B1); PG8_BAR; PG8_SCHED;
            } else {
            PG8_LDB(B0, 0, 0); PG8_SCHED; PG8_LDA(At, 0, 0); PG8_STAGE(PG8_SA(1, 1), a1 + hstepA, voffA);
            PG8_WAIT_L(8); PG8_BAR; PG8_WAIT_L(0); PG8_MMA(0, 0, At, B0); PG8_BAR; PG8_SCHED;
            PG8_LDB(B1, 0, 1); PG8_STAGE(PG8_SB(0, 0), b2, voffB);
            PG8_BAR; PG8_WAIT_L(0); PG8_MMA(0, 1, At, B1); PG8_BAR;
            PG8_LDA(At, 0, 1); PG8_STAGE(PG8_SA(0, 0), a2, voffA);
            PG8_BAR; PG8_WAIT_L(0); PG8_MMA(1, 0, At, B0); PG8_BAR; PG8_SCHED;
            PG8_STAGE(PG8_SB(0, 1), b2 + hstepB, voffB);
            PG8_WAIT_V(6); PG8_BAR; PG8_MMA(1, 1, At, B1); PG8_BAR;
            PG8_LDB(B0, 1, 0); PG8_SCHED; PG8_LDA(At, 1, 0); PG8_STAGE(PG8_SA(0, 1), a2 + hstepA, voffA);
            PG8_WAIT_L(8); PG8_BAR; PG8_WAIT_L(0); PG8_MMA(0, 0, At, B0); PG8_BAR; PG8_SCHED;
            PG8_LDB(B1, 1, 1); PG8_STAGE(PG8_SB(1, 0), b3, voffB);
            PG8_BAR; PG8_WAIT_L(0); PG8_MMA(0, 1, At, B1); PG8_BAR;
            PG8_LDA(At, 1, 1); PG8_STAGE(PG8_SA(1, 0), a3, voffA);
            PG8_BAR; PG8_WAIT_L(0); PG8_MMA(1, 0, At, B0); PG8_BAR; PG8_SCHED;
            PG8_STAGE(PG8_SB(1, 1), b3 + hstepB, voffB);
            PG8_WAIT_V(6); PG8_BAR; PG8_MMA(1, 1, At, B1); PG8_BAR;
            }
        }
        if constexpr (ALIGN_EPI) { if (wr == 0) PG8_BAR; }
        if constexpr (!Epi::AFTER_DRAIN) { E(acc, cur, wr, wc, fr, fq); S.done(cur); }
        if (!has_next) break;
#pragma unroll
        for (int a = 0; a < 2; ++a)
#pragma unroll
            for (int b = 0; b < 2; ++b)
#pragma unroll
                for (int m = 0; m < 4; ++m)
#pragma unroll
                    for (int n = 0; n < 2; ++n) acc[a][b][m][n] = (f32x4){0.f, 0.f, 0.f, 0.f};
        cur = nxt; cA = nA; cB = nB; ++ui;
        if constexpr (ALIGN_EPI) { if (wr == 1) PG8_BAR; }
    }
    PG8_WAIT_V(0);
    if constexpr (!ALIGN_EPI) { if (wr == 0) PG8_BAR; }
    PG8_BAR;
    if constexpr (Epi::AFTER_DRAIN) { E.fused(acc, cur, wr, wc, fr, fq, lds, wid, lane); S.done(cur); }
#undef PG8_SA
#undef PG8_SB
#undef PG8_STAGE
#undef PG8_LDA
#undef PG8_LDB
#undef PG8_MMA
#undef PG8_WAIT_V
#undef PG8_WAIT_L
#undef PG8_BAR
#undef PG8_SCHED
}
}

namespace epi {
using pg8::Unit; using pg8::HALF; using pg8::BM;

DI void store_bf16_tile(const f32x4 (&acc)[2][2][4][2], bf16_t* base, int ld, int row0, int col0) {
#pragma unroll
    for (int ai = 0; ai < 2; ++ai)
#pragma unroll
        for (int m = 0; m < 4; ++m) { bf16_t* rowp = base + (size_t)(row0 + ai * HALF + m * 16) * ld + col0;
#pragma unroll
            for (int bj = 0; bj < 2; ++bj) { const f32x4 v0 = acc[ai][bj][m][0], v1 = acc[ai][bj][m][1];
                u32x4 w; w.x = pk2(v0[0], v0[1]); w.y = pk2(v0[2], v0[3]); w.z = pk2(v1[0], v1[1]); w.w = pk2(v1[2], v1[3]);
                *(u32x4*)(rowp + bj * HALF) = w; } }
}

struct EpiE0 {
    static constexpr bool PERM = true, AFTER_DRAIN = false;
    bf16_t* zab; bf16_t* xbcraw; bf16_t* xb; float* dtraw;
    DI void operator()(const f32x4 (&acc)[2][2][4][2], const Unit& u, int wr, int wc, int fr, int fq) const {
        const int pn = u.pn, row0 = u.pm * BM + wr * 64 + fr;
        bf16_t* base; int ld, colt;
        if (pn < 4) { base = zab; ld = 2048; colt = pn * 256; }
        else if (pn < 12) { base = xbcraw; ld = 2048; colt = (pn - 4) * 256; }
        else if (pn < 16) { base = zab; ld = 2048; colt = 1024 + (pn - 12) * 256; }
        else if (pn < 20) { base = xb; ld = 1024; colt = (pn - 16) * 256; }
        else {
            if (wc == 0) {
#pragma unroll
                for (int ai = 0; ai < 2; ++ai)
#pragma unroll
                    for (int m = 0; m < 4; ++m) { float* p = dtraw + (size_t)(row0 + ai * HALF + m * 16) * 32 + 8 * fq;
                        *(f32x4*)p = acc[ai][0][m][0]; *(f32x4*)(p + 4) = acc[ai][0][m][1]; }
            }
            return;
        }
        store_bf16_tile(acc, base, ld, row0, colt + wc * 32 + 8 * fq);
    }
};
struct EpiO {
    static constexpr bool PERM = true, AFTER_DRAIN = false;
    bf16_t* u1; const float* rope; int grow0;
    bf16_t* kc; bf16_t* vc; bf16_t* kd; bf16_t* vd;
    DI void operator()(const f32x4 (&acc)[2][2][4][2], const Unit& u, int wr, int wc, int fr_, int fq_) const {
        int lane; asm volatile("v_mbcnt_lo_u32_b32 %0, -1, 0\n\tv_mbcnt_hi_u32_b32 %0, -1, %0" : "=v"(lane));
        const int fr = lane & 15, fq = lane >> 4;
        const int gr0 = grow0 + u.pm * BM, pn = u.pn;
        const bool latent = gr0 >= R_CTX;
        const bool rot = latent && (pn < 8 || (pn >= 16 && pn <= 20));
        const int rl0 = u.pm * BM + wr * 64 + fr, col0 = pn * 256 + wc * 32 + 8 * fq;
        bf16_t* pb[2]; int rs;
        if (latent && ((pn >= 4 && pn < 12) || pn == 20 || pn == 21)) {
            const int lrow0 = gr0 - R_CTX, bl = (lrow0 >> 12) & 3, t0 = (lrow0 & 4095) + wr * 64 + fr;
            if (pn < 12) { bf16_t* cb = pn < 8 ? kc : vc; const int hh0 = 2 * (pn & 3); rs = 128;
                pb[0] = cb + ((size_t)((bl * 8 + hh0) * 4096 + t0)) * 128 + wc * 32 + 8 * fq; pb[1] = pb[0] + (size_t)4096 * 128; }
            else { bf16_t* cb = pn == 20 ? kd : vd; rs = 64;
                pb[0] = cb + ((size_t)((bl * 4 + (wc >> 1)) * 4096 + t0)) * 64 + (wc & 1) * 32 + 8 * fq; pb[1] = pb[0] + (size_t)2 * 4096 * 64; }
        } else { pb[0] = u1 + (size_t)rl0 * N_O + col0; pb[1] = pb[0] + HALF; rs = N_O; }
        if (!rot) {
#pragma unroll
            for (int ai = 0; ai < 2; ++ai)
#pragma unroll
                for (int m = 0; m < 4; ++m)
#pragma unroll
                    for (int bj = 0; bj < 2; ++bj) { const f32x4 v0 = acc[ai][bj][m][0], v1 = acc[ai][bj][m][1];
                        u32x4 w; w.x = pk2(v0[0], v0[1]); w.y = pk2(v0[2], v0[3]); w.z = pk2(v1[0], v1[1]); w.w = pk2(v1[2], v1[3]);
                        *(u32x4*)(pb[bj] + (size_t)(ai * HALF + m * 16) * rs) = w; }
            return;
        }
        const int axis = wc & 1;
        const bool upper = lane >= 32;
        const float sgn = upper ? 1.f : -1.f;
#pragma unroll
        for (int ai = 0; ai < 2; ++ai)
#pragma unroll
            for (int m = 0; m < 4; ++m) {
                const int rl = rl0 + ai * HALF + m * 16;
                const int t = (grow0 + rl - R_CTX) & 4095, pos = axis ? (t & 63) : (t >> 6);
                const float* cp = rope + pos * 16 + 8 * (fq & 1);
                const f32x4 c0 = *(const f32x4*)cp, c1 = *(const f32x4*)(cp + 4), s0 = *(const f32x4*)(cp + 1024) * sgn, s1 = *(const f32x4*)(cp + 1028) * sgn;
#pragma unroll
                for (int bj = 0; bj < 2; ++bj) {
                    f32x4 o[2];
#pragma unroll
                    for (int n = 0; n < 2; ++n) { const f32x4 own = acc[ai][bj][m][n]; f32x4 par;
#pragma unroll
                        for (int q = 0; q < 4; ++q) { auto rr = __builtin_amdgcn_permlane32_swap(__float_as_uint(own[q]), __float_as_uint(own[q]), false, false); par[q] = __uint_as_float(upper ? rr[0] : rr[1]); }
                        o[n] = own * (n ? c1 : c0) + par * (n ? s1 : s0); }
                    u32x4 w; w.x = pk2(o[0][0], o[0][1]); w.y = pk2(o[0][2], o[0][3]); w.z = pk2(o[1][0], o[1][1]); w.w = pk2(o[1][2], o[1][3]);
                    *(u32x4*)(pb[bj] + (size_t)(ai * HALF + m * 16) * rs) = w;
                }
            }
    }
};
struct EpiPool {
    static constexpr bool PERM = true, AFTER_DRAIN = false;
    bf16_t* aout; const bf16_t* zab; const float* ssy;
    DI void operator()(const f32x4 (&acc)[2][2][4][2], const Unit& u, int wr, int wc, int fr_, int fq_) const {
        int lane; asm volatile("v_mbcnt_lo_u32_b32 %0, -1, 0\n\tv_mbcnt_hi_u32_b32 %0, -1, %0" : "=v"(lane));
        const int fr = lane & 15, fq = lane >> 4;
        const int row0 = u.pm * BM + wr * 64 + fr, col0 = u.pn * 256 + wc * 32 + 8 * fq;
#pragma unroll
        for (int ai = 0; ai < 2; ++ai)
#pragma unroll
            for (int m = 0; m < 4; ++m) { const size_t r = (size_t)(row0 + ai * HALF + m * 16); const float irs = sqrtf(ssy[r] * (1.f / 1024.f) + EPS);
#pragma unroll
                for (int bj = 0; bj < 2; ++bj) {
                    const size_t off = r * 2048 + 1024 + col0 + bj * HALF;
                    const u32x4 z = *(const u32x4*)(zab + off);
                    const f32x4 v0 = acc[ai][bj][m][0] * irs, v1 = acc[ai][bj][m][1] * irs;
                    u32x4 w; w.x = pk2(v0[0] * silu_f(lo_f(z.x)), v0[1] * silu_f(hi_f(z.x))); w.y = pk2(v0[2] * silu_f(lo_f(z.y)), v0[3] * silu_f(hi_f(z.y)));
                    w.z = pk2(v1[0] * silu_f(lo_f(z.z)), v1[1] * silu_f(hi_f(z.z))); w.w = pk2(v1[2] * silu_f(lo_f(z.w)), v1[3] * silu_f(hi_f(z.w)));
                    *(u32x4*)(aout + off) = w;
                    asm volatile("" ::: "memory"); } }
    }
};
template <bool L0>
struct EpiRes {
    static constexpr bool PERM = true, AFTER_DRAIN = false;
    const float* xp; const float* xs;
    float* out;
    const float* modl;
    int grow0;
    const float* ssy;
    bf16_t* x1b;
    bf16_t* x2b;
    DI void operator()(const f32x4 (&acc)[2][2][4][2], const Unit& u, int wr, int wc, int fr_, int fq_) const {
        int lane; asm volatile("v_mbcnt_lo_u32_b32 %0, -1, 0\n\tv_mbcnt_hi_u32_b32 %0, -1, %0" : "=v"(lane));
        const int fr = lane & 15, fq = lane >> 4;
        const int gr0 = grow0 + u.pm * BM;
        const int g = gr0 < R_CTX ? 8 : ((gr0 - R_CTX) >> 12);
        const float* gate = modl + g * 3072 + 2048;
        const int col0 = u.pn * 256 + wc * 32 + 8 * fq, rl = wr * 64 + fr;
        f32x4 gv[2][2];
#pragma unroll
        for (int bj = 0; bj < 2; ++bj) { gv[bj][0] = *(const f32x4*)(gate + col0 + bj * HALF); gv[bj][1] = *(const f32x4*)(gate + col0 + bj * HALF + 4); }
#pragma unroll
        for (int ai = 0; ai < 2; ++ai)
#pragma unroll
            for (int m = 0; m < 4; ++m) { const int rt = rl + ai * HALF + m * 16; const size_t loff = (size_t)(u.pm * BM + rt) * DM + col0;
                float rs = 1.f; if (L0) rs = rsqrtf(ssy[u.pm * BM + rt] * (1.f / 1024.f) + EPS);
#pragma unroll
                for (int bj = 0; bj < 2; ++bj) {
                    f32x4 x0, x1;
                    if (L0) { const float* xin = (gr0 < R_CTX ? xp + (size_t)gr0 * DM : xs + (size_t)(gr0 - R_CTX) * DM) + (size_t)rt * DM + col0 + bj * HALF;
                        x0 = *(const f32x4*)xin; x1 = *(const f32x4*)(xin + 4); }
                    else { const u32x4 xb = *(const u32x4*)(x1b + loff + bj * HALF); x0 = (f32x4){lo_f(xb.x), hi_f(xb.x), lo_f(xb.y), hi_f(xb.y)}; x1 = (f32x4){lo_f(xb.z), hi_f(xb.z), lo_f(xb.w), hi_f(xb.w)}; }
                    const f32x4 y0 = x0 + gv[bj][0] * (acc[ai][bj][m][0] * rs), y1 = x1 + gv[bj][1] * (acc[ai][bj][m][1] * rs);
                    u32x4 w; w.x = pk2(y0[0], y0[1]); w.y = pk2(y0[2], y0[3]); w.z = pk2(y1[0], y1[1]); w.w = pk2(y1[2], y1[3]);
                    *(u32x4*)((L0 ? x1b : x2b) + loff + bj * HALF) = w;
                }
                asm volatile("" ::: "memory"); }
    }
};
}
struct Params { const float* in[28]; float* out; unsigned char* ws; int ph_lo, ph_hi; };
struct Frame {
    ldsp lds; int tid, lane, wave, G, bid;
    const Params& p; float* out; unsigned char* ws; int probe;
};
enum { I_XP = 0, I_XS, I_SSDF, I_SSDB, I_CDK, I_CDV, I_CWK, I_CWV, I_C, I_CCTX, I_WADA, I_BADA, I_EWIN, I_ECONVW, I_ECONVB, I_EALOG, I_EDTB, I_ED, I_ENORMG,
       I_EPOOLW, I_EPOOLS, I_EWOUT, I_OWIN, I_OLAM, I_OSUBG, I_OSINK, I_OWOUT, I_FNORMG };

DI void transpose_item(const float* W, int ldw, int srcn0, int K, bf16_t* WT, int dstn0, int k0, LAS float* scr, int lane, const float* nscale = nullptr) {
    if (srcn0 >= 0) {
#pragma unroll 8
        for (int i = 0; i < 32; ++i) { const int kk = 2 * i + (lane >> 5); scr[kk * 33 + (lane & 31)] = W[(size_t)(k0 + kk) * ldw + srcn0 + (lane & 31)]; }
    } else {
#pragma unroll 8
        for (int i = 0; i < 32; ++i) { const int kk = 2 * i + (lane >> 5); scr[kk * 33 + (lane & 31)] = 0.f; }
    }
    asm volatile("s_waitcnt lgkmcnt(0)" ::: "memory");
    const int c = lane & 7;
#pragma unroll
    for (int j = 0; j < 4; ++j) { const int n = (lane >> 3) + 8 * j; const LAS float* s = scr + (8 * c) * 33 + n;
        const float sc = nscale ? nscale[n] : 1.f;
        u32x4 o; o.x = pk2(s[0 * 33] * sc, s[1 * 33] * sc); o.y = pk2(s[2 * 33] * sc, s[3 * 33] * sc); o.z = pk2(s[4 * 33] * sc, s[5 * 33] * sc); o.w = pk2(s[6 * 33] * sc, s[7 * 33] * sc);
        *(u32x4*)(WT + (size_t)(dstn0 + n) * K + k0 + 8 * c) = o; }
    asm volatile("s_waitcnt lgkmcnt(0)" ::: "memory");
}

DI void phase_p0(Frame& F) {
    if (F.bid < 192) {
        LAS float* sv = (LAS float*)F.lds;
        LAS float* red = (LAS float*)(F.lds + 40960);
        for (int i = F.tid; i < 9 * 1024; i += NTHREADS) { const int g = i >> 10, k = i & 1023; const float v = g < 8 ? F.p.in[I_C][g * 1024 + k] : F.p.in[I_CCTX][k]; sv[i] = silu_f(v); }
        __syncthreads();
        const int l = F.bid / 96, n0 = (F.bid % 96) * 32, kg = F.tid >> 5, c = F.tid & 31;
        const float* w = F.p.in[I_WADA] + (size_t)l * 1024 * 3072 + n0 + c;
        float acc[9];
#pragma unroll
        for (int g = 0; g < 9; ++g) acc[g] = 0.f;
#pragma unroll 4
        for (int kk = 0; kk < 64; ++kk) { const int k = kg * 64 + kk; const float wv = w[(size_t)k * 3072];
#pragma unroll
            for (int g = 0; g < 9; ++g) acc[g] += sv[g * 1024 + k] * wv; }
#pragma unroll
        for (int g = 0; g < 9; ++g) red[(kg * 9 + g) * 32 + c] = acc[g];
        __syncthreads();
        if (F.tid < 288) { const int g = F.tid >> 5, cc = F.tid & 31; float s = F.p.in[I_BADA][l * 3072 + n0 + cc];
#pragma unroll
            for (int q = 0; q < 16; ++q) s += red[(q * 9 + g) * 32 + cc];
            ((float*)(F.ws + WS_MOD))[(l * 9 + g) * 3072 + n0 + cc] = s; }
        __syncthreads();
    }
    if (F.bid == F.G - 1) {
        float* rc = (float*)(F.ws + WS_ROPE); float* rs = rc + 1024;
        for (int i = F.tid; i < 1024; i += NTHREADS) { const int pos = i >> 4, f = i & 15; const float inv = __builtin_amdgcn_exp2f(-(float)f * (13.287712379549449f / 16.f)); const float ang = (float)pos * inv; rc[i] = __cosf(ang); rs[i] = __sinf(ang); }
        if (F.tid == 0) { const float* lp = F.p.in[I_OLAM]; float s1 = 0.f, s2 = 0.f;
            for (int i = 0; i < 64; ++i) { s1 += lp[i] * lp[64 + i]; s2 += lp[128 + i] * lp[192 + i]; }
            float lam_init = 0.8f - 0.6f * 0.7408182206817179f; asm volatile("" : "+v"(lam_init));
            float* o = (float*)(F.ws + WS_LAM); o[0] = __expf(s1) - __expf(s2) + lam_init; o[1] = 1.f - lam_init; }
    }
    {
        LAS float* scr = (LAS float*)(F.lds + 65536 + F.wave * 8704);
        const int gw = F.bid * NWAVES + F.wave, NGW = F.G * NWAVES;
        for (int it = gw; it < 8192; it += NGW) {
            int r = it;
            if (r < 2688) { const int kb = r / 168, nb = r % 168; int src;
                if (nb < 96) src = nb * 32; else if (nb < 160) src = (nb + 1) * 32; else if (nb == 160) src = 3072; else src = -1;
                transpose_item(F.p.in[I_EWIN], 5152, src, 1024, (bf16_t*)(F.ws + WS_WT_IN_E), nb * 32, kb * 64, scr, F.lane); continue; }
            r -= 2688;
            if (r < 1024) { const int kb = r >> 5, nb = r & 31; transpose_item(F.p.in[I_EWOUT], 1024, nb * 32, 2048, (bf16_t*)(F.ws + WS_WT_OUT_E), nb * 32, kb * 64, scr, F.lane); continue; }
            r -= 1024;
            if (r < 3328) { const int kb = r / 208, nb = r % 208; transpose_item(F.p.in[I_OWIN], N_O, nb * 32, 1024, (bf16_t*)(F.ws + WS_WT_IN_O), nb * 32, kb * 64, scr, F.lane); continue; }
            r -= 3328;
            if (r < 1024) { const int kb = r >> 5, nb = r & 31; transpose_item(F.p.in[I_OWOUT], 1024, nb * 32, 2048, (bf16_t*)(F.ws + WS_WT_OUT_O), nb * 32, kb * 64, scr, F.lane); continue; }
            r -= 1024;
            { const int g = r >> 5, q = r & 31, kb = q >> 3, nb = q & 7;
              transpose_item(F.p.in[I_EPOOLW] + (size_t)g * 65536, 256, nb * 32, 256, (bf16_t*)(F.ws + WS_WT_POOL) + (size_t)g * 65536, nb * 32, kb * 64, scr, F.lane, F.p.in[I_EPOOLS] + g * 256 + nb * 32); }
        }
    }
    {
        const int gt = F.bid * NTHREADS + F.tid, NT = F.G * NTHREADS;
        for (int it = gt; it < 1310720; it += NT) {
            const float* src; bf16_t* dst; int o = it;
            if (o < 524288) { src = F.p.in[I_CDK]; dst = (bf16_t*)(F.ws + WS_CK); }
            else if (o < 1048576) { o -= 524288; src = F.p.in[I_CDV]; dst = (bf16_t*)(F.ws + WS_CV); }
            else if (o < 1179648) { o -= 1048576; src = F.p.in[I_CWK]; dst = (bf16_t*)(F.ws + WS_WK); }
            else { o -= 1179648; src = F.p.in[I_CWV]; dst = (bf16_t*)(F.ws + WS_WV); }
            const f32x4 a = *(const f32x4*)(src + (size_t)o * 8), b = *(const f32x4*)(src + (size_t)o * 8 + 4);
            u32x4 w; w.x = pk2(a[0], a[1]); w.y = pk2(a[2], a[3]); w.z = pk2(b[0], b[1]); w.w = pk2(b[2], b[3]);
            *(u32x4*)(dst + (size_t)o * 8) = w;
        }
    }
}

DI void phase_modnorm(Frame& F, int grp, int layer) {
    const int row0 = GRP_ROW0[grp], rows = GRP_ROWS[grp];
    const int gw = F.bid * NWAVES + F.wave, NGW = F.G * NWAVES;
    const float* mod = (const float*)(F.ws + WS_MOD) + layer * 9 * 3072;
    bf16_t* H = (bf16_t*)(F.ws + WS_REGA);
    for (int rl = gw; rl < rows; rl += 2 * NGW) {
        f32x4 v[2][4]; float s[2];
#pragma unroll
        for (int q = 0; q < 2; ++q) { const int grow = row0 + min(rl + q * NGW, rows - 1);
            if (layer == 0) { const float* xrow = grow < R_CTX ? F.p.in[I_XP] + (size_t)grow * DM : F.p.in[I_XS] + (size_t)(grow - R_CTX) * DM;
                const f32x4* xr = (const f32x4*)xrow + F.lane;
#pragma unroll
                for (int j = 0; j < 4; ++j) v[q][j] = xr[64 * j]; }
            else { const u32x2* xr = (const u32x2*)((const bf16_t*)(F.ws + WS_X1B) + (size_t)(grow - row0) * DM) + F.lane;
#pragma unroll
                for (int j = 0; j < 4; ++j) { const u32x2 w = xr[64 * j]; v[q][j] = (f32x4){lo_f(w.x), hi_f(w.x), lo_f(w.y), hi_f(w.y)}; } } }
#pragma unroll
        for (int q = 0; q < 2; ++q) { float t = 0.f;
#pragma unroll
            for (int j = 0; j < 4; ++j) t += (v[q][j].x * v[q][j].x + v[q][j].y * v[q][j].y) + (v[q][j].z * v[q][j].z + v[q][j].w * v[q][j].w);
            s[q] = t; }
#pragma unroll
        for (int o = 1; o < 64; o <<= 1) { s[0] += shfl_idx(s[0], F.lane ^ o); s[1] += shfl_idx(s[1], F.lane ^ o); }
#pragma unroll
        for (int q = 0; q < 2; ++q) { const int rq = min(rl + q * NGW, rows - 1), grow = row0 + rq; const RowInfo ri = rowinfo(grow);
            const float rstd = rsqrtf(s[q] * (1.f / DM) + EPS);
            const float* sh = mod + ri.g * 3072; const float* sc = sh + 1024;
            u32x2* o8 = (u32x2*)(H + (size_t)rq * DM) + F.lane;
#pragma unroll
            for (int j = 0; j < 4; ++j) { const f32x4 a = *((const f32x4*)sh + F.lane + 64 * j), b = *((const f32x4*)sc + F.lane + 64 * j);
                const f32x4 y = v[q][j] * rstd * (b + 1.f) + a; u32x2 w; w.x = pk2(y.x, y.y); w.y = pk2(y.z, y.w); o8[64 * j] = w; } }
    }
}

DI float softplus_f(float x) { return x > 15.f ? x : (x < -15.f ? __expf(x) : __logf(1.f + __expf(x))); }
DI void acc8(float (&s)[8], const u32x4 xv, const float sg) {
    s[0] += sg * lo_f(xv.x); s[1] += sg * hi_f(xv.x); s[2] += sg * lo_f(xv.y); s[3] += sg * hi_f(xv.y); s[4] += sg * lo_f(xv.z); s[5] += sg * hi_f(xv.z); s[6] += sg * lo_f(xv.w); s[7] += sg * hi_f(xv.w);
}
template <int W>
DI void pool_task(const bf16_t* xp, bf16_t* op, const int t0, const int T) {
    constexpr int LEFT = W / 2, RIGHT = W - 1 - LEFT, S = 16, NR = S + W - 1;
    const u32x4 zero4 = {0u, 0u, 0u, 0u};
    u32x4 r[NR];
#pragma unroll
    for (int k = 0; k < NR; ++k) { const int pos = t0 - LEFT + k; r[k] = (pos >= 0 && pos < T) ? *(const u32x4*)(xp + (ptrdiff_t)(k - LEFT) * 1024) : zero4; }
    float s[8];
#pragma unroll
    for (int e = 0; e < 8; ++e) s[e] = 0.f;
#pragma unroll
    for (int k = 0; k < W; ++k) acc8(s, r[k], 1.f);
#pragma unroll
    for (int i = 0; i < S; ++i) {
        const int t = t0 + i, lo = max(t - LEFT, 0), hi = min(t + RIGHT + 1, T);
        const float inv = 1.f / (float)(hi - lo);
        const u32x4 xs = r[i + LEFT];
        u32x4 o; o.x = pk2(s[0] * inv - lo_f(xs.x), s[1] * inv - hi_f(xs.x)); o.y = pk2(s[2] * inv - lo_f(xs.y), s[3] * inv - hi_f(xs.y));
        o.z = pk2(s[4] * inv - lo_f(xs.z), s[5] * inv - hi_f(xs.z)); o.w = pk2(s[6] * inv - lo_f(xs.w), s[7] * inv - hi_f(xs.w));
        *(u32x4*)(op + (size_t)i * 1024) = o;
        if (i + 1 < S) { acc8(s, r[i + W], 1.f); acc8(s, r[i], -1.f); }
    }
}
DI void phase_conv(Frame& F, int grp) {
    const int row0 = GRP_ROW0[grp], rows = GRP_ROWS[grp];
    const int gt = F.bid * NTHREADS + F.tid, NT = F.G * NTHREADS;
    { float* ssy = (float*)(F.ws + WS_SSY); float* ss1 = (float*)(F.ws + WS_SS1); for (int i = gt; i < rows; i += NT) { ssy[i] = 0.f; ss1[i] = 0.f; } }
    const bf16_t* xb = (const bf16_t*)(F.ws + WS_XB); bf16_t* pooled = (bf16_t*)(F.ws + WS_POOLED);
    const int nstrip = rows / 16;
    for (int task = gt; task < nstrip * 128; task += NT) {
        const int g = task / (nstrip * 32), rem = task - g * (nstrip * 32), strip = rem >> 5, c0 = g * 256 + (rem & 31) * 8, rl0 = strip * 16;
        const RowInfo ri = rowinfo(row0 + rl0);
        const bf16_t* xp = xb + (size_t)rl0 * 1024 + c0; bf16_t* op = pooled + (size_t)rl0 * 1024 + c0;
        if (g == 0) pool_task<2>(xp, op, ri.t, ri.T); else if (g == 1) pool_task<4>(xp, op, ri.t, ri.T); else if (g == 2) pool_task<8>(xp, op, ri.t, ri.T); else pool_task<16>(xp, op, ri.t, ri.T);
    }
    const float* dtraw = (const float*)(F.ws + WS_DTRAW); float* dtv = (float*)(F.ws + WS_DTV); float* acs = (float*)(F.ws + WS_ACS);
    const int nch = rows >> 7;
    LAS float* tot = (LAS float*)F.lds;
    for (int ci = F.bid; ci < nch; ci += F.G) {
        const int j = F.tid & 31, seg = F.tid >> 5; const size_t r0 = (size_t)ci * 128 + seg * 8;
        const float bias = F.p.in[I_EDTB][j], A = -__expf(F.p.in[I_EALOG][j]);
        float d[8], inc[8], run = 0.f;
#pragma unroll
        for (int i = 0; i < 8; ++i) d[i] = dtraw[(r0 + i) * 32 + j];
#pragma unroll
        for (int i = 0; i < 8; ++i) { d[i] = softplus_f(d[i] + bias); run += d[i] * A; inc[i] = run; }
        tot[seg * 32 + j] = run;
        __syncthreads();
        float before = 0.f, total = 0.f;
#pragma unroll
        for (int s = 0; s < 16; ++s) { const float v = tot[s * 32 + j]; total += v; before += s < seg ? v : 0.f; }
        __syncthreads();
#pragma unroll
        for (int i = 0; i < 8; ++i) { dtv[(r0 + i) * 32 + j] = d[i]; acs[(r0 + i) * 32 + j] = j < 16 ? inc[i] + before : total - (inc[i] + before) + d[i] * A; }
    }
}

DI void phase_bias1(Frame& F) {
    const bf16_t* wt = (const bf16_t*)(F.ws + WS_WT_IN_O); const float* mod1 = (const float*)(F.ws + WS_MOD) + 9 * 3072; float* b1 = (float*)(F.ws + WS_BIAS1);
    const int gw = F.bid * NWAVES + F.wave, NGW = F.G * NWAVES;
    for (int n = gw; n < N_O; n += NGW) {
        const u32x4 w0 = *(const u32x4*)(wt + (size_t)n * 1024 + F.lane * 16), w1 = *(const u32x4*)(wt + (size_t)n * 1024 + F.lane * 16 + 8);
        const float wv[16] = {lo_f(w0.x), hi_f(w0.x), lo_f(w0.y), hi_f(w0.y), lo_f(w0.z), hi_f(w0.z), lo_f(w0.w), hi_f(w0.w), lo_f(w1.x), hi_f(w1.x), lo_f(w1.y), hi_f(w1.y), lo_f(w1.z), hi_f(w1.z), lo_f(w1.w), hi_f(w1.w)};
#pragma unroll 1
        for (int g = 0; g < 9; ++g) { const float* sh = mod1 + g * 3072 + F.lane * 16; float s = 0.f;
#pragma unroll
            for (int q = 0; q < 4; ++q) { const f32x4 v = *(const f32x4*)(sh + 4 * q); s += (v.x * wv[4 * q] + v.y * wv[4 * q + 1]) + (v.z * wv[4 * q + 2] + v.w * wv[4 * q + 3]); }
            s = wave_sum(s, F.lane);
            if (F.lane == 0) b1[g * N_O + n] = s; }
    }
}
template <int NR = 8>
DI void conv_rows_to_lds(const bf16_t* xraw, const float* cw, const float* cb, int rbase, int t0, int T, int col0, int rb, ldsp dst, int dstride) {
    const bf16_t* xp = xraw + (size_t)(rbase + NR * rb) * 2048 + col0;
    const u32x4 zero4 = {0u, 0u, 0u, 0u};
    u32x4 r[NR + 4];
#pragma unroll
    for (int k = 0; k < NR + 4; ++k) { const int pos = t0 + NR * rb + k - 2; r[k] = (pos >= 0 && pos < T) ? *(const u32x4*)(xp + (ptrdiff_t)(k - 2) * 2048) : zero4; }
    float w[5][8], bias[8];
#pragma unroll
    for (int k = 0; k < 5; ++k) { const f32x4 w0 = *(const f32x4*)(cw + k * 2048 + col0), w1 = *(const f32x4*)(cw + k * 2048 + col0 + 4);
        w[k][0] = w0.x; w[k][1] = w0.y; w[k][2] = w0.z; w[k][3] = w0.w; w[k][4] = w1.x; w[k][5] = w1.y; w[k][6] = w1.z; w[k][7] = w1.w; }
    { const f32x4 b0 = *(const f32x4*)(cb + col0), b1 = *(const f32x4*)(cb + col0 + 4); bias[0] = b0.x; bias[1] = b0.y; bias[2] = b0.z; bias[3] = b0.w; bias[4] = b1.x; bias[5] = b1.y; bias[6] = b1.z; bias[7] = b1.w; }
#pragma unroll
    for (int i = 0; i < NR; ++i) {
        float acc[8];
#pragma unroll
        for (int e = 0; e < 8; ++e) acc[e] = bias[e];
#pragma unroll
        for (int k = 0; k < 5; ++k) { const u32x4 xv = r[i + k];
            acc[0] += lo_f(xv.x) * w[k][0]; acc[1] += hi_f(xv.x) * w[k][1]; acc[2] += lo_f(xv.y) * w[k][2]; acc[3] += hi_f(xv.y) * w[k][3];
            acc[4] += lo_f(xv.z) * w[k][4]; acc[5] += hi_f(xv.z) * w[k][5]; acc[6] += lo_f(xv.w) * w[k][6]; acc[7] += hi_f(xv.w) * w[k][7]; }
        u32x4 o; o.x = pk2(silu_f(acc[0]), silu_f(acc[1])); o.y = pk2(silu_f(acc[2]), silu_f(acc[3])); o.z = pk2(silu_f(acc[4]), silu_f(acc[5])); o.w = pk2(silu_f(acc[6]), silu_f(acc[7]));
        lds_st128(dst + (NR * rb + i) * dstride, o);
    }
}

DI void phase_states(Frame& F, int grp) {
    const int row0 = GRP_ROW0[grp], rows = GRP_ROWS[grp], nch = rows >> 7;
    const bf16_t* xraw = (const bf16_t*)(F.ws + WS_XBCRAW);
    const float* dtv = (const float*)(F.ws + WS_DTV); const float* acs = (const float*)(F.ws + WS_ACS);
    float* decay = (float*)(F.ws + WS_DECAY); bf16_t* states = (bf16_t*)(F.ws + WS_REGA);
    const ldsp Bimg = F.lds, ximg = F.lds + 40960, xw = F.lds + 114688; LAS float* wts = (LAS float*)(F.lds + 139264);
    const int lane = F.lane, h = lane >> 5, i16 = lane & 15, qq = i16 >> 2, pp = i16 & 3, blk = (lane >> 4) & 1;
    for (int unit = F.bid; unit < nch * 4; unit += F.G) {
        const int ci = unit >> 2, g = unit & 3, rbase = ci * 128;
        { const RowInfo ri = rowinfo(row0 + rbase);
          conv_rows_to_lds<8>(xraw, F.p.in[I_ECONVW], F.p.in[I_ECONVB], rbase, ri.t, ri.T, g * 256 + (F.tid & 31) * 8, F.tid >> 5, ximg + (F.tid & 31) * 16, 576);
          conv_rows_to_lds<4>(xraw, F.p.in[I_ECONVW], F.p.in[I_ECONVB], rbase, ri.t, ri.T, 1024 + g * 128 + (F.tid & 15) * 8, F.tid >> 4, Bimg + (F.tid & 15) * 16, 320); }
#pragma unroll
        for (int i = 0; i < 2; ++i) { const int v = F.tid + 512 * i, hd = v >> 7, l = v & 127, j = (hd >> 2) * 16 + g * 4 + (hd & 3);
            const float ref = acs[(size_t)(rbase + ((hd >> 2) ? 0 : 127)) * 32 + j];
            wts[v] = __expf(ref - acs[(size_t)(rbase + l) * 32 + j]) * dtv[(size_t)(rbase + l) * 32 + j]; }
        if (F.tid < 8) { const int hd = F.tid, j = (hd >> 2) * 16 + g * 4 + (hd & 3); decay[ci * 32 + j] = __expf(acs[(size_t)(rbase + ((hd >> 2) ? 0 : 127)) * 32 + j]); }
        __syncthreads();
        for (int hd = 0; hd < 8; ++hd) {
            const int r = hd & 3, j = (hd >> 2) * 16 + g * 4 + r;
            { const int l = F.tid >> 2, pq = F.tid & 3; const float w = wts[hd * 128 + l];
              const ldsp src = ximg + l * 576 + (r * 64 + pq * 16) * 2; const ldsp dst = xw + l * 192 + pq * 32;
#pragma unroll
              for (int q = 0; q < 2; ++q) { const u32x4 v = *(const LAS u32x4*)(src + q * 16); u32x4 o;
                  o.x = pk2(lo_f(v.x) * w, hi_f(v.x) * w); o.y = pk2(lo_f(v.y) * w, hi_f(v.y) * w); o.z = pk2(lo_f(v.z) * w, hi_f(v.z) * w); o.w = pk2(lo_f(v.w) * w, hi_f(v.w) * w);
                  lds_st128(dst + q * 16, o); } }
            __syncthreads();
            const int pt = F.wave >> 2, nt = F.wave & 3;
            f32x16 acc;
#pragma unroll
            for (int i = 0; i < 16; ++i) acc[i] = 0.f;
            const ldsp ab = xw + (8 * h + qq) * 192 + (pt * 32 + 16 * blk) * 2 + 8 * pp;
            const ldsp bb = Bimg + (8 * h + qq) * 320 + (nt * 32 + 16 * blk) * 2 + 8 * pp;
#pragma unroll
            for (int ks = 0; ks < 8; ++ks) {
                const bf16x8 a = cat8(lds_tr(ab + ks * 16 * 192), lds_tr(ab + ks * 16 * 192 + 4 * 192));
                const bf16x8 b = cat8(lds_tr(bb + ks * 16 * 320), lds_tr(bb + ks * 16 * 320 + 4 * 320));
                acc = MFMA32(a, b, acc);
            }
            bf16_t* so = states + ((size_t)(ci * 32 + j) * 64 + pt * 32) * 128 + nt * 32 + (lane & 31);
#pragma unroll
            for (int i = 0; i < 16; ++i) so[(size_t)crow(i, h) * 128] = f2bf(acc[i]);
            __syncthreads();
        }
    }
}

DI void phase_scan(Frame& F, int grp) {
    bf16_t* st = (bf16_t*)(F.ws + WS_REGA); const float* decay = (const float*)(F.ws + WS_DECAY);
    const int nlat = 4, nctx = grp == 0 ? 16 : 0;
    const int gt = F.bid * NTHREADS + F.tid, NT = F.G * NTHREADS;
    const int nitems = (nlat + nctx) * 32768;
    for (int it = gt; it < nitems; it += NT) {
        int seq, c0, nc, lat; int rem;
        if (it < nlat * 32768) { seq = it >> 15; rem = it & 32767; lat = 1; nc = 32; c0 = (grp == 0 ? 32 : 0) + 32 * seq; }
        else { const int o = it - nlat * 32768; seq = o >> 15; rem = o & 32767; lat = 0; nc = 2; c0 = 2 * seq; }
        const int j = rem >> 10, e = (rem & 1023) * 8, dir = j >> 4, head = j & 15;
        float hv[8];
        if (lat) { const int b = grp * 4 + seq; const float* s0 = (dir ? F.p.in[I_SSDB] : F.p.in[I_SSDF]) + (size_t)(b * 16 + head) * 8192 + e;
            const f32x4 a = *(const f32x4*)s0, bq = *(const f32x4*)(s0 + 4); hv[0] = a.x; hv[1] = a.y; hv[2] = a.z; hv[3] = a.w; hv[4] = bq.x; hv[5] = bq.y; hv[6] = bq.z; hv[7] = bq.w; }
        else {
#pragma unroll
            for (int i = 0; i < 8; ++i) hv[i] = 0.f; }
        const int cs = dir ? -1 : 1, cb = c0 + (dir ? nc - 1 : 0);
        u32x4 win[4]; float dwin[4];
#pragma unroll
        for (int q = 0; q < 4; ++q) if (q < nc) { const int c = cb + cs * q; win[q] = *(const u32x4*)(st + (size_t)(c * 32 + j) * 8192 + e); dwin[q] = decay[c * 32 + j]; }
        for (int k0 = 0; k0 < nc; k0 += 4) {
#pragma unroll
            for (int q = 0; q < 4; ++q) {
                const int k = k0 + q;
                if (k < nc) {
                    const int c = cb + cs * k;
                    bf16_t* p = st + (size_t)(c * 32 + j) * 8192 + e;
                    const u32x4 sv = win[q]; const float d = dwin[q];
                    if (k + 4 < nc) { const int cn = cb + cs * (k + 4); win[q] = *(const u32x4*)(st + (size_t)(cn * 32 + j) * 8192 + e); dwin[q] = decay[cn * 32 + j]; }
                    u32x4 o; o.x = pk2(hv[0], hv[1]); o.y = pk2(hv[2], hv[3]); o.z = pk2(hv[4], hv[5]); o.w = pk2(hv[6], hv[7]);
                    *(u32x4*)p = o;
                    hv[0] = hv[0] * d + lo_f(sv.x); hv[1] = hv[1] * d + hi_f(sv.x); hv[2] = hv[2] * d + lo_f(sv.y); hv[3] = hv[3] * d + hi_f(sv.y);
                    hv[4] = hv[4] * d + lo_f(sv.z); hv[5] = hv[5] * d + hi_f(sv.z); hv[6] = hv[6] * d + lo_f(sv.w); hv[7] = hv[7] * d + hi_f(sv.w);
                }
            }
        }
        if (!lat) { float* o = F.out + (dir ? OUT_SSD_B : OUT_SSD_F) + (size_t)(seq * 16 + head) * 8192 + e;
            *(f32x4*)o = (f32x4){hv[0], hv[1], hv[2], hv[3]}; *(f32x4*)(o + 4) = (f32x4){hv[4], hv[5], hv[6], hv[7]}; }
    }
}

DI void phase_y(Frame& F, int grp) {
    const int row0 = GRP_ROW0[grp], rows = GRP_ROWS[grp], nch = rows >> 7;
    const bf16_t* xraw = (const bf16_t*)(F.ws + WS_XBCRAW);
    const float* dtv = (const float*)(F.ws + WS_DTV); const float* acs = (const float*)(F.ws + WS_ACS);
    const bf16_t* hprev = (const bf16_t*)(F.ws + WS_REGA);
    const bf16_t* zab = (const bf16_t*)(F.out + OUT_X + (size_t)row0 * DM);
    bf16_t* aout = (bf16_t*)(F.ws + WS_AOUT);
    const ldsp Bimg = F.lds, Cimg = F.lds + 34816, ximg = F.lds + 69632; LAS float* arr = (LAS float*)(F.lds + 143360);
    const int lane = F.lane, h = lane >> 5, r32 = lane & 31, i16 = lane & 15, qq = i16 >> 2, pp = i16 & 3, blk = (lane >> 4) & 1;
    const int lt = F.wave & 3, pt = F.wave >> 2;
    for (int unit = F.bid; unit < nch * 4; unit += F.G) {
        const int ci = unit >> 2, g = unit & 3, rbase = ci * 128;
        { const RowInfo ri = rowinfo(row0 + rbase);
#pragma unroll 1
          for (int id = F.tid; id < 1024; id += 512) { const int chunk = id & 63, rb = id >> 6;
              if (chunk < 16) conv_rows_to_lds(xraw, F.p.in[I_ECONVW], F.p.in[I_ECONVB], rbase, ri.t, ri.T, 1024 + g * 128 + chunk * 8, rb, Bimg + chunk * 16, 272);
              else if (chunk < 32) conv_rows_to_lds(xraw, F.p.in[I_ECONVW], F.p.in[I_ECONVB], rbase, ri.t, ri.T, 1536 + g * 128 + (chunk - 16) * 8, rb, Cimg + (chunk - 16) * 16, 272);
              else conv_rows_to_lds(xraw, F.p.in[I_ECONVW], F.p.in[I_ECONVB], rbase, ri.t, ri.T, g * 256 + (chunk - 32) * 8, rb, ximg + (chunk - 32) * 16, 576); } }
#pragma unroll
        for (int i = 0; i < 4; ++i) { const int v = F.tid + 512 * i, kind = v >> 9, r = (v >> 7) & 3, l = v & 127, j = (kind & 1) * 16 + g * 4 + r;
            arr[v] = (kind < 2 ? acs : dtv)[(size_t)(rbase + l) * 32 + j]; }
#pragma unroll
        for (int i = 0; i < 2; ++i) { const int v = F.tid + 512 * i, dirb = v >> 9, r = (v >> 7) & 3, sidx = v & 127, j = dirb * 16 + g * 4 + r;
            const int e = dirb ? (sidx & ~31) : (sidx | 31);
            arr[2048 + v] = __expf(acs[(size_t)(rbase + e) * 32 + j] - acs[(size_t)(rbase + sidx) * 32 + j]) * dtv[(size_t)(rbase + sidx) * 32 + j]; }
        __syncthreads();
        const int l = lt * 32 + r32;
        const ldsp cfp = Cimg + l * 272 + 8 * h * 2;
        const size_t rl = (size_t)(rbase + l);
        f32x16 cbt[4];
#pragma unroll
        for (int st = 0; st < 4; ++st) {
#pragma unroll
            for (int i = 0; i < 16; ++i) cbt[st][i] = 0.f;
            const ldsp bfp = Bimg + (st * 32 + r32) * 272 + 8 * h * 2;
#pragma unroll
            for (int ks = 0; ks < 8; ++ks) cbt[st] = MFMA32(lds_ld128(bfp + 32 * ks), lds_ld128(cfp + 32 * ks), cbt[st]);
        }
        __syncthreads();
#pragma unroll 1
        for (int r = 0; r < 4; ++r) {
            const int head = g * 4 + r;
            const bf16_t* hf = hprev + ((size_t)(ci * 32 + head) * 64 + pt * 32 + r32) * 128 + 8 * h;
            const bf16_t* hb = hf + (size_t)16 * 8192;
            bf16x8 hfv[8];
#pragma unroll
            for (int ks = 0; ks < 8; ++ks) hfv[ks] = *(const bf16x8*)(hf + 16 * ks);

            const float af_l = arr[(0 * 4 + r) * 128 + l], ab_l = arr[(1 * 4 + r) * 128 + l];
            f32x16 yd;
#pragma unroll
            for (int i = 0; i < 16; ++i) yd[i] = 0.f;
#pragma unroll
            for (int st = 0; st < 4; ++st) {
                const LAS float* as_ = arr + r * 128 + st * 32 + 4 * h;
                f32x16 gm;
                if (st < lt) {
                    const float rf = __expf(fminf(af_l - arr[(0 * 4 + r) * 128 + st * 32 + 31], 0.f));
#pragma unroll
                    for (int q = 0; q < 4; ++q) { const f32x4 cfv = *(const LAS f32x4*)(as_ + 4 * 512 + 8 * q);
#pragma unroll
                        for (int e = 0; e < 4; ++e) gm[4 * q + e] = cbt[st][4 * q + e] * (rf * cfv[e]); }
                } else if (st > lt) {
                    const float rf = __expf(fminf(ab_l - arr[(1 * 4 + r) * 128 + st * 32], 0.f));
#pragma unroll
                    for (int q = 0; q < 4; ++q) { const f32x4 cfv = *(const LAS f32x4*)(as_ + 5 * 512 + 8 * q);
#pragma unroll
                        for (int e = 0; e < 4; ++e) gm[4 * q + e] = cbt[st][4 * q + e] * (rf * cfv[e]); }
                } else {
                    int dq = r32 - 4 * h; asm volatile("" : "+v"(dq));
#pragma unroll
                    for (int i = 0; i < 16; ++i) { const int so = (i & 3) + 8 * (i >> 2);
                        const float ef = __expf(fminf(af_l - as_[so], 0.f)) * as_[2 * 512 + so];
                        const float eb = __expf(fminf(ab_l - as_[1 * 512 + so], 0.f)) * as_[3 * 512 + so];
                        gm[i] = cbt[st][i] * ((dq >= so ? ef : 0.f) + (dq <= so ? eb : 0.f)); }
                }
#pragma unroll
                for (int k2 = 0; k2 < 2; ++k2) {
                    const ldsp xa = ximg + (st * 32 + 16 * k2 + 4 * h + qq) * 576 + (r * 64 + pt * 32 + 16 * blk) * 2 + 8 * pp;
                    yd = MFMA32(cat8(lds_tr(xa), lds_tr(xa + 8 * 576)), pack8(gm, k2), yd);
                }
            }
            f32x16 tf, tb;
#pragma unroll
            for (int i = 0; i < 16; ++i) { tf[i] = 0.f; tb[i] = 0.f; }
#pragma unroll
            for (int ks = 0; ks < 8; ++ks) tf = MFMA32(hfv[ks], lds_ld128(cfp + 32 * ks), tf);
#pragma unroll
            for (int ks = 0; ks < 8; ++ks) tb = MFMA32(*(const bf16x8*)(hb + 16 * ks), lds_ld128(cfp + 32 * ks), tb);
            const float ef_l = __expf(af_l), eb_l = __expf(ab_l), Dh = F.p.in[I_ED][head];
            LAS float* ystg = (LAS float*)Bimg;
#pragma unroll
            for (int q4 = 0; q4 < 4; ++q4) {
                const int p0 = pt * 32 + 8 * q4 + 4 * h;
                const u32x2 xv = *(const LAS u32x2*)(ximg + l * 576 + (r * 64 + p0) * 2);
                f32x4 yv;
                yv[0] = yd[4 * q4 + 0] + tf[4 * q4 + 0] * ef_l + tb[4 * q4 + 0] * eb_l + Dh * lo_f(xv.x);
                yv[1] = yd[4 * q4 + 1] + tf[4 * q4 + 1] * ef_l + tb[4 * q4 + 1] * eb_l + Dh * hi_f(xv.x);
                yv[2] = yd[4 * q4 + 2] + tf[4 * q4 + 2] * ef_l + tb[4 * q4 + 2] * eb_l + Dh * lo_f(xv.y);
                yv[3] = yd[4 * q4 + 3] + tf[4 * q4 + 3] * ef_l + tb[4 * q4 + 3] * eb_l + Dh * hi_f(xv.y);
                *(LAS f32x4*)(ystg + l * 68 + p0) = yv;
            }
            __syncthreads();
            {
                const int row = F.tid >> 2, c16 = (F.tid & 3) * 16; const size_t rg = (size_t)(rbase + row);
                const u32x4 z0 = *(const u32x4*)(zab + rg * 2048 + head * 64 + c16), z1 = *(const u32x4*)(zab + rg * 2048 + head * 64 + c16 + 8);
                const unsigned zz[8] = {z0.x, z0.y, z0.z, z0.w, z1.x, z1.y, z1.z, z1.w};
                float ss = 0.f; unsigned ow[8];
#pragma unroll
                for (int q = 0; q < 4; ++q) { const f32x4 yv = *(const LAS f32x4*)(ystg + row * 68 + c16 + 4 * q); const f32x4 gn = *(const f32x4*)(F.p.in[I_ENORMG] + head * 64 + c16 + 4 * q);
                    const float v0 = yv[0] * silu_f(lo_f(zz[2 * q])), v1 = yv[1] * silu_f(hi_f(zz[2 * q])), v2 = yv[2] * silu_f(lo_f(zz[2 * q + 1])), v3 = yv[3] * silu_f(hi_f(zz[2 * q + 1]));
                    ss += (v0 * v0 + v1 * v1) + (v2 * v2 + v3 * v3);
                    ow[2 * q] = pk2(v0 * gn.x, v1 * gn.y); ow[2 * q + 1] = pk2(v2 * gn.z, v3 * gn.w); }
                *(u32x4*)(aout + rg * 2048 + head * 64 + c16) = (u32x4){ow[0], ow[1], ow[2], ow[3]}; *(u32x4*)(aout + rg * 2048 + head * 64 + c16 + 8) = (u32x4){ow[4], ow[5], ow[6], ow[7]};
                ss += shfl_idx(ss, F.lane ^ 1); ss += shfl_idx(ss, F.lane ^ 2);
                if ((F.tid & 3) == 0 && !F.probe) atomicAdd((float*)(F.ws + WS_SSY) + rg, ss);
            }
            __syncthreads();
        }
        __syncthreads();
    }
}
DI void phase_cachecopy(Frame& F) {
    const bf16_t* u1 = (const bf16_t*)(F.ws + WS_U);
    const int gt = F.bid * NTHREADS + F.tid, NT = F.G * NTHREADS;
    for (int it = gt; it < R_CTX * 320; it += NT) {
        const int row = it / 320, ch = it - row * 320, b = row >> 8, t = row & 255;
        int col; float* o;
        if (ch < 128) { col = 1024 + ch * 8; o = F.out + OUT_DIFF_K + ((size_t)(b * 8 + (ch >> 4)) * 256 + t) * 128 + (ch & 15) * 8; }
        else if (ch < 256) { const int c2 = ch - 128; col = 2048 + c2 * 8; o = F.out + OUT_DIFF_V + ((size_t)(b * 8 + (c2 >> 4)) * 256 + t) * 128 + (c2 & 15) * 8; }
        else if (ch < 288) { const int c2 = ch - 256; col = 5120 + c2 * 8; o = F.out + OUT_WIN_K + ((size_t)(b * 4 + (c2 >> 3)) * 256 + t) * 64 + (c2 & 7) * 8; }
        else { const int c2 = ch - 288; col = 5376 + c2 * 8; o = F.out + OUT_WIN_V + ((size_t)(b * 4 + (c2 >> 3)) * 256 + t) * 64 + (c2 & 7) * 8; }
        const u32x4 v = *(const u32x4*)(u1 + (size_t)row * N_O + col);
        *(f32x4*)o = (f32x4){lo_f(v.x), hi_f(v.x), lo_f(v.y), hi_f(v.y)}; *(f32x4*)(o + 4) = (f32x4){lo_f(v.z), hi_f(v.z), lo_f(v.w), hi_f(v.w)};
    }
}

struct AttnSeg { unsigned k, v; int ldk, ldv, nt; };
struct AttnEpi { unsigned aout, z; float lam, oml; };

#ifndef ATT_LEAD
#define ATT_LEAD(w) ((w) < 4)
#endif
#ifndef ATT_PRIO
#define ATT_PRIO 0
#endif
constexpr float ATT_THR = 8.f;
#ifndef ATT_ROT
#define ATT_ROT(qb) ((2 * (qb)) % 72)
#endif
#ifndef ATT_LA
#define ATT_LA 4
#endif
#ifndef ATT_VD
#define ATT_VD 1
#endif
DI void glds16(const void* gsrc, unsigned lds_dst) { unsigned keep;
    asm volatile("s_mov_b32 %0, m0\n\ts_mov_b32 m0, %2\n\ts_nop 0\n\tglobal_load_lds_dwordx4 %1, off\n\ts_mov_b32 m0, %0" : "=&s"(keep) : "v"(gsrc), "s"(lds_dst) : "memory"); }
template <int DV, bool WIN> DI void attn_epilogue(Frame& F, f32x16 (&O)[DV / 32], float lsum, float m, float sink_l2, const AttnEpi E);
template <int DV, int KSLOTS, bool WIN, int PM = 0, bool QPRE = false>
DI void attn_unit(Frame& F, const unsigned qoff, const AttnSeg s0, const AttnSeg s1, int qpos0, int kpos1, bool maskwin, float sink_l2, const AttnEpi E, const int rot, u32x4 (&qpre)[4], const unsigned qnext, const bool more) {
    constexpr int LA = ATT_LA, KR = LA, VR = LA + 1;
    constexpr int KIMG = 8192, KSTAGE = KSLOTS * KIMG, VROW = DV * 2, VSTAGE = 64 * VROW, VBASE = KR * KSTAGE, NDV = DV / 32;
    static_assert(VBASE + VR * VSTAGE <= LDS_BYTES - 8192, "attention rings exceed LDS");
    constexpr int VD = ATT_VD;
    constexpr int VP = VSTAGE / 8192, OPS = KSLOTS + VP;
    int lane; asm volatile("v_mbcnt_lo_u32_b32 %0, -1, 0\n\tv_mbcnt_hi_u32_b32 %0, -1, %0" : "=v"(lane));
    const int wave = F.wave, slot = wave & 1, qb = wave >> 1;
    const int h = lane >> 5, r32 = lane & 31, i16 = lane & 15, qq = i16 >> 2, pp = i16 & 3, blk = (lane >> 4) & 1;
    const int NT = PM == 7 ? (s0.nt + s1.nt) / 2 : s0.nt + s1.nt;
    const unsigned lds0 = (unsigned)(uintptr_t)F.lds;
    const int dk_row = 8 * wave + (lane >> 3), dk_col = (((lane & 7) ^ ((dk_row >> 1) & 7)) * 8);
    const int dv_row = DV == 128 ? 4 * wave + (lane >> 4) : 8 * wave + (lane >> 3);
    const int dv_col = DV == 128 ? (((((lane & 15) >> 2) ^ (dv_row & 3)) * 32) + (lane & 3) * 8) : (((((lane & 7) >> 2) ^ ((dv_row >> 1) & 1)) * 32) + (lane & 3) * 8);
#define ATT_DMA(tt0, ks_, vs_) do { int tr_ = (tt0) + rot; tr_ = tr_ >= NT ? tr_ - NT : tr_; if (PM == 8) tr_ &= 7; const bool in0 = tr_ < s0.nt; const int ldk_ = in0 ? s0.ldk : s1.ldk, ldv_ = in0 ? s0.ldv : s1.ldv; const int tl = in0 ? tr_ : tr_ - s0.nt; \
        const char* kb_ = (const char*)F.ws + (in0 ? s0.k : s1.k) + (size_t)tl * 128 * ldk_; const char* vb_ = (const char*)F.ws + (in0 ? s0.v : s1.v) + (size_t)tl * 128 * ldv_; \
        const unsigned ko_ = (unsigned)(dk_row * ldk_ + dk_col) * 2u; \
        _Pragma("unroll") for (int s_ = 0; s_ < KSLOTS; ++s_) glds16(kb_ + ko_ + s_ * 128, (unsigned)__builtin_amdgcn_readfirstlane((int)(lds0 + (ks_) * KSTAGE + s_ * KIMG + wave * 1024))); \
        const unsigned vo_ = (unsigned)(dv_row * ldv_ + dv_col) * 2u; \
        _Pragma("unroll") for (int j_ = 0; j_ < VP; ++j_) glds16(vb_ + (size_t)j_ * 64 * ldv_ + vo_, (unsigned)__builtin_amdgcn_readfirstlane((int)(lds0 + VBASE + (vs_) * VSTAGE + (wave + 8 * j_) * 1024))); } while (0)
#define ATT_VMWAIT(n) do { if ((n) == 8) asm volatile("s_waitcnt vmcnt(8)" ::: "memory"); else if ((n) == 6) asm volatile("s_waitcnt vmcnt(6)" ::: "memory"); else if ((n) == 4) asm volatile("s_waitcnt vmcnt(4)" ::: "memory"); else if ((n) == 3) asm volatile("s_waitcnt vmcnt(3)" ::: "memory"); else if ((n) == 2) asm volatile("s_waitcnt vmcnt(2)" ::: "memory"); else if ((n) == 1) asm volatile("s_waitcnt vmcnt(1)" ::: "memory"); else { static_assert(true, ""); asm volatile("s_waitcnt vmcnt(0)" ::: "memory"); } } while (0)
    int kro[4];
#pragma unroll
    for (int d0 = 0; d0 < 4; ++d0) kro[d0] = r32 * 128 + ((((2 * d0 + h) ^ ((r32 >> 1) & 7))) << 4);
    int vro[NDV];
#pragma unroll
    for (int d = 0; d < NDV; ++d) vro[d] = (4 * h + qq) * VROW + ((d ^ (DV == 128 ? qq : (qq >> 1))) * 64) + blk * 32 + pp * 8;
#define ATT_QK(P0, P1, ks_) do { const ldsp kimg_ = F.lds + (ks_) * KSTAGE + (KSLOTS == 2 ? slot * KIMG : 0); bf16x8 kf_[8]; \
        _Pragma("unroll") for (int d0 = 0; d0 < 4; ++d0) { kf_[2 * d0] = lds_ld128(kimg_ + kro[d0]); kf_[2 * d0 + 1] = lds_ld128(kimg_ + kro[d0] + 4096); } \
        __builtin_amdgcn_sched_barrier(0); \
        P0 = MFMA32(kf_[0], qv[0], negm); P1 = MFMA32(kf_[1], qv[0], negm); \
        _Pragma("unroll") for (int d0 = 1; d0 < 4; ++d0) { P0 = MFMA32(kf_[2 * d0], qv[d0], P0); P1 = MFMA32(kf_[2 * d0 + 1], qv[d0], P1); } \
        __builtin_amdgcn_sched_barrier(0); } while (0)
#pragma unroll
    for (int t = 0; t < LA; ++t) ATT_DMA(t, t, t);
    bf16x8 qv[4];
    { const bf16_t* qp = (const bf16_t*)(F.ws + qoff) + (size_t)(qb * 32 + r32) * N_O + slot * 64 + 8 * h;
#pragma unroll
      for (int d0 = 0; d0 < 4; ++d0) { const u32x4 v = QPRE ? qpre[d0] : *(const u32x4*)(qp + 16 * d0); u32x4 o;
          o.x = pk2(lo_f(v.x) * C2, hi_f(v.x) * C2); o.y = pk2(lo_f(v.y) * C2, hi_f(v.y) * C2); o.z = pk2(lo_f(v.z) * C2, hi_f(v.z) * C2); o.w = pk2(lo_f(v.w) * C2, hi_f(v.w) * C2);
          qv[d0] = __builtin_bit_cast(bf16x8, o); } }
    ATT_VMWAIT((LA - 2) * OPS);
    bar_lds();
    f32x16 O[NDV];
#pragma unroll
    for (int d = 0; d < NDV; ++d)
#pragma unroll
        for (int i = 0; i < 16; ++i) O[d][i] = 0.f;
    float m = 0.f, lsum = 0.f;
    f32x16 negm;
#pragma unroll
    for (int i = 0; i < 16; ++i) negm[i] = 0.f;
    const int qpos = qpos0 + qb * 32 + r32;
    f32x16 pC0, pC1;
    ATT_QK(pC0, pC1, 0);
    {
        float rm = fmaxf(pC0[0], pC1[0]);
#pragma unroll
        for (int i = 1; i < 16; ++i) asm("v_max3_f32 %0, %0, %1, %2" : "+v"(rm) : "v"(pC0[i]), "v"(pC1[i]));
        { auto rr = __builtin_amdgcn_permlane32_swap(__float_as_uint(rm), __float_as_uint(rm), false, false); rm = fmaxf(__uint_as_float(rr[0]), __uint_as_float(rr[1])); }
        m = rm;
#pragma unroll
        for (int i = 0; i < 16; ++i) { pC0[i] = __builtin_amdgcn_exp2f(pC0[i] - rm); pC1[i] = __builtin_amdgcn_exp2f(pC1[i] - rm); negm[i] = -rm; }
    }
    bar_lds();
    int ks1 = 1 % KR, ksI = 0, vs0 = 0, vsI = LA % VR;
    for (int tt = 0; tt < NT; ++tt) {
        f32x16 pN0, pN1;
        u32x4 w[4];
        {
            const ldsp kimg_ = F.lds + ks1 * KSTAGE + (KSLOTS == 2 ? slot * KIMG : 0);
#define ATT_KF(j) lds_ld128(kimg_ + kro[(j) >> 1] + ((j) & 1) * 4096)
            bf16x8 kf[8];
            kf[0] = ATT_KF(0); kf[1] = ATT_KF(1); kf[2] = ATT_KF(2);
            if (PM < 5 && tt + LA < NT) ATT_DMA(tt + LA, ksI, vsI);
            asm volatile("" : "+v"(pC0), "+v"(pC1));
            __builtin_amdgcn_sched_barrier(0);
            float ps = 0.f;
#pragma unroll
            for (int j = 0; j < 8; ++j) {
                if (j + 3 < 8) kf[j + 3] = ATT_KF(j + 3);
                if (j & 1) pN1 = MFMA32(kf[j], qv[j >> 1], j < 2 ? negm : pN1); else pN0 = MFMA32(kf[j], qv[j >> 1], j < 2 ? negm : pN0);
                if (PM < 4) { ps += (pC0[2 * j] + pC0[2 * j + 1]) + (pC1[2 * j] + pC1[2 * j + 1]);
                w[j >> 2][j & 3] = pk2(pC0[2 * j], pC0[2 * j + 1]); w[2 + (j >> 2)][j & 3] = pk2(pC1[2 * j], pC1[2 * j + 1]); }
                else if (j == 0) { w[0] = __builtin_bit_cast(u32x4, (f32x4){pC0[0], pC0[1], pC0[2], pC0[3]}); w[1] = __builtin_bit_cast(u32x4, (f32x4){pC0[4], pC0[5], pC0[6], pC0[7]}); w[2] = __builtin_bit_cast(u32x4, (f32x4){pC1[0], pC1[1], pC1[2], pC1[3]}); w[3] = __builtin_bit_cast(u32x4, (f32x4){pC1[4], pC1[5], pC1[6], pC1[7]}); }
            }
#pragma unroll
            for (int j = 0; j < 8; ++j) { __builtin_amdgcn_sched_group_barrier(0x008, 1, 0); __builtin_amdgcn_sched_group_barrier(0x100, 1, 0); if (PM < 4) __builtin_amdgcn_sched_group_barrier(0x002, 6, 0); }
            asm volatile("" : "+v"(ps), "+v"(w[0]), "+v"(w[1]), "+v"(w[2]), "+v"(w[3]));
            __builtin_amdgcn_sched_barrier(0);
            lsum += ps;
#undef ATT_KF
        }
        const ldsp vb = F.lds + VBASE + vs0 * VSTAGE;
        bf16x8 vf[4][NDV];
#define ATT_VF(k4_, d_) (PM == 1 ? lds_ld128(vb + ((d_) * 32 + r32) * 128 + (((2 * (k4_) + h) ^ ((r32 >> 1) & 7)) << 4)) : cat8(lds_tr(vb + vro[d_] + (k4_) * 16 * VROW), lds_tr(vb + vro[d_] + (k4_) * 16 * VROW + 8 * VROW)))
#pragma unroll
        for (int k4 = 0; k4 < VD; ++k4)
#pragma unroll
            for (int d = 0; d < NDV; ++d) vf[k4][d] = ATT_VF(k4, d);
        bf16x8 pk[4];
        pk[0] = __builtin_bit_cast(bf16x8, w[0]); pk[1] = __builtin_bit_cast(bf16x8, w[1]); pk[2] = __builtin_bit_cast(bf16x8, w[2]); pk[3] = __builtin_bit_cast(bf16x8, w[3]);
        float fsc = 1.f; bool resc = false;
        if (PM < 4 && tt + 1 < NT) {
            if (WIN && maskwin && tt + 1 >= s0.nt) {
                const int kb = kpos1 + (tt + 1 - s0.nt) * 64, qlo = qpos0 + qb * 32;
                if (qlo + 31 - kb > 128 || kb + 63 - qlo > 128) {
                    const int base = kb - qpos + 128 + 4 * h;
#pragma unroll
                    for (int i = 0; i < 16; ++i) { const int ci = (i & 3) + 8 * (i >> 2);
                        if ((unsigned)(base + ci) > 256u) pN0[i] = -INFINITY;
                        if ((unsigned)(base + ci + 32) > 256u) pN1[i] = -INFINITY; }
                }
            }
            float rm = fmaxf(pN0[0], pN1[0]), rm1, rm2, rm3;
            asm volatile("v_max_f32 %0, %1, %2" : "=v"(rm1) : "v"(pN0[1]), "v"(pN1[1]));
            asm volatile("v_max_f32 %0, %1, %2" : "=v"(rm2) : "v"(pN0[2]), "v"(pN1[2]));
            asm volatile("v_max_f32 %0, %1, %2" : "=v"(rm3) : "v"(pN0[3]), "v"(pN1[3]));
#pragma unroll
            for (int i = 4; i < 16; i += 4) {
                asm volatile("v_max3_f32 %0, %0, %1, %2" : "+v"(rm) : "v"(pN0[i]), "v"(pN1[i])); asm volatile("v_max3_f32 %0, %0, %1, %2" : "+v"(rm1) : "v"(pN0[i + 1]), "v"(pN1[i + 1]));
                asm volatile("v_max3_f32 %0, %0, %1, %2" : "+v"(rm2) : "v"(pN0[i + 2]), "v"(pN1[i + 2])); asm volatile("v_max3_f32 %0, %0, %1, %2" : "+v"(rm3) : "v"(pN0[i + 3]), "v"(pN1[i + 3])); }
            asm volatile("v_max_f32 %0, %0, %1" : "+v"(rm2) : "v"(rm3));
            asm volatile("v_max3_f32 %0, %0, %1, %2" : "+v"(rm) : "v"(rm1), "v"(rm2));
            { auto rr = __builtin_amdgcn_permlane32_swap(__float_as_uint(rm), __float_as_uint(rm), false, false); rm = fmaxf(__uint_as_float(rr[0]), __uint_as_float(rr[1])); }
            const float delta = rm > ATT_THR ? rm : 0.f;
            if (__any(delta != 0.f)) {
                resc = true; m += delta; fsc = __builtin_amdgcn_exp2f(-delta);
#pragma unroll
                for (int i = 0; i < 16; ++i) { pN0[i] -= delta; pN1[i] -= delta; negm[i] = -m; }
            }
        }
        {
            asm volatile("" : "+v"(pN0), "+v"(pN1));
            __builtin_amdgcn_sched_barrier(0);
            constexpr int EPG = 32 / (NDV * 4);
#pragma unroll
            for (int k4 = 0; k4 < 4; ++k4) {
#pragma unroll
                for (int d = 0; d < NDV; ++d) {
                    if (k4 + VD < 4) vf[k4 + VD][d] = ATT_VF(k4 + VD, d);
                    O[d] = MFMA32(vf[k4][d], pk[k4], O[d]);
#pragma unroll
                    for (int e = 0; e < EPG; ++e) { const int idx = (k4 * NDV + d) * EPG + e;
                        if (PM >= 4) continue; if (idx < 16) pN0[idx] = __builtin_amdgcn_exp2f(pN0[idx]); else pN1[idx - 16] = __builtin_amdgcn_exp2f(pN1[idx - 16]); }
                }
            }
#pragma unroll
            for (int g = 0; g < NDV * 4; ++g) { __builtin_amdgcn_sched_group_barrier(0x008, 1, 0); if (g < NDV * (4 - VD)) __builtin_amdgcn_sched_group_barrier(0x100, PM == 1 ? 1 : 2, 0); if (PM < 4) __builtin_amdgcn_sched_group_barrier(0x400, EPG, 0); }
            asm volatile("" : "+v"(pN0), "+v"(pN1));
            __builtin_amdgcn_sched_barrier(0);
        }
        if (resc) {
            lsum *= fsc;
#pragma unroll
            for (int d = 0; d < NDV; ++d)
#pragma unroll
                for (int i = 0; i < 16; ++i) O[d][i] *= fsc;
        }
        pC0 = pN0; pC1 = pN1;
        ks1 = ks1 == KR - 1 ? 0 : ks1 + 1; ksI = ksI == KR - 1 ? 0 : ksI + 1; vs0 = vs0 == VR - 1 ? 0 : vs0 + 1; vsI = vsI == VR - 1 ? 0 : vsI + 1;
        if (PM >= 5) ATT_VMWAIT(0); else if (LA == 4 && tt + 4 < NT) ATT_VMWAIT(2 * OPS); else if (tt + 3 < NT) ATT_VMWAIT(OPS); else ATT_VMWAIT(0);
        if (PM != 6) bar_lds();
    }
#undef ATT_DMA
#undef ATT_VMWAIT
#undef ATT_QK
#undef ATT_VF
    if (QPRE && more) { const bf16_t* qn = (const bf16_t*)(F.ws + qnext) + (size_t)(qb * 32 + r32) * N_O + slot * 64 + 8 * h;
#pragma unroll
        for (int d0 = 0; d0 < 4; ++d0) qpre[d0] = *(const u32x4*)(qn + 16 * d0); }
    attn_epilogue<DV, WIN>(F, O, lsum, m, sink_l2, E);
}
template <int DV, bool WIN>
DI void attn_epilogue(Frame& F, f32x16 (&O)[DV / 32], float lsum, float m, float sink_l2, const AttnEpi E) {
    constexpr int NDV = DV / 32;
    int lane; asm volatile("v_mbcnt_lo_u32_b32 %0, -1, 0\n\tv_mbcnt_hi_u32_b32 %0, -1, %0" : "=v"(lane));
    const int wave = F.wave, tid = wave * 64 + lane, slot = wave & 1, qb = wave >> 1, h = lane >> 5, r32 = lane & 31;
    { auto rr = __builtin_amdgcn_permlane32_swap(__float_as_uint(lsum), __float_as_uint(lsum), false, false); lsum = __uint_as_float(rr[0]) + __uint_as_float(rr[1]); }
    if (WIN) lsum += __builtin_amdgcn_exp2f(sink_l2 - m);
    const float inv = 1.f / lsum;
    u32x4 zpre[4];
#pragma unroll
    for (int k = 0; k < 4; ++k) { const int it = tid + 512 * k, q = it >> 4, cc = it & 15; zpre[k] = *(const u32x4*)((const bf16_t*)(F.ws + E.z) + (size_t)q * N_O + cc * 8); }
    LAS float* Y = (LAS float*)F.lds;
    if (!WIN) {
        LAS float* X = (LAS float*)(F.lds + 67584) + qb * 4096;
        if (slot == 1) {
            const float sc = inv * E.lam;
#pragma unroll
            for (int d = 0; d < NDV; ++d)
#pragma unroll
                for (int i = 0; i < 16; ++i) X[(d * 32 + crow(i, h)) * 32 + r32] = O[d][i] * sc;
        }
        bar_lds();
        if (slot == 0) {
            float ss = 0.f;
#pragma unroll
            for (int d = 0; d < NDV; ++d)
#pragma unroll
                for (int i = 0; i < 16; ++i) { const float v = O[d][i] * inv - X[(d * 32 + crow(i, h)) * 32 + r32]; O[d][i] = v; ss += v * v; }
            { auto rr = __builtin_amdgcn_permlane32_swap(__float_as_uint(ss), __float_as_uint(ss), false, false); ss = __uint_as_float(rr[0]) + __uint_as_float(rr[1]); }
            const float rstd = rsqrtf(ss * (1.f / 128.f) + EPS) * E.oml;
#pragma unroll
            for (int d = 0; d < NDV; ++d)
#pragma unroll
                for (int q4 = 0; q4 < 4; ++q4)
                    *(LAS f32x4*)(Y + (qb * 32 + r32) * 132 + d * 32 + 8 * q4 + 4 * h) = (f32x4){O[d][4 * q4] * rstd, O[d][4 * q4 + 1] * rstd, O[d][4 * q4 + 2] * rstd, O[d][4 * q4 + 3] * rstd};
        }
        bar_lds();
    } else {
#pragma unroll
        for (int d = 0; d < NDV; ++d)
#pragma unroll
            for (int q4 = 0; q4 < 4; ++q4)
                *(LAS f32x4*)(Y + (qb * 32 + r32) * 132 + slot * 64 + d * 32 + 8 * q4 + 4 * h) = (f32x4){O[d][4 * q4] * inv, O[d][4 * q4 + 1] * inv, O[d][4 * q4 + 2] * inv, O[d][4 * q4 + 3] * inv};
        bar_lds();
    }
#pragma unroll
    for (int k = 0; k < 4; ++k) {
        const int it = tid + 512 * k, q = it >> 4, cc = it & 15;
        const f32x4 y0 = *(const LAS f32x4*)(Y + q * 132 + cc * 8), y1 = *(const LAS f32x4*)(Y + q * 132 + cc * 8 + 4);
        f32x4 g0 = {1.f, 1.f, 1.f, 1.f}, g1 = g0;
        if (!WIN) { g0 = *(const f32x4*)(F.p.in[I_OSUBG] + cc * 8); g1 = *(const f32x4*)(F.p.in[I_OSUBG] + cc * 8 + 4); }
        const u32x4 z = zpre[k];
        u32x4 o; o.x = pk2(y0.x * g0.x * silu_f(lo_f(z.x)), y0.y * g0.y * silu_f(hi_f(z.x))); o.y = pk2(y0.z * g0.z * silu_f(lo_f(z.y)), y0.w * g0.w * silu_f(hi_f(z.y)));
        o.z = pk2(y1.x * g1.x * silu_f(lo_f(z.z)), y1.y * g1.y * silu_f(hi_f(z.z))); o.w = pk2(y1.z * g1.z * silu_f(lo_f(z.w)), y1.w * g1.w * silu_f(hi_f(z.w)));
        *(u32x4*)((bf16_t*)(F.ws + E.aout) + (size_t)q * 2048 + cc * 8) = o;
    }
    bar_lds();
}

template <int PM = 0, int ONLY = 0>
DI void phase_attn(Frame& F, int grp) {
    const float lam = ((const float*)(F.ws + WS_LAM))[0], oml = ((const float*)(F.ws + WS_LAM))[1];
    const unsigned lat0 = grp == 0 ? R_CTX : 0;
    constexpr unsigned UB = (unsigned)WS_U, AB = (unsigned)WS_AOUT;
    const int NU = 1024 + (grp == 0 ? 256 : 0);
    u32x4 qpre[4];
    const size_t qlane = (size_t)((F.wave >> 1) * 32 + (F.lane & 31)) * N_O + (F.wave & 1) * 64 + 8 * (F.lane >> 5);
    if (ONLY == 0 || ONLY == 1) {
    auto qoff_c = [&](int u) { if (u < 1024) { const int x = u & 7, qb = (u >> 3) & 31, bh = (u >> 8) * 8 + x, bl = bh >> 3, hh = bh & 7; return UB + ((lat0 + bl * 4096 + qb * 128) * N_O + hh * 128) * 2; }
                               const int c = u - 1024, b = c >> 4, hh = (c >> 1) & 7, qb = c & 1; return UB + ((unsigned)(b * 256 + qb * 128) * N_O + hh * 128) * 2; };
    if (F.bid < NU) { const bf16_t* qn = (const bf16_t*)(F.ws + qoff_c(F.bid)) + qlane;
#pragma unroll
        for (int d0 = 0; d0 < 4; ++d0) qpre[d0] = *(const u32x4*)(qn + 16 * d0); }
    for (int u = F.bid; u < NU; u += F.G) {
        AttnSeg s0, s1; AttnEpi E; unsigned q0; int rot;
        if (u < 1024) {
            const int x = u & 7, qb = (u >> 3) & 31, bh = (u >> 8) * 8 + x, bl = bh >> 3, hh = bh & 7, b = grp * 4 + bl;
            const unsigned ls = lat0 + bl * 4096; q0 = qb * 128;
            s0 = AttnSeg{(unsigned)WS_CK + (unsigned)(b * 8 + hh) * 512 * 128 * 2, (unsigned)WS_CV + (unsigned)(b * 8 + hh) * 512 * 128 * 2, 128, 128, 8};
            s1 = AttnSeg{(unsigned)WS_KC + (unsigned)(bl * 8 + hh) * 4096 * 128 * 2, (unsigned)WS_VC + (unsigned)(bl * 8 + hh) * 4096 * 128 * 2, 128, 128, 64};
            E = AttnEpi{AB + ((ls + q0) * 2048 + hh * 128) * 2, UB + ((ls + q0) * N_O + 3072 + hh * 128) * 2, lam, oml};
            rot = ATT_ROT(qb);
        } else {
            const int c = u - 1024, b = c >> 4, hh = (c >> 1) & 7, qb = c & 1; const unsigned ls = b * 256; q0 = qb * 128;
            s0 = AttnSeg{UB, UB, N_O, N_O, 0};
            s1 = AttnSeg{UB + (ls * N_O + 1024 + hh * 128) * 2, UB + (ls * N_O + 2048 + hh * 128) * 2, N_O, N_O, 4};
            E = AttnEpi{AB + ((ls + q0) * 2048 + hh * 128) * 2, UB + ((ls + q0) * N_O + 3072 + hh * 128) * 2, lam, oml};
            rot = 0;
        }
        const bool more = u + F.G < NU;
        attn_unit<128, 2, false, PM, true>(F, qoff_c(u), s0, s1, (int)q0, 0, false, 0.f, E, rot, qpre, more ? qoff_c(u + F.G) : 0u, more);
    } }
    if (ONLY == 0 || ONLY == 2) {
    auto qoff_w = [&](int u) { if (u < 1024) { const int x = u & 7, qb = (u >> 3) & 31, combo = (u >> 8) * 8 + x, bl = combo >> 3, kv = (combo >> 1) & 3, gp = combo & 1; return UB + ((lat0 + bl * 4096 + qb * 128) * N_O + 4096 + (kv * 4 + 2 * gp) * 64) * 2; }
                               const int c = u - 1024, b = c >> 4, kv = (c >> 2) & 3, gp = (c >> 1) & 1, qb = c & 1; return UB + ((unsigned)(b * 256 + qb * 128) * N_O + 4096 + (kv * 4 + 2 * gp) * 64) * 2; };
    if (F.bid < NU) { const bf16_t* qn = (const bf16_t*)(F.ws + qoff_w(F.bid)) + qlane;
#pragma unroll
        for (int d0 = 0; d0 < 4; ++d0) qpre[d0] = *(const u32x4*)(qn + 16 * d0); }
    for (int u = F.bid; u < NU; u += F.G) {
        AttnSeg s0, s1; AttnEpi E; int q0, ks, hd0; bool mw;
        if (u < 1024) {
            const int x = u & 7, qb = (u >> 3) & 31, combo = (u >> 8) * 8 + x, bl = combo >> 3, kv = (combo >> 1) & 3, gp = combo & 1, b = grp * 4 + bl;
            const unsigned ls = lat0 + bl * 4096; q0 = qb * 128; hd0 = kv * 4 + 2 * gp;
            ks = max(0, q0 - 128); const int ke = min(4096, q0 + 256);
            s0 = AttnSeg{(unsigned)WS_WK + (unsigned)(b * 4 + kv) * 512 * 64 * 2, (unsigned)WS_WV + (unsigned)(b * 4 + kv) * 512 * 64 * 2, 64, 64, 8};
            s1 = AttnSeg{(unsigned)WS_KD + (unsigned)((bl * 4 + kv) * 4096 + ks) * 64 * 2, (unsigned)WS_VD + (unsigned)((bl * 4 + kv) * 4096 + ks) * 64 * 2, 64, 64, (ke - ks) >> 6};
            E = AttnEpi{AB + ((ls + q0) * 2048 + 1024 + hd0 * 64) * 2, UB + ((ls + q0) * N_O + 5632 + hd0 * 64) * 2, 0.f, 0.f};
            mw = true;
        } else {
            const int c = u - 1024, b = c >> 4, kv = (c >> 2) & 3, gp = (c >> 1) & 1, qb = c & 1; const unsigned ls = b * 256; q0 = qb * 128; hd0 = kv * 4 + 2 * gp; ks = 0;
            s0 = AttnSeg{UB, UB, N_O, N_O, 0};
            s1 = AttnSeg{UB + (ls * N_O + 5120 + kv * 64) * 2, UB + (ls * N_O + 5376 + kv * 64) * 2, N_O, N_O, 4};
            E = AttnEpi{AB + ((ls + q0) * 2048 + 1024 + hd0 * 64) * 2, UB + ((ls + q0) * N_O + 5632 + hd0 * 64) * 2, 0.f, 0.f};
            mw = false;
        }
        const float sk = F.p.in[I_OSINK][hd0 + (F.wave & 1)] * LOG2E;
        const bool more = u + F.G < NU;
        attn_unit<64, 1, true, PM, true>(F, qoff_w(u), s0, s1, q0, ks, mw, sk, E, 0, qpre, more ? qoff_w(u + F.G) : 0u, more);
    } }
}

DI void phase_final(Frame& F, int grp) {
    const int row0 = GRP_ROW0[grp], rows = GRP_ROWS[grp];
    const int gw = F.bid * NWAVES + F.wave, NGW = F.G * NWAVES;
    const float* ng = F.p.in[I_FNORMG];
    const bf16_t* x2b = (const bf16_t*)(F.ws + WS_REGA);
    for (int rl = gw; rl < rows; rl += 2 * NGW) {
        f32x4 v[2][4]; float s[2];
#pragma unroll
        for (int q = 0; q < 2; ++q) { const u32x2* xr = (const u32x2*)(x2b + (size_t)min(rl + q * NGW, rows - 1) * DM) + F.lane;
#pragma unroll
            for (int j = 0; j < 4; ++j) { const u32x2 w = xr[64 * j]; v[q][j] = (f32x4){lo_f(w.x), hi_f(w.x), lo_f(w.y), hi_f(w.y)}; } }
#pragma unroll
        for (int q = 0; q < 2; ++q) { float t = 0.f;
#pragma unroll
            for (int j = 0; j < 4; ++j) t += (v[q][j].x * v[q][j].x + v[q][j].y * v[q][j].y) + (v[q][j].z * v[q][j].z + v[q][j].w * v[q][j].w);
            s[q] = t; }
#pragma unroll
        for (int o = 1; o < 64; o <<= 1) { s[0] += shfl_idx(s[0], F.lane ^ o); s[1] += shfl_idx(s[1], F.lane ^ o); }
#pragma unroll
        for (int q = 0; q < 2; ++q) { if (rl + q * NGW >= rows) continue;
            const float rstd = rsqrtf(s[q] * (1.f / DM) + EPS);
            f32x4* xr = (f32x4*)(F.out + OUT_X + (size_t)(row0 + rl + q * NGW) * DM) + F.lane;
#pragma unroll
            for (int j = 0; j < 4; ++j) { const f32x4 g = *((const f32x4*)ng + F.lane + 64 * j); xr[64 * j] = v[q][j] * rstd * g; } }
    }
}
#define RLX_AGENT __ATOMIC_RELAXED, __HIP_MEMORY_SCOPE_AGENT
#define XB_TMO      128
#define XB_XCNT(j)  (256  + 64 * (j))
#define XB_XSUB(j)  (1280 + 64 * (j))
#define XB_XGEN(j)  (2304 + 64 * (j))
#define XB_TOP      3328
#define XB_TOPGEN   3392
#define XCD_BAR_WORDS 3456
#define XB_SPIN_CAP (1u << 18)

__device__ __forceinline__ unsigned xb_ld(unsigned* p)              { return __hip_atomic_load(p, __ATOMIC_RELAXED, __HIP_MEMORY_SCOPE_AGENT); }
__device__ __forceinline__ unsigned xb_add(unsigned* p, unsigned v) { return __hip_atomic_fetch_add(p, v, __ATOMIC_RELAXED, __HIP_MEMORY_SCOPE_AGENT); }
__device__ __forceinline__ unsigned xb_xcc_id() { return (unsigned)__builtin_amdgcn_s_getreg((3 << 11) | 20) & 0xFu; }
#define XB_SPIN(cond, bar) do { unsigned _sp = 0; while (cond) { __builtin_amdgcn_s_sleep(1); \
    if ((++_sp & 255u) == 0u) { if (xb_ld(&(bar)[XB_TMO])) break; if (_sp > XB_SPIN_CAP) { atomicAdd(&(bar)[XB_TMO], 1u); break; } } } } while (0)

struct XcdBarrier {
    unsigned* bar; unsigned x;
    volatile LAS unsigned* st;
};

__device__ __forceinline__ XcdBarrier xcd_barrier_post(unsigned* bar, volatile LAS unsigned* st) {
    XcdBarrier b; b.bar = bar; b.x = xb_xcc_id(); b.st = st;
    if (threadIdx.x == 0) (void)xb_add(&bar[XB_XCNT(b.x)], 1u);
    return b;
}
__device__ __forceinline__ void xcd_barrier_complete(unsigned* bar, unsigned x, unsigned& nloc, unsigned& nx) {
    const unsigned G = gridDim.x * gridDim.y * gridDim.z;
    unsigned sum, cnt, mine, sp = 0u;
    for (;;) {
        sum = 0u; cnt = 0u; mine = 0u;
#pragma unroll
        for (unsigned j = 0; j < 16; ++j) { const unsigned c = xb_ld(&bar[XB_XCNT(j)]); sum += c; cnt += (c > 0u) ? 1u : 0u; mine = (j == x) ? c : mine; }
        if (sum == G) break;
        __builtin_amdgcn_s_sleep(1);
        if ((++sp & 255u) == 0u) { if (xb_ld(&bar[XB_TMO])) break; if (sp > XB_SPIN_CAP) { atomicAdd(&bar[XB_TMO], 1u); break; } }
    }
    nloc = mine > 0u ? mine : 1u; nx = cnt > 0u ? cnt : 1u;
}

__device__ __forceinline__ void xcd_barrier(const XcdBarrier& b) {
    asm volatile("s_waitcnt vmcnt(0)" ::: "memory");
    __syncthreads();
    if (threadIdx.x == 0) {
        unsigned* bar = b.bar;
        __builtin_amdgcn_s_waitcnt(0);
        unsigned nloc = b.st[0], nx = b.st[1];
        if (nloc == 0u) { xcd_barrier_complete(bar, b.x, nloc, nx); b.st[0] = nloc; b.st[1] = nx; }
        const unsigned old = xb_add(&bar[XB_XSUB(b.x)], 1u);
        const unsigned gen = old / nloc;
        if (old + 1u == (gen + 1u) * nloc) {
            __builtin_amdgcn_fence(__ATOMIC_RELEASE, "agent");
            asm volatile("s_waitcnt vmcnt(0)" ::: "memory");
            const unsigned og = xb_add(&bar[XB_TOP], 1u);
            const unsigned tg = og / nx;
            if (og + 1u == (tg + 1u) * nx) xb_add(&bar[XB_TOPGEN], 1u);
            else XB_SPIN(xb_ld(&bar[XB_TOPGEN]) == tg, bar);
            __builtin_amdgcn_fence(__ATOMIC_ACQUIRE, "agent");
            xb_add(&bar[XB_XGEN(b.x)], 1u);
            asm volatile("s_waitcnt vmcnt(0)" ::: "memory");
        } else {
            XB_SPIN(xb_ld(&bar[XB_XGEN(b.x)]) == gen, bar);
            __builtin_amdgcn_fence(__ATOMIC_ACQUIRE, "agent");
            asm volatile("s_waitcnt vmcnt(0)" ::: "memory");
        }
    }
    __syncthreads();
}

constexpr int NPHG = 13;
constexpr int NPH = 1 + 2 * NPHG;

DI Frame relaunder(const Frame& F0) {
    int ln; asm volatile("v_mbcnt_lo_u32_b32 %0, -1, 0\n\tv_mbcnt_hi_u32_b32 %0, -1, %0" : "=v"(ln));
    int b = F0.bid, G = F0.G, wv = F0.wave; size_t z0 = 0, z1 = 0; asm volatile("" : "+s"(b), "+s"(G), "+s"(z0), "+s"(z1), "+s"(wv));
    float* o = F0.p.out + z0; unsigned char* w = F0.p.ws + z1;
    return Frame{F0.lds, wv * 64 + ln, ln, wv, G, b, F0.p, o, w, F0.probe};
}
DI void run_phase(const Frame& F0, int ph) {
#ifndef PHMASK
#define PHMASK 0xFFFF
#endif
#define PHON(k) ((PHMASK >> (k)) & 1)
    if (ph == 0) { if (PHON(14)) { Frame F = relaunder(F0); phase_p0(F); } return; }
    const int grp = (ph - 1) / NPHG, k = (ph - 1) % NPHG;
    const int row0 = GRP_ROW0[grp], rows = GRP_ROWS[grp];
        switch (k) {
    case 0: if (PHON(0)) { Frame F = relaunder(F0); phase_modnorm(F, grp, 0); } break;
    case 1: if (PHON(1)) { Frame F = relaunder(F0); { pg8::Gemm g{(const bf16_t*)(F.ws + WS_REGA), (const bf16_t*)(F.ws + WS_WT_IN_E), rows, N_E, 1024, 1024, 0};
              pg8::StaticOrder S; S.init(rows, N_E, F.G, F.bid);
              epi::EpiE0 E{(bf16_t*)(F.out + OUT_X + (size_t)row0 * DM), (bf16_t*)(F.ws + WS_XBCRAW), (bf16_t*)(F.ws + WS_XB), (float*)(F.ws + WS_DTRAW)};
              pg8::gemm_phase<epi::EpiE0, pg8::StaticOrder, true, true>(F.lds, g, S, E, F.tid); } } break;
    case 2: if (PHON(2)) { Frame F = relaunder(F0); phase_conv(F, grp); } break;
    case 3: if (PHON(3)) { Frame F = relaunder(F0); phase_states(F, grp); } break;
    case 4: if (PHON(4)) { Frame F = relaunder(F0); phase_scan(F, grp); } break;
    case 5: if (PHON(5)) { Frame F = relaunder(F0); phase_y(F, grp); } break;
    case 6: if (PHON(6)) { Frame F = relaunder(F0); {
              pg8::Gemm g{(const bf16_t*)(F.ws + WS_POOLED), (const bf16_t*)(F.ws + WS_WT_POOL), rows, 1024, 256, 1024, 256};
              pg8::StaticOrder S; S.init(rows, 1024, F.G, F.bid);
              epi::EpiPool E{(bf16_t*)(F.ws + WS_AOUT), (const bf16_t*)(F.out + OUT_X + (size_t)row0 * DM), (const float*)(F.ws + WS_SSY)};
              pg8::gemm_phase<epi::EpiPool, pg8::StaticOrder, true, true>(F.lds, g, S, E, F.tid); } } break;
    case 7: if (PHON(7)) { Frame F = relaunder(F0); { pg8::Gemm g{(const bf16_t*)(F.ws + WS_AOUT), (const bf16_t*)(F.ws + WS_WT_OUT_E), rows, 1024, 2048, 2048, 0};
              pg8::StaticOrder S; S.init(rows, 1024, F.G, F.bid);
              epi::EpiRes<true> E{F.p.in[I_XP], F.p.in[I_XS], nullptr, (const float*)(F.ws + WS_MOD), row0, (const float*)(F.ws + WS_SSY), (bf16_t*)(F.ws + WS_X1B), nullptr};
              pg8::gemm_phase<epi::EpiRes<true>, pg8::StaticOrder, true, true>(F.lds, g, S, E, F.tid); } } break;
    case 8: if (PHON(8)) { Frame F = relaunder(F0); phase_modnorm(F, grp, 1); } break;
    case 9: if (PHON(9)) { Frame F = relaunder(F0); { pg8::Gemm g{(const bf16_t*)(F.ws + WS_REGA), (const bf16_t*)(F.ws + WS_WT_IN_O), rows, N_O, 1024, 1024, 0};
              pg8::StaticOrder S; S.init(rows, N_O, F.G, F.bid);
              epi::EpiO E{(bf16_t*)(F.ws + WS_U), (const float*)(F.ws + WS_ROPE), row0, (bf16_t*)(F.ws + WS_KC), (bf16_t*)(F.ws + WS_VC), (bf16_t*)(F.ws + WS_KD), (bf16_t*)(F.ws + WS_VD)};
              pg8::gemm_phase<epi::EpiO, pg8::StaticOrder, true, true>(F.lds, g, S, E, F.tid); } } break;
    case 10: if (PHON(10)) { Frame F = relaunder(F0); if (grp == 0) phase_cachecopy(F); phase_attn(F, grp); } break;
    case 11: if (PHON(11)) { Frame F = relaunder(F0); { pg8::Gemm g{(const bf16_t*)(F.ws + WS_AOUT), (const bf16_t*)(F.ws + WS_WT_OUT_O), rows, 1024, 2048, 2048, 0};
               pg8::StaticOrder S; S.init(rows, 1024, F.G, F.bid);
               epi::EpiRes<false> E{nullptr, nullptr, F.out + OUT_X, (const float*)(F.ws + WS_MOD) + 9 * 3072, row0, nullptr, (bf16_t*)(F.ws + WS_X1B), (bf16_t*)(F.ws + WS_REGA)};
               pg8::gemm_phase<epi::EpiRes<false>, pg8::StaticOrder, true, true>(F.lds, g, S, E, F.tid); } } break;
    default: if (PHON(12)) { Frame F = relaunder(F0); phase_final(F, grp); } break;
    }
}

__global__ void __launch_bounds__(NTHREADS, 2) mega_fwd(Params p) {
    extern __shared__ __attribute__((aligned(16))) unsigned char lds_raw[];
    cg::grid_group grid = cg::this_grid();
    const int wave_ = __builtin_amdgcn_readfirstlane((int)threadIdx.x >> 6);
    volatile LAS unsigned* bst = (volatile LAS unsigned*)((ldsp)lds_raw + LDS_BYTES - 256);
    if (threadIdx.x < 2) bst[threadIdx.x] = 0u;
    __syncthreads();
    XcdBarrier bar = xcd_barrier_post((unsigned*)(p.ws + WS_BAR), bst);
    for (int ph = p.ph_lo; ph < p.ph_hi; ++ph) {
        int lane_; asm volatile("v_mbcnt_lo_u32_b32 %0, -1, 0\n\tv_mbcnt_hi_u32_b32 %0, -1, %0" : "=v"(lane_));
        Frame F{(ldsp)lds_raw, wave_ * 64 + lane_, lane_, wave_, (int)gridDim.x, (int)blockIdx.x, p, p.out, p.ws, 0};
#ifdef ATT_PROBE
#ifndef ATT_PM
#define ATT_PM 0
#endif
        if (ph > 0 && (ph - 1) % NPHG == 10) { Frame Fp = relaunder(F); phase_attn<ATT_PM, ATT_PROBE>(Fp, (ph - 1) / NPHG); xcd_barrier(bar); }
#endif
#ifdef DUP_MASK
        if (ph > 0 && ((DUP_MASK >> ((ph - 1) % NPHG)) & 1)) { Frame Fp{F.lds, F.tid, F.lane, F.wave, F.G, F.bid, F.p, F.out, F.ws, 1}; run_phase(Fp, ph); xcd_barrier(bar); }
#endif
        run_phase(F, ph);
        if (ph + 1 < p.ph_hi) { if (ph == 0) grid.sync(); else xcd_barrier(bar); }
    }
}

#ifndef MK_MULTI
#define MK_MULTI 0
#endif
extern "C" void kernel_launch(void* const* d_in, const int* in_sizes, int n_in, void* d_out, int out_size, void* d_ws, size_t ws_size, hipStream_t stream) {
    static int grid = 0;
    if (grid == 0) {
        if (n_in != 28 || (size_t)out_size != OUT_END || ws_size < WS_END) { fprintf(stderr, "kernel_launch: unexpected sizes n_in %d out %d ws %zu\n", n_in, out_size, ws_size); grid = -1; return; }
        int dev = 0, cus = 0, per_cu = 0;
        hipGetDevice(&dev); hipDeviceGetAttribute(&cus, hipDeviceAttributeMultiprocessorCount, dev);
        if (hipFuncSetAttribute((const void*)mega_fwd, hipFuncAttributeMaxDynamicSharedMemorySize, LDS_BYTES) != hipSuccess) { fprintf(stderr, "kernel_launch: hipFuncSetAttribute failed\n"); grid = -1; return; }
        if (hipOccupancyMaxActiveBlocksPerMultiprocessor(&per_cu, (const void*)mega_fwd, NTHREADS, LDS_BYTES) != hipSuccess || per_cu < 1) { fprintf(stderr, "kernel_launch: occupancy query failed (%d)\n", per_cu); (void)hipGetLastError(); per_cu = 1; }
        grid = cus * (per_cu > 1 ? 1 : per_cu);
        if (grid > 256) grid = 256;
    }
    if (grid < 0) return;
    if (hipMemsetAsync((char*)d_ws + WS_BAR, 0, 16384, stream) != hipSuccess) { fprintf(stderr, "kernel_launch: memset failed\n"); return; }
    Params p{};
    for (int i = 0; i < 28; ++i) p.in[i] = (const float*)d_in[i];
    p.out = (float*)d_out; p.ws = (unsigned char*)d_ws;
#if MK_MULTI
    for (int ph = 0; ph < NPH; ++ph) { p.ph_lo = ph; p.ph_hi = ph + 1; hipLaunchKernelGGL(mega_fwd, dim3(grid), dim3(NTHREADS), LDS_BYTES, stream, p); }
#else
    p.ph_lo = 0; p.ph_hi = NPH;
    void* args[] = {&p};
    hipError_t e = hipLaunchCooperativeKernel((const void*)mega_fwd, dim3(grid), dim3(NTHREADS), args, LDS_BYTES, stream);
    if (e != hipSuccess) fprintf(stderr, "cooperative launch failed: %s (grid %d)\n", hipGetErrorString(e), grid);
#endif
}
```
